# Optimizing an MI355X kernel written in HIP

```python
import math
import jax, jax.numpy as jnp
from jax import lax
import numpy as np

D_MODEL = 1024
BATCH = 8
SEQ = 4096
DEPTH = 1

D_RNN = D_MODEL
RNN_BLOCKS = 16
RNN_BLOCK = D_RNN // RNN_BLOCKS
CONV_WIDTH = 4
LRU_C = 8.0
N_HEADS = 8
HEAD_DIM = D_MODEL // (2 * N_HEADS)
V_DIM = 2 * HEAD_DIM
D_QK = N_HEADS * 2 * HEAD_DIM
D_ATTN = N_HEADS * V_DIM
Q_BLOCK = 128
SPLIT_SIZES = (D_RNN, D_RNN, D_QK, D_QK, D_ATTN, D_ATTN, 2 * D_MODEL)
D_IN_TOTAL = sum(SPLIT_SIZES)
NORM_EPS = 1e-6

kernel_name = "hawk_diffattn_gated_parallel_block"


def lambda_init(layer_idx):
    return 0.8 - 0.6 * math.exp(-0.3 * layer_idx)


def rmsnorm(x, g):
    xf = x.astype(jnp.float32)
    y = xf * lax.rsqrt(jnp.mean(xf * xf, axis=-1, keepdims=True) + NORM_EPS)
    return (y * g.astype(jnp.float32)).astype(x.dtype)


def causal_depthwise_conv(x, w, b):
    S = x.shape[1]
    xp = jnp.pad(x, ((0, 0), (CONV_WIDTH - 1, 0), (0, 0)))
    y = xp[:, 0:S] * w[0]
    for tap in range(1, CONV_WIDTH):
        y = y + xp[:, tap:tap + S] * w[tap]
    return y + b


def rg_lru(x, wa, ba, wx, bx, a_param):
    B, S, _ = x.shape
    xf = x.astype(jnp.float32)
    xb = xf.reshape(B, S, RNN_BLOCKS, RNN_BLOCK)
    r = jax.nn.sigmoid(jnp.einsum('bsgi,gij->bsgj', xb, wa.astype(jnp.float32)) + ba).reshape(B, S, D_RNN)
    i = jax.nn.sigmoid(jnp.einsum('bsgi,gij->bsgj', xb, wx.astype(jnp.float32)) + bx).reshape(B, S, D_RNN)
    log_a = -LRU_C * r * jax.nn.softplus(-a_param.astype(jnp.float32))
    a = jnp.exp(log_a)
    b = jnp.sqrt(-jnp.expm1(2.0 * log_a)) * (i * xf)

    def combine(left, right):
        a1, b1 = left
        a2, b2 = right
        return a1 * a2, a2 * b1 + b2

    _, h = lax.associative_scan(combine, (a, b), axis=1)
    return h.astype(x.dtype)


def diff_attention(q, k, v, lam):
    S = q.shape[1]
    scale = HEAD_DIM ** -0.5
    outs = []
    for qb in range(S // Q_BLOCK):
        q0 = qb * Q_BLOCK
        q1 = q0 + Q_BLOCK
        s = jnp.einsum('bqhcd,bkhcd->bhcqk', q[:, q0:q1], k[:, :q1]).astype(jnp.float32) * scale
        mask = (q0 + jnp.arange(Q_BLOCK))[:, None] >= jnp.arange(q1)[None, :]
        s = jnp.where(mask, s, -jnp.inf)
        p = jax.nn.softmax(s, axis=-1)
        w = p[:, :, 0] - lam * p[:, :, 1]
        outs.append(jnp.einsum('bhqk,bkhe->bqhe', w.astype(v.dtype), v[:, :q1]))
    return jnp.concatenate(outs, axis=1)


def setup_inputs(seed: int = 0) -> dict:
    key = jax.random.key(seed)
    ks = jax.random.split(key, 24)
    f32 = jnp.float32
    nrm = lambda k, shape, s: jax.random.normal(k, shape, f32) * s
    x = jax.random.normal(ks[0], (BATCH, SEQ, D_MODEL), f32)
    pre_g = 1.0 + nrm(ks[1], (DEPTH, D_MODEL), 0.02)
    post_g = 1.0 + nrm(ks[2], (DEPTH, D_MODEL), 0.02)
    w_in = nrm(ks[3], (DEPTH, D_MODEL, D_IN_TOTAL), D_MODEL ** -0.5)
    conv_w = nrm(ks[4], (DEPTH, CONV_WIDTH, D_RNN), CONV_WIDTH ** -0.5)
    conv_b = nrm(ks[5], (DEPTH, D_RNN), 0.01)
    lru_wa = nrm(ks[6], (DEPTH, RNN_BLOCKS, RNN_BLOCK, RNN_BLOCK), RNN_BLOCK ** -0.5)
    lru_ba = nrm(ks[7], (DEPTH, RNN_BLOCKS, RNN_BLOCK), 0.01)
    lru_wx = nrm(ks[8], (DEPTH, RNN_BLOCKS, RNN_BLOCK, RNN_BLOCK), RNN_BLOCK ** -0.5)
    lru_bx = nrm(ks[9], (DEPTH, RNN_BLOCKS, RNN_BLOCK), 0.01)
    r0 = jax.random.uniform(ks[10], (DEPTH, D_RNN), f32, 0.9, 0.999)
    s0 = r0 ** (1.0 / LRU_C)
    lru_a = jnp.log(s0) - jnp.log1p(-s0)
    attn_lq1 = nrm(ks[11], (DEPTH, HEAD_DIM), 0.1)
    attn_lk1 = nrm(ks[12], (DEPTH, HEAD_DIM), 0.1)
    attn_lq2 = nrm(ks[13], (DEPTH, HEAD_DIM), 0.1)
    attn_lk2 = nrm(ks[14], (DEPTH, HEAD_DIM), 0.1)
    subln_g = 1.0 + nrm(ks[15], (DEPTH, V_DIM), 0.02)
    w_br_rnn = nrm(ks[16], (DEPTH, D_RNN, D_MODEL), D_RNN ** -0.5)
    w_br_attn = nrm(ks[17], (DEPTH, D_ATTN, D_MODEL), D_ATTN ** -0.5)
    w_out = nrm(ks[18], (DEPTH, D_MODEL, D_MODEL), D_MODEL ** -0.5)
    return {"x": x, "pre_g": pre_g, "post_g": post_g, "w_in": w_in,
            "conv_w": conv_w, "conv_b": conv_b, "lru_wa": lru_wa, "lru_ba": lru_ba,
            "lru_wx": lru_wx, "lru_bx": lru_bx, "lru_a": lru_a,
            "attn_lq1": attn_lq1, "attn_lk1": attn_lk1, "attn_lq2": attn_lq2,
            "attn_lk2": attn_lk2, "subln_g": subln_g, "w_br_rnn": w_br_rnn,
            "w_br_attn": w_br_attn, "w_out": w_out}


def reference(x, pre_g, post_g, w_in, conv_w, conv_b, lru_wa, lru_ba, lru_wx, lru_bx,
              lru_a, attn_lq1, attn_lk1, attn_lq2, attn_lk2, subln_g, w_br_rnn,
              w_br_attn, w_out):
    B, S, _ = x.shape
    split_points = [int(v) for v in np.cumsum(SPLIT_SIZES)[:-1]]
    h = x
    for l in range(DEPTH):
        u = rmsnorm(h, pre_g[l])
        z = jnp.einsum('bsd,df->bsf', u, w_in[l])
        xr, zr, q, k, v, za, gm = jnp.split(z, split_points, axis=-1)

        xc = causal_depthwise_conv(xr, conv_w[l], conv_b[l])
        y_r = rg_lru(xc, lru_wa[l], lru_ba[l], lru_wx[l], lru_bx[l], lru_a[l]) * jax.nn.silu(zr)

        lam_init = lambda_init(l)
        lam = (jnp.exp(jnp.sum(attn_lq1[l] * attn_lk1[l]).astype(jnp.float32))
               - jnp.exp(jnp.sum(attn_lq2[l] * attn_lk2[l]).astype(jnp.float32)) + lam_init)
        qh = q.reshape(B, S, N_HEADS, 2, HEAD_DIM)
        kh = k.reshape(B, S, N_HEADS, 2, HEAD_DIM)
        vh = v.reshape(B, S, N_HEADS, V_DIM)
        o = diff_attention(qh, kh, vh, lam)
        o = rmsnorm(o, subln_g[l]) * (1.0 - lam_init)
        y_a = o.reshape(B, S, D_ATTN) * jax.nn.silu(za)

        g_r, g_a = jnp.split(jax.nn.sigmoid(gm), 2, axis=-1)
        m = (g_r * jnp.einsum('bse,ed->bsd', y_r, w_br_rnn[l])
             + g_a * jnp.einsum('bse,ed->bsd', y_a, w_br_attn[l]))
        y = jnp.einsum('bsd,de->bse', m, w_out[l])
        h = h + rmsnorm(y, post_g[l])
    return h
```

```cpp
#include <hip/hip_runtime.h>
#include <hip/hip_cooperative_groups.h>
#include <cstdio>
#include <cstdint>
__device__ __forceinline__ int lane_id_() { return (int)__builtin_amdgcn_mbcnt_hi(~0u, __builtin_amdgcn_mbcnt_lo(~0u, 0u)); }
namespace pg8 {
#define PG8_LAS __attribute__((address_space(3)))
typedef unsigned short bf16_t;
typedef short bf16x8 __attribute__((ext_vector_type(8)));
typedef float f32x4 __attribute__((ext_vector_type(4)));
typedef unsigned u32x4 __attribute__((ext_vector_type(4)));
constexpr int BM = 256, BK = 64, HALF = 128, HTB = HALF * BK * 2  , STAGE_BYTES = 8 * HTB, NXCD = 8, WGM = 8;

__host__ __device__ __forceinline__ int lds_byte(int r, int c) { const int st = (r >> 4) * 2 + (c >> 5), rr = r & 15, cc = c & 31, ob = rr * 64 + cc * 2; return st * 1024 + (ob ^ (((ob >> 9) & 1) << 5)); }
__host__ __device__ __forceinline__ void stage_rc(int b, int& R, int& C) { const int st = b / 1024, sb = b % 1024, swz = sb ^ (((sb >> 9) & 1) << 5); R = (st >> 1) * 16 + swz / 64; C = (st & 1) * 32 + (swz % 64) / 2; }
__host__ __device__ __forceinline__ int perm32(int rho) { const int n = rho >> 4, i = rho & 15; return 8 * (i >> 2) + 4 * n + (i & 3); }

struct Unit { int pm, pn; };
struct Gemm { const bf16_t* A; const bf16_t* Bt; int M, N, K; };

struct StaticOrder {
    int nM, nN, nwg, G, c;
    __host__ __device__ void init(int M, int N, int G_, int c_) { nM = M / BM; nN = N / BM; nwg = nM * nN; G = G_; c = c_; }
    __host__ __device__ bool next(int i, Unit& u) const {
        const long L = (long)i * G + c; if (L >= nwg) return false;
        int wgid = (int)L; { const int q = nwg / NXCD, r = nwg % NXCD, xcd = wgid % NXCD, off = wgid / NXCD; wgid = (xcd < r ? xcd * (q + 1) : r * (q + 1) + (xcd - r) * q) + off; }
        const int nig = WGM * nN, gid = wgid / nig, fm = gid * WGM, gsz = (nM - fm) < WGM ? (nM - fm) : WGM;
        u.pm = fm + ((wgid % nig) % gsz); u.pn = (wgid % nig) / gsz; return true;
    }
    __device__ __forceinline__ void a_ready(const Unit&) const {}
    __device__ __forceinline__ void done(const Unit&) const {}
};

__device__ __forceinline__ unsigned cvt_pk_bf16(float lo, float hi) { unsigned r; asm volatile("v_cvt_pk_bf16_f32 %0, %1, %2" : "=v"(r) : "v"(lo), "v"(hi)); return r; }
typedef float f32x2 __attribute__((ext_vector_type(2)));
__device__ __forceinline__ float bf_lo(unsigned w) { return __builtin_bit_cast(float, w << 16); }
__device__ __forceinline__ float bf_hi(unsigned w) { return __builtin_bit_cast(float, w & 0xffff0000u); }
__device__ __forceinline__ float sigmoid_f(float v) { return __builtin_amdgcn_rcpf(1.0f + __builtin_amdgcn_exp2f(-1.4426950408889634f * v)); }
struct EpiSplit {
    static constexpr bool PERM = true, AFTER_DRAIN = false;
    bf16_t* O; size_t split_stride; unsigned acts; float scl;
    __device__ __forceinline__ void operator()(const f32x4 (&acc)[2][2][4][2], const Unit& u, int wr, int wc, int fr, int fq) const {
        const int row0 = u.pm * BM + wr * 64 + fr; int colt = u.pn * BM; const int t = colt >> 10; bf16_t* base = O + (size_t)t * split_stride; colt -= t << 10;
        const int act = (int)((acts >> (4 * t)) & 15u);
        const int col0 = colt + wc * 32 + 8 * fq;
#pragma unroll
        for (int ai = 0; ai < 2; ++ai)
#pragma unroll
            for (int m = 0; m < 4; ++m) { bf16_t* rowp = base + (size_t)(row0 + ai * HALF + m * 16) * 1024 + col0;
#pragma unroll
                for (int bj = 0; bj < 2; ++bj) { f32x4 v0 = acc[ai][bj][m][0], v1 = acc[ai][bj][m][1];
                    if (act == 1) {
#pragma unroll
                        for (int e = 0; e < 4; ++e) { v0[e] = v0[e] * sigmoid_f(v0[e]); v1[e] = v1[e] * sigmoid_f(v1[e]); }
                    } else if (act == 2) {
#pragma unroll
                        for (int e = 0; e < 4; ++e) { v0[e] = sigmoid_f(v0[e]); v1[e] = sigmoid_f(v1[e]); }
                    } else if (act == 3) { v0 = v0 * scl; v1 = v1 * scl; }
                    u32x4 w; w.x = cvt_pk_bf16(v0[0], v0[1]); w.y = cvt_pk_bf16(v0[2], v0[3]); w.z = cvt_pk_bf16(v1[0], v1[1]); w.w = cvt_pk_bf16(v1[2], v1[3]);
                    *(u32x4*)(rowp + bj * HALF) = w; } }
    }
};
template <bool ACCUM> struct EpiGate {
    static constexpr bool PERM = true, AFTER_DRAIN = false;
    const bf16_t* G; bf16_t* Mb;
    __device__ __forceinline__ void operator()(const f32x4 (&acc)[2][2][4][2], const Unit& u, int wr, int wc, int fr, int fq) const {
        const int row0 = u.pm * BM + wr * 64 + fr, col0 = u.pn * BM + wc * 32 + 8 * fq;
#pragma unroll
        for (int ai = 0; ai < 2; ++ai)
#pragma unroll
            for (int m = 0; m < 4; ++m) { const size_t off = (size_t)(row0 + ai * HALF + m * 16) * 1024 + col0;
#pragma unroll
                for (int bj = 0; bj < 2; ++bj) { const f32x4 a0 = acc[ai][bj][m][0], a1 = acc[ai][bj][m][1];
                    const u32x4 g = *(const u32x4*)(G + off + bj * HALF);
                    f32x4 v0, v1;
                    v0[0] = bf_lo(g.x) * a0[0]; v0[1] = bf_hi(g.x) * a0[1]; v0[2] = bf_lo(g.y) * a0[2]; v0[3] = bf_hi(g.y) * a0[3];
                    v1[0] = bf_lo(g.z) * a1[0]; v1[1] = bf_hi(g.z) * a1[1]; v1[2] = bf_lo(g.w) * a1[2]; v1[3] = bf_hi(g.w) * a1[3];
                    if (ACCUM) { const u32x4 o = *(const u32x4*)(Mb + off + bj * HALF);
                        v0[0] += bf_lo(o.x); v0[1] += bf_hi(o.x); v0[2] += bf_lo(o.y); v0[3] += bf_hi(o.y);
                        v1[0] += bf_lo(o.z); v1[1] += bf_hi(o.z); v1[2] += bf_lo(o.w); v1[3] += bf_hi(o.w); }
                    u32x4 w; w.x = cvt_pk_bf16(v0[0], v0[1]); w.y = cvt_pk_bf16(v0[2], v0[3]); w.z = cvt_pk_bf16(v1[0], v1[1]); w.w = cvt_pk_bf16(v1[2], v1[3]);
                    *(u32x4*)(Mb + off + bj * HALF) = w; } }
    }
};
struct EpiF32Stats {
    static constexpr bool PERM = false, AFTER_DRAIN = false;
    float* Y; float* stats;
    __device__ __forceinline__ void operator()(const f32x4 (&acc)[2][2][4][2], const Unit& u, int wr, int wc, int fr, int fq) const {
        const int col0 = u.pn * BM + wc * 32 + 4 * fq;
#pragma unroll
        for (int ai = 0; ai < 2; ++ai)
#pragma unroll
            for (int m = 0; m < 4; ++m) { const int r = u.pm * BM + ai * HALF + wr * 64 + m * 16 + fr; const size_t off = (size_t)r * 1024 + col0; float s = 0.f;
#pragma unroll
                for (int bj = 0; bj < 2; ++bj)
#pragma unroll
                    for (int n = 0; n < 2; ++n) { const f32x4 x = acc[ai][bj][m][n]; *(f32x4*)(Y + off + bj * HALF + n * 16) = x; s += (x[0] * x[0] + x[1] * x[1]) + (x[2] * x[2] + x[3] * x[3]); }
                s += __shfl_xor(s, 16); s += __shfl_xor(s, 32);
                if (fq == 0) stats[(size_t)r * 16 + u.pn * 4 + wc] = s; }
    }
};
template <class Epi, class Sched, bool ALIGN_EPI = false, bool SP2 = false>
__device__ __forceinline__ void gemm_phase(PG8_LAS unsigned char* lds, const Gemm g, const Sched& S, const Epi& E, const int wave_) {
    const int lane = lane_id_(), wid = wave_, tid = wid * 64 + lane, wr = wid >> 2, wc = wid & 3, fr = lane & 15, fq = lane >> 4;
    const int K = g.K, nt = K / BK;
    unsigned voffA[2], voffB[2];
#pragma unroll
    for (int i = 0; i < 2; ++i) { int R, C; stage_rc(tid * 16 + i * 8192, R, C); const int Rb = Epi::PERM ? ((R & ~31) + perm32(R & 31)) : R;
        voffA[i] = (unsigned)(R * K + C) * 2u; voffB[i] = (unsigned)(Rb * K + C) * 2u; }
    const size_t kstep = (size_t)(BK * 2);
    const size_t hstep = (size_t)HALF * K * 2;
    const size_t tstep = 2 * hstep;
    const unsigned ldsw = (unsigned)wid * 1024u;
    const int aoff = lds_byte(wr * 64 + fr, fq * 8), boff = lds_byte(wc * 32 + fr, fq * 8);
#define PG8_SA(b, h) (((b) * 2 + (h)) * HTB)
#define PG8_SB(b, h) ((4 + (b) * 2 + (h)) * HTB)
#define PG8_STAGE(bufoff, gbase, voff) do { _Pragma("unroll") for (int _i = 0; _i < 2; ++_i) \
        __builtin_amdgcn_global_load_lds((const unsigned*)((const char*)(gbase) + (voff)[_i]), (PG8_LAS unsigned*)(lds + (bufoff) + ldsw + _i * 8192), 16, 0, 0); } while (0)
#define PG8_LDA(dst, b, h) do { _Pragma("unroll") for (int m = 0; m < 4; ++m) _Pragma("unroll") for (int k = 0; k < 2; ++k) dst[m][k] = *(const PG8_LAS bf16x8*)(lds + PG8_SA(b, h) + aoff + m * 2048 + k * 1024); } while (0)
#define PG8_LDB(dst, b, h) do { _Pragma("unroll") for (int n = 0; n < 2; ++n) _Pragma("unroll") for (int k = 0; k < 2; ++k) dst[n][k] = *(const PG8_LAS bf16x8*)(lds + PG8_SB(b, h) + boff + n * 2048 + k * 1024); } while (0)
#define PG8_MMA(ai, bj, At, Bt) do { __builtin_amdgcn_s_setprio(1); _Pragma("unroll") for (int m = 0; m < 4; ++m) _Pragma("unroll") for (int n = 0; n < 2; ++n) _Pragma("unroll") for (int k = 0; k < 2; ++k) \
        acc[ai][bj][m][n] = __builtin_amdgcn_mfma_f32_16x16x32_bf16(Bt[n][k], At[m][k], acc[ai][bj][m][n], 0, 0, 0); __builtin_amdgcn_s_setprio(0); } while (0)
#define PG8_WAIT_V(n) asm volatile("s_waitcnt vmcnt(" #n ")" ::: "memory")
#define PG8_WAIT_L(n) asm volatile("s_waitcnt lgkmcnt(" #n ")" ::: "memory")
#define PG8_BAR __builtin_amdgcn_s_barrier()
#define PG8_SCHED __builtin_amdgcn_sched_barrier(0)
    Unit cur, nxt; int ui = 0;
    if (!S.next(0, cur)) return;
    f32x4 acc[2][2][4][2];
#pragma unroll
    for (int a = 0; a < 2; ++a)
#pragma unroll
        for (int b = 0; b < 2; ++b)
#pragma unroll
            for (int m = 0; m < 4; ++m)
#pragma unroll
                for (int n = 0; n < 2; ++n) acc[a][b][m][n] = (f32x4){0.f, 0.f, 0.f, 0.f};
    bf16x8 At[4][2], B0[2][2], B1[2][2];
    const char* cA = (const char*)g.A + (size_t)cur.pm * tstep; const char* cB = (const char*)g.Bt + (size_t)cur.pn * tstep;
    S.a_ready(cur);
    if constexpr (SP2) {
        PG8_STAGE(PG8_SB(0, 0), cB, voffB); PG8_STAGE(PG8_SB(0, 1), cB + hstep, voffB); PG8_STAGE(PG8_SA(0, 0), cA, voffA); PG8_STAGE(PG8_SA(0, 1), cA + hstep, voffA);
        if (wr == 1) PG8_BAR;
        PG8_WAIT_V(2); PG8_BAR;
        PG8_STAGE(PG8_SB(1, 0), cB + kstep, voffB); PG8_STAGE(PG8_SA(1, 0), cA + kstep, voffA); PG8_STAGE(PG8_SB(1, 1), cB + hstep + kstep, voffB);
        PG8_WAIT_V(6); PG8_BAR;
    } else {
        PG8_STAGE(PG8_SB(0, 0), cB, voffB); PG8_STAGE(PG8_SA(0, 0), cA, voffA); PG8_STAGE(PG8_SB(0, 1), cB + hstep, voffB); PG8_STAGE(PG8_SA(0, 1), cA + hstep, voffA);
        if (wr == 1) PG8_BAR;
        PG8_WAIT_V(4); PG8_BAR;
        PG8_STAGE(PG8_SB(1, 0), cB + kstep, voffB); PG8_STAGE(PG8_SA(1, 0), cA + kstep, voffA); PG8_STAGE(PG8_SB(1, 1), cB + hstep + kstep, voffB);
        PG8_WAIT_V(6); PG8_BAR;
    }
    for (;;) {
        const bool has_next = S.next(ui + 1, nxt);
        const char* nA = has_next ? (const char*)g.A + (size_t)nxt.pm * tstep : cA; const char* nB = has_next ? (const char*)g.Bt + (size_t)nxt.pn * tstep : cB;
        for (int t = 0; t < nt; t += 2) {
            const bool last = (t == nt - 2);
            const char* a1 = cA + (size_t)(t + 1) * kstep;
            const char* a2 = last ? nA : cA + (size_t)(t + 2) * kstep; const char* b2 = last ? nB : cB + (size_t)(t + 2) * kstep;
            const char* a3 = a2 + kstep; const char* b3 = b2 + kstep;
            if (last && has_next) S.a_ready(nxt);
            if constexpr (SP2) {
            PG8_LDB(B0, 0, 0); PG8_LDB(B1, 0, 1); PG8_SCHED; PG8_LDA(At, 0, 0); PG8_STAGE(PG8_SA(1, 1), a1 + hstep, voffA);
            PG8_WAIT_V(8); PG8_WAIT_L(0); PG8_BAR; PG8_MMA(0, 0, At, B0); PG8_MMA(0, 1, At, B1); PG8_BAR; PG8_SCHED;
            PG8_LDA(At, 0, 1); PG8_STAGE(PG8_SB(0, 0), b2, voffB); PG8_STAGE(PG8_SB(0, 1), b2 + hstep, voffB); PG8_STAGE(PG8_SA(0, 0), a2, voffA);
            PG8_WAIT_V(8); PG8_WAIT_L(0); PG8_BAR; PG8_MMA(1, 0, At, B0); PG8_MMA(1, 1, At, B1); PG8_BAR; PG8_SCHED;
            PG8_LDB(B0, 1, 0); PG8_LDB(B1, 1, 1); PG8_SCHED; PG8_LDA(At, 1, 0); PG8_STAGE(PG8_SA(0, 1), a2 + hstep, voffA);
            PG8_WAIT_V(8); PG8_WAIT_L(0); PG8_BAR; PG8_MMA(0, 0, At, B0); PG8_MMA(0, 1, At, B1); PG8_BAR; PG8_SCHED;
            PG8_LDA(At, 1, 1); PG8_STAGE(PG8_SB(1, 0), b3, voffB); PG8_STAGE(PG8_SB(1, 1), b3 + hstep, voffB); PG8_STAGE(PG8_SA(1, 0), a3, voffA);
            PG8_WAIT_V(8); PG8_WAIT_L(0); PG8_BAR; PG8_MMA(1, 0, At, B0); PG8_MMA(1, 1, At, B1); PG8_BAR; PG8_SCHED;
            } else {
            PG8_LDB(B0, 0, 0); PG8_SCHED; PG8_LDA(At, 0, 0); PG8_STAGE(PG8_SA(1, 1), a1 + hstep, voffA);
            PG8_WAIT_L(8); PG8_BAR; PG8_WAIT_L(0); PG8_MMA(0, 0, At, B0); PG8_BAR; PG8_SCHED;
            PG8_LDB(B1, 0, 1); PG8_STAGE(PG8_SB(0, 0), b2, voffB);
            PG8_BAR; PG8_WAIT_L(0); PG8_MMA(0, 1, At, B1); PG8_BAR;
            PG8_LDA(At, 0, 1); PG8_STAGE(PG8_SA(0, 0), a2, voffA);
            PG8_BAR; PG8_WAIT_L(0); PG8_MMA(1, 0, At, B0); PG8_BAR; PG8_SCHED;
            PG8_STAGE(PG8_SB(0, 1), b2 + hstep, voffB);
            PG8_WAIT_V(6); PG8_BAR; PG8_MMA(1, 1, At, B1); PG8_BAR;
            PG8_LDB(B0, 1, 0); PG8_SCHED; PG8_LDA(At, 1, 0); PG8_STAGE(PG8_SA(0, 1), a2 + hstep, voffA);
            PG8_WAIT_L(8); PG8_BAR; PG8_WAIT_L(0); PG8_MMA(0, 0, At, B0); PG8_BAR; PG8_SCHED;
            PG8_LDB(B1, 1, 1); PG8_STAGE(PG8_SB(1, 0), b3, voffB);
            PG8_BAR; PG8_WAIT_L(0); PG8_MMA(0, 1, At, B1); PG8_BAR;
            PG8_LDA(At, 1, 1); PG8_STAGE(PG8_SA(1, 0), a3, voffA);
            PG8_BAR; PG8_WAIT_L(0); PG8_MMA(1, 0, At, B0); PG8_BAR; PG8_SCHED;
            PG8_STAGE(PG8_SB(1, 1), b3 + hstep, voffB);
            PG8_WAIT_V(6); PG8_BAR; PG8_MMA(1, 1, At, B1); PG8_BAR;
            }
        }
        if constexpr (ALIGN_EPI) { if (wr == 0) PG8_BAR; }
        if constexpr (!Epi::AFTER_DRAIN) { E(acc, cur, wr, wc, fr, fq); S.done(cur); }
        if (!has_next) break;
#pragma unroll
        for (int a = 0; a < 2; ++a)
#pragma unroll
            for (int b = 0; b < 2; ++b)
#pragma unroll
                for (int m = 0; m < 4; ++m)
#pragma unroll
                    for (int n = 0; n < 2; ++n) acc[a][b][m][n] = (f32x4){0.f, 0.f, 0.f, 0.f};
        cur = nxt; cA = nA; cB = nB; ++ui;
        if constexpr (ALIGN_EPI) { if (wr == 1) PG8_BAR; }
    }
    PG8_WAIT_V(0);
    if constexpr (!ALIGN_EPI) { if (wr == 0) PG8_BAR; }
    PG8_BAR;
    if constexpr (Epi::AFTER_DRAIN) { E.fused(acc, cur, wr, wc, fr, fq, lds, wid, lane); S.done(cur); }
#undef PG8_SA
#undef PG8_SB
#undef PG8_STAGE
#undef PG8_LDA
#undef PG8_LDB
#undef PG8_MMA
#undef PG8_WAIT_V
#undef PG8_WAIT_L
#undef PG8_BAR
#undef PG8_SCHED
}
}

#ifndef PG8_SP2
#define PG8_SP2 true
#endif
#ifndef PG8_ALIGN
#define PG8_ALIGN true
#endif
#include <hip/hip_bf16.h>
#include <cmath>
#include <hip/hip_bf16.h>
#include <cmath>
namespace attn_body {
using bf16=__hip_bfloat16;
using bf16x8=__attribute__((ext_vector_type(8)))short;
using s16x4=__attribute__((ext_vector_type(4)))short;
using f32x16=__attribute__((ext_vector_type(16)))float;
using u32x4=__attribute__((ext_vector_type(4)))unsigned;
constexpr int BATCH=8,NHEAD=16,SEQ=4096,D=64,DM=NHEAD*D,OPITCH=2048;
constexpr int NW=8,QBLK=32,QB=QBLK*NW,KVBLK=64,NQB=SEQ/QB;
constexpr int ATTN_PITCH=DM, ATTN_UNIT_ROWS=QB;
__device__ __forceinline__ int crow(int r,int hi){return (r&3)+8*(r>>2)+4*hi;}
#define SBAR() __builtin_amdgcn_sched_barrier(0)
__device__ __forceinline__ void cmask(f32x16&p0,f32x16&p1,int jb,int qrel,int hi){
  const float NEG=-INFINITY; int kb=64*jb+4*hi;
  #pragma unroll
  for(int r=0;r<16;++r){int kv=kb+(r&3)+8*(r>>2); if(kv>qrel)p0[r]=NEG; if(kv+32>qrel)p1[r]=NEG;}
}

constexpr int NSLOT=3, SLOTB=8192;
constexpr int LDS_K=0, LDS_V=NSLOT*SLOTB, LDS_WS=2*NSLOT*SLOTB, LDS_OST=LDS_WS+NW*64*4, LDS_BYTES=LDS_OST+NW*4096;
constexpr float C2=0.125f*1.4426950408889634f;
__device__ __forceinline__ void glds16(const void*gsrc,unsigned lds_dst){unsigned keep;
  asm volatile("s_mov_b32 %0, m0\n\ts_mov_b32 m0, %2\n\ts_nop 0\n\tglobal_load_lds_dwordx4 %1, off\n\ts_mov_b32 m0, %0":"=&s"(keep):"v"(gsrc),"s"(lds_dst):"memory");}
__device__ __forceinline__ float max3f(float a,float b,float c){float r;asm("v_max3_f32 %0, %1, %2, %3":"=v"(r):"v"(a),"v"(b),"v"(c));return r;}
__device__ __forceinline__ float max2f(float a,float b){float r;asm("v_max_f32_e32 %0, %1, %2":"=v"(r):"v"(a),"v"(b));return r;}
__device__ __forceinline__ float fadd_s(float a,float b){float r;asm("v_add_f32_e32 %0, %1, %2":"=v"(r):"v"(a),"v"(b));return r;}
__device__ __forceinline__ float fsub_s(float a,float b){float r;asm("v_sub_f32_e32 %0, %1, %2":"=v"(r):"v"(a),"v"(b));return r;}
typedef float f32x2_t __attribute__((ext_vector_type(2))); typedef __bf16 bf16x2_t __attribute__((ext_vector_type(2)));
__device__ __forceinline__ unsigned cvtpk_s(float lo,float hi){f32x2_t v={lo,hi};bf16x2_t b=__builtin_convertvector(v,bf16x2_t);return __builtin_bit_cast(unsigned,b);}
#define WAIT_BAR(N) asm volatile("s_waitcnt vmcnt(" #N ") lgkmcnt(0)\n\ts_barrier":::"memory")

__device__ __forceinline__ void qkt(f32x16&p0,f32x16&p1,const char*Kslot,const bf16x8*qr,int r32,int hi){
  const char*kb=Kslot+hi*1024+r32*16;
  #pragma unroll
  for(int d0=0;d0<4;++d0){
    const bf16x8 b0=*reinterpret_cast<const bf16x8*>(kb+d0*2048);
    const bf16x8 b1=*reinterpret_cast<const bf16x8*>(kb+d0*2048+512);
    if(d0==0){p0=__builtin_amdgcn_mfma_f32_32x32x16_bf16(b0,qr[0],f32x16{},0,0,0);p1=__builtin_amdgcn_mfma_f32_32x32x16_bf16(b1,qr[0],f32x16{},0,0,0);}
    else{p0=__builtin_amdgcn_mfma_f32_32x32x16_bf16(b0,qr[d0],p0,0,0,0);p1=__builtin_amdgcn_mfma_f32_32x32x16_bf16(b1,qr[d0],p1,0,0,0);}}
}
typedef __attribute__((address_space(3))) const char* lds_cptr;
typedef short v4i16_t __attribute__((ext_vector_type(4)));
__device__ __forceinline__ void kload8(bf16x8*kf,lds_cptr kp){
  kf[0]=*(const __attribute__((address_space(3))) bf16x8*)(kp);      kf[1]=*(const __attribute__((address_space(3))) bf16x8*)(kp+512);
  kf[2]=*(const __attribute__((address_space(3))) bf16x8*)(kp+2048); kf[3]=*(const __attribute__((address_space(3))) bf16x8*)(kp+2560);
  kf[4]=*(const __attribute__((address_space(3))) bf16x8*)(kp+4096); kf[5]=*(const __attribute__((address_space(3))) bf16x8*)(kp+4608);
  kf[6]=*(const __attribute__((address_space(3))) bf16x8*)(kp+6144); kf[7]=*(const __attribute__((address_space(3))) bf16x8*)(kp+6656);
}
__device__ __forceinline__ void kload2(bf16x8*kf,lds_cptr kp,int j){ kf[2*j]=*(const __attribute__((address_space(3))) bf16x8*)(kp+j*2048); kf[2*j+1]=*(const __attribute__((address_space(3))) bf16x8*)(kp+j*2048+512); }
__device__ __forceinline__ s16x4 vtr(lds_cptr p){ return __builtin_bit_cast(s16x4,__builtin_amdgcn_ds_read_tr16_b64_v4i16((__attribute__((address_space(3))) v4i16_t*)p)); }
__device__ __forceinline__ float rowmax(const f32x16&p0,const f32x16&p1){
  float a=max3f(p0[0],p0[1],p1[0]),b=max3f(p0[2],p0[3],p1[1]);a=max3f(a,p1[2],p1[3]);
  #pragma unroll
  for(int r=4;r<16;r+=4){a=max3f(a,p0[r],p0[r+1]);b=max3f(b,p0[r+2],p0[r+3]);a=max3f(a,p1[r],p1[r+1]);b=max3f(b,p1[r+2],p1[r+3]);}
  const float m=max2f(a,b);
  auto rr=__builtin_amdgcn_permlane32_swap(__float_as_uint(m),__float_as_uint(m),false,false);
  return max2f(__uint_as_float(rr[0]),__uint_as_float(rr[1]));
}
__device__ __forceinline__ void pv(f32x16*o,int vb,bf16x8 pa0,bf16x8 pa1,bf16x8 pa2,bf16x8 pa3){
  #pragma unroll
  for(int d0=0;d0<2;++d0){s16x4 lo[4],hi[4];
    #pragma unroll
    for(int ks=0;ks<4;++ks){
      asm volatile("ds_read_b64_tr_b16 %0,%1 offset:%c2":"=&v"(lo[ks]):"v"(vb),"i"(d0*4096+ks*1024):"memory");
      asm volatile("ds_read_b64_tr_b16 %0,%1 offset:%c2":"=&v"(hi[ks]):"v"(vb),"i"(d0*4096+ks*1024+512):"memory");}
    asm volatile("s_waitcnt lgkmcnt(0)":::"memory");SBAR();
    #define PK(k) (bf16x8){lo[k][0],lo[k][1],lo[k][2],lo[k][3],hi[k][0],hi[k][1],hi[k][2],hi[k][3]}
    o[d0]=__builtin_amdgcn_mfma_f32_32x32x16_bf16(pa0,PK(0),o[d0],0,0,0);
    o[d0]=__builtin_amdgcn_mfma_f32_32x32x16_bf16(pa1,PK(1),o[d0],0,0,0);
    o[d0]=__builtin_amdgcn_mfma_f32_32x32x16_bf16(pa2,PK(2),o[d0],0,0,0);
    o[d0]=__builtin_amdgcn_mfma_f32_32x32x16_bf16(pa3,PK(3),o[d0],0,0,0);
    #undef PK
  }
}

#ifndef ATTN_STORE16
#define ATTN_STORE16(p,v) (*(u32x4*)(p)=(v))
#endif
template<int THRL> __device__ __forceinline__ void attn_unit(int b,int h,int vh,int qb,const bf16*Q,const bf16*__restrict__ K,const bf16*__restrict__ V,bf16*O,char*shm,const int wave_){
  const int lane=lane_id_(),r32=lane&31,hi=lane>>5; const int wid=wave_; const int tid=wid*64+lane;
  const long rowbase=(long)b*SEQ; const int q0=qb*QB;
  const bf16*Qw=Q+(rowbase+q0+wid*QBLK)*DM+h*D;
  const bf16*Kh=K+rowbase*DM+h*D,*Vh=V+rowbase*DM+(h>>1)*128+vh*64;
  const unsigned lds0=(unsigned)(uintptr_t)shm;
  float*wsf=(float*)(shm+LDS_WS)+wid*64;
  const bf16*ksrc=Kh+(long)lane*DM+wid*8;
  const bf16*vsrc=Vh+(long)(16*(wid&3)+(lane>>2))*DM+(wid>>2)*32+(lane&3)*8;
  const unsigned kdst=lds0+LDS_K+wid*1024, vdst=lds0+LDS_V+wid*1024;
  #define DMA_K(t,slot) glds16(ksrc+(long)(t)*KVBLK*DM,(unsigned)__builtin_amdgcn_readfirstlane(kdst+(slot)))
  #define DMA_V(t,slot) glds16(vsrc+(long)(t)*KVBLK*DM,(unsigned)__builtin_amdgcn_readfirstlane(vdst+(slot)))
  const int vb0=(int)(lds0+LDS_V)+((lane>>4)&1)*32+(lane&3)*8+(4*hi+((lane&15)>>2))*64;
  const char*Kbase=shm+LDS_K; bf16x8 kf[8];
  const lds_cptr shm3=(lds_cptr)shm; const lds_cptr kp0=shm3+LDS_K+hi*1024+r32*16; const lds_cptr vp0=shm3+LDS_V+((lane>>4)&1)*32+(lane&3)*8+(4*hi+((lane&15)>>2))*64;
  const int NT=(q0+QB)/KVBLK;
  DMA_K(0,0);DMA_V(0,0);DMA_K(1,SLOTB);
  bf16x8 qr[4];
  #pragma unroll
  for(int d0=0;d0<4;++d0)qr[d0]=*reinterpret_cast<const bf16x8*>(&Qw[(long)r32*DM+d0*16+hi*8]);
  float mhat=0.f,l_reg=0.f;f32x16 o[2];o[0]=f32x16{};o[1]=f32x16{};
  const int qrel=wid*QBLK+r32;
  #define CMASK(P0,P1,t) do{int jb_=(t)-(NT-4); if(jb_>=0)cmask(P0,P1,jb_,qrel,hi);}while(0)
  bool resc=false;
  #define START(P0,P1) do{ const float rm=rowmax(P0,P1); resc=false; \
    { const float dl=rm; mhat=fadd_s(mhat,dl); \
      _Pragma("unroll") for(int r=0;r<16;++r){P0[r]=fsub_s(P0[r],dl);P1[r]=fsub_s(P1[r],dl);} \
      } \
    _Pragma("unroll") for(int r=0;r<16;++r)P0[r]=__builtin_amdgcn_exp2f(P0[r]); }while(0)
  #define RESC() do{ if(resc){ asm volatile("s_waitcnt lgkmcnt(0)":::"memory"); \
      _Pragma("unroll") for(int d_=0;d_<2;++d_) _Pragma("unroll") for(int r=0;r<16;++r)o[d_][r]*=wsf[crow(r,hi)]; } }while(0)
  f32x16 pA0,pA1,pB0,pB1;
  int sl_prev=0,sl_cur=0,sl_next=SLOTB;
  #define ROT() do{sl_prev=sl_cur;sl_cur=sl_next;sl_next=(sl_next==(NSLOT-1)*SLOTB)?0:sl_next+SLOTB;}while(0)
  DMA_K(2,2*SLOTB);
  WAIT_BAR(3);
  qkt(pA0,pA1,Kbase,qr,r32,hi);asm volatile("s_nop 15\n\ts_nop 7":"+v"(pA0),"+v"(pA1));CMASK(pA0,pA1,0);
  START(pA0,pA1);
  _Pragma("unroll") for(int r=0;r<16;++r)pA1[r]=__builtin_amdgcn_exp2f(pA1[r]);
  WAIT_BAR(0);
  DMA_K(3,0);DMA_V(1,SLOTB);
  ROT();
  kload8(kf,kp0+sl_cur);
  WAIT_BAR(2);
  s16x4 vlo[8],vhi[8]; u32x4 pw0,pw1,pw2,pw3;
  #define PKW(P,B) cvtpk_s(P[B],P[B+1])
  #define PAF(k) __builtin_bit_cast(bf16x8,pw##k)
  #define VFR(i) (bf16x8){vlo[i][0],vlo[i][1],vlo[i][2],vlo[i][3],vhi[i][0],vhi[i][1],vhi[i][2],vhi[i][3]}
  #define PIN(x) asm volatile("":"+v"(x))
  #define MX3(a,b,c) __builtin_fmaxf(__builtin_fmaxf((a),(b)),(c))
  #define GAPA(MF,A0,A1,A2,A3,W0,W1,PW) do{ MF; sacc+=A0; sacc+=A1; sacc+=A2; sacc+=A3; PIN(sacc); W0; W1; PIN(PW); SBAR(); }while(0)
  #define EX(v) __builtin_amdgcn_exp2f(v)
  #define GAPB(MF,X,B) do{ MF; X[B]=EX(X[B]-mhat); X[B+1]=EX(X[B+1]-mhat); X[B+2]=EX(X[B+2]-mhat); X[B+3]=EX(X[B+3]-mhat); PIN(X); SBAR(); }while(0)
  #define VRD(i) do{ vlo[i]=vtr(vp_+(((i)>>2)*4096+((i)&3)*1024)); vhi[i]=vtr(vp_+(((i)>>2)*4096+((i)&3)*1024+512)); }while(0)
  #define KRD(G,j) do{ if(G){ kload2(kf,kp0+sl_next,j); SBAR(); } }while(0)
  #define STEP(C0,C1,P0,P1,t,GK,GV,GL) do{ SBAR(); \
    const lds_cptr vp_=vp0+sl_prev; \
    VRD(0); SBAR(); float sacc=(P0[0]+P0[1]); \
    GAPA(C0=__builtin_amdgcn_mfma_f32_32x32x16_bf16(kf[0],qr[0],f32x16{},0,0,0), P0[2],P0[3],P0[4],P0[5],     pw0[0]=PKW(P0,0), pw0[1]=PKW(P0,2), pw0); \
    VRD(4); SBAR(); GAPA(C1=__builtin_amdgcn_mfma_f32_32x32x16_bf16(kf[1],qr[0],f32x16{},0,0,0), P0[6],P0[7],P0[8],P0[9],     pw0[2]=PKW(P0,4), pw0[3]=PKW(P0,6), pw0); \
    VRD(1); SBAR(); GAPA(C0=__builtin_amdgcn_mfma_f32_32x32x16_bf16(kf[2],qr[1],C0,0,0,0),   P0[10],P0[11],P0[12],P0[13], pw1[0]=PKW(P0,8), pw1[1]=PKW(P0,10), pw1); \
    VRD(5); SBAR(); GAPA(C1=__builtin_amdgcn_mfma_f32_32x32x16_bf16(kf[3],qr[1],C1,0,0,0),   P0[14],P0[15],P1[0],P1[1],   pw1[2]=PKW(P0,12),pw1[3]=PKW(P0,14), pw1); \
    VRD(2); SBAR(); GAPA(C0=__builtin_amdgcn_mfma_f32_32x32x16_bf16(kf[4],qr[2],C0,0,0,0),   P1[2],P1[3],P1[4],P1[5],     pw2[0]=PKW(P1,0), pw2[1]=PKW(P1,2), pw2); \
    VRD(6); SBAR(); GAPA(C1=__builtin_amdgcn_mfma_f32_32x32x16_bf16(kf[5],qr[2],C1,0,0,0),   P1[6],P1[7],P1[8],P1[9],     pw2[2]=PKW(P1,4), pw2[3]=PKW(P1,6), pw2); \
    VRD(3); SBAR(); GAPA(C0=__builtin_amdgcn_mfma_f32_32x32x16_bf16(kf[6],qr[3],C0,0,0,0),   P1[10],P1[11],P1[12],P1[13], pw3[0]=PKW(P1,8), pw3[1]=PKW(P1,10), pw3); \
    VRD(7); SBAR(); GAPA(C1=__builtin_amdgcn_mfma_f32_32x32x16_bf16(kf[7],qr[3],C1,0,0,0),   P1[14],P1[15],0.f,0.f,       pw3[2]=PKW(P1,12),pw3[3]=PKW(P1,14), pw3); \
    l_reg+=sacc; \
    if(GK){DMA_K((t)+3,sl_cur);} if(GV){DMA_V((t)+1,sl_next);} \
    CMASK(C0,C1,t); \
    { float a=MX3(C0[0],C0[1],C1[0]),b=MX3(C0[2],C0[3],C1[1]); a=MX3(a,C1[2],C1[3]); \
      _Pragma("unroll") for(int r=4;r<16;r+=4){a=MX3(a,C0[r],C0[r+1]);b=MX3(b,C0[r+2],C0[r+3]);a=MX3(a,C1[r],C1[r+1]);b=MX3(b,C1[r+2],C1[r+3]);} \
      float rm=__builtin_fmaxf(a,b); { auto rr=__builtin_amdgcn_permlane32_swap(__float_as_uint(rm),__float_as_uint(rm),false,false); rm=__builtin_fmaxf(__uint_as_float(rr[0]),__uint_as_float(rr[1])); } \
      resc=false; \
      rm-=mhat; \
      if(__builtin_expect(__any(rm>(float)THRL),0)){ const float dl=__builtin_fmaxf(rm,0.f); mhat+=dl; \
        const float f=__builtin_amdgcn_exp2f(-dl); l_reg*=f; if(hi==0)wsf[r32]=f; resc=true; } } \
    SBAR(); \
    GAPB(o[0]=__builtin_amdgcn_mfma_f32_32x32x16_bf16(PAF(0),VFR(0),o[0],0,0,0), C0,0); \
    GAPB(o[1]=__builtin_amdgcn_mfma_f32_32x32x16_bf16(PAF(0),VFR(4),o[1],0,0,0), C0,4); \
    KRD(GL,0); GAPB(o[0]=__builtin_amdgcn_mfma_f32_32x32x16_bf16(PAF(1),VFR(1),o[0],0,0,0), C0,8); \
    KRD(GL,1); GAPB(o[1]=__builtin_amdgcn_mfma_f32_32x32x16_bf16(PAF(1),VFR(5),o[1],0,0,0), C0,12); \
    KRD(GL,2); GAPB(o[0]=__builtin_amdgcn_mfma_f32_32x32x16_bf16(PAF(2),VFR(2),o[0],0,0,0), C1,0); \
    KRD(GL,3); GAPB(o[1]=__builtin_amdgcn_mfma_f32_32x32x16_bf16(PAF(2),VFR(6),o[1],0,0,0), C1,4); \
    GAPB(o[0]=__builtin_amdgcn_mfma_f32_32x32x16_bf16(PAF(3),VFR(3),o[0],0,0,0), C1,8); \
    GAPB(o[1]=__builtin_amdgcn_mfma_f32_32x32x16_bf16(PAF(3),VFR(7),o[1],0,0,0), C1,12); \
    }while(0)
  int t=1;
  #undef CMASK
  #define CMASK(P0,P1,t) do{}while(0)
  for(;t+5<NT;t+=2){
    STEP(pB0,pB1,pA0,pA1,t,true,true,true);     WAIT_BAR(2); RESC(); ROT();
    STEP(pA0,pA1,pB0,pB1,t+1,true,true,true);   WAIT_BAR(2); RESC(); ROT();
  }
  #undef CMASK
  #define CMASK(P0,P1,t) do{int jb_=(t)-(NT-4); if(jb_>=0)cmask(P0,P1,jb_,qrel,hi);}while(0)
  #define ENDW(tt) do{ if((tt)+3<NT){WAIT_BAR(2);} else if((tt)+2<NT){WAIT_BAR(1);} else {WAIT_BAR(0);} }while(0)
  for(;t+1<NT;t+=2){
    STEP(pB0,pB1,pA0,pA1,t,(t+3<NT),(t+1<NT),(t+1<NT));       ENDW(t);   RESC(); ROT();
    STEP(pA0,pA1,pB0,pB1,t+1,(t+4<NT),(t+2<NT),(t+2<NT));     ENDW(t+1); RESC(); ROT();
  }
  STEP(pB0,pB1,pA0,pA1,NT-1,false,false,false); RESC();
  { float sacc=pB0[0]+pB0[1]; _Pragma("unroll") for(int r=2;r<16;++r)sacc+=pB0[r]; _Pragma("unroll") for(int r=0;r<16;++r)sacc+=pB1[r]; l_reg+=sacc;
    pw0=(u32x4){PKW(pB0,0),PKW(pB0,2),PKW(pB0,4),PKW(pB0,6)};pw1=(u32x4){PKW(pB0,8),PKW(pB0,10),PKW(pB0,12),PKW(pB0,14)};pw2=(u32x4){PKW(pB1,0),PKW(pB1,2),PKW(pB1,4),PKW(pB1,6)};pw3=(u32x4){PKW(pB1,8),PKW(pB1,10),PKW(pB1,12),PKW(pB1,14)};
    SBAR(); pv(o,vb0+sl_cur,PAF(0),PAF(1),PAF(2),PAF(3)); }
  #undef PKW
  #undef PAF
  #undef VFR
  #undef PIN
  #undef MX3
  #undef GAPA
  #undef GAPB
  #undef EX
  #undef VRD
  #undef KRD
  #undef STEP
  #undef ENDW
  {auto rr=__builtin_amdgcn_permlane32_swap(__float_as_uint(l_reg),__float_as_uint(l_reg),false,false);l_reg=__uint_as_float(rr[0])+__uint_as_float(rr[1]);}
  if(hi==0)wsf[32+r32]=l_reg;asm volatile("s_waitcnt lgkmcnt(0)":::"memory");
  float rli[16];
  #pragma unroll
  for(int r=0;r<16;++r)rli[r]=__builtin_amdgcn_rcpf(wsf[32+crow(r,hi)]);
  bf16*Ow=O+(rowbase+q0+wid*QBLK)*OPITCH+h*128+vh*64;
  { bf16*stg=(bf16*)(shm+LDS_OST)+wid*2048;
    #pragma unroll
    for(int r=0;r<16;++r){const int orow=crow(r,hi);
      #pragma unroll
      for(int d0=0;d0<2;++d0)stg[orow*64+d0*32+r32]=__float2bfloat16(o[d0][r]*rli[r]);}
    asm volatile("s_waitcnt lgkmcnt(0)":::"memory");
    #pragma unroll
    for(int i=0;i<4;++i){const int row=i*8+(lane>>3),ch=lane&7; const u32x4 v=*(const u32x4*)(stg+row*64+ch*8); ATTN_STORE16(Ow+(long)row*OPITCH+ch*8,v);} }
  asm volatile("s_waitcnt lgkmcnt(0)\n\ts_barrier":::"memory");
  #undef DMA_K
  #undef DMA_V
  #undef CMASK
  #undef START
  #undef RESC
  #undef ROT
}
constexpr int ATTN_LDS_BYTES=LDS_BYTES;
struct AttnTensors { const bf16* Q; const bf16* K; const bf16* V; bf16* O; };
struct AttnUnit { int bh; int vh; int qb; };
struct StaticOrder {
  int vcu, G;
  __device__ __forceinline__ explicit StaticOrder(int vcu_,int G_):vcu(vcu_),G(G_){}
  __device__ __forceinline__ bool next(int i,AttnUnit&u)const{ const int s=vcu+(i>>4)*G; if(s>=BATCH*NHEAD*2)return false; u.bh=s>>1; u.vh=s&1; const int j=i&15; u.qb=(j&1)?(j>>1):(NQB-1-(j>>1)); return true; }
};
template<class Sched,int THRL=8> __device__ __forceinline__ void attn_phase(char*lds,const AttnTensors&T,const Sched&S,const int wave_){
  AttnUnit u;
  for(int i=0;S.next(i,u);++i){ attn_unit<THRL>(u.bh/NHEAD,u.bh%NHEAD,u.vh,u.qb,T.Q,T.K,T.V,T.O,lds,wave_); }
}
#undef SBAR
#undef WAIT_BAR
}
#define GAS __attribute__((address_space(1)))
#define LAS __attribute__((address_space(3)))
#define XB_TMO      128
#define XB_XCNT(j)  (256  + 64 * (j))
#define XB_XSUB(j)  (1280 + 64 * (j))
#define XB_XGEN(j)  (2304 + 64 * (j))
#define XB_TOP      3328
#define XB_TOPGEN   3392
#define XCD_BAR_WORDS 3456
#define XB_SPIN_CAP (1u << 18)

__device__ __forceinline__ unsigned xb_ld(unsigned* p)              { return __hip_atomic_load(p, __ATOMIC_RELAXED, __HIP_MEMORY_SCOPE_AGENT); }
__device__ __forceinline__ unsigned xb_add(unsigned* p, unsigned v) { return __hip_atomic_fetch_add(p, v, __ATOMIC_RELAXED, __HIP_MEMORY_SCOPE_AGENT); }
__device__ __forceinline__ unsigned xb_xcc_id() { return (unsigned)__builtin_amdgcn_s_getreg((3 << 11) | 20) & 0xFu; }
#define XB_SPIN(cond, bar) do { unsigned _sp = 0; while (cond) { __builtin_amdgcn_s_sleep(1); \
    if ((++_sp & 255u) == 0u) { if (xb_ld(&(bar)[XB_TMO])) break; if (_sp > XB_SPIN_CAP) { atomicAdd(&(bar)[XB_TMO], 1u); break; } } } } while (0)

struct XcdBarrier {
    unsigned* bar; unsigned x;
    volatile LAS unsigned* st;
};

__device__ __forceinline__ XcdBarrier xcd_barrier_post(unsigned* bar, volatile LAS unsigned* st, const bool lane0w0) {
    XcdBarrier b; b.bar = bar; b.x = xb_xcc_id(); b.st = st;
    if (lane0w0) (void)xb_add(&bar[XB_XCNT(b.x)], 1u);
    return b;
}
__device__ __forceinline__ void xcd_barrier_complete(unsigned* bar, unsigned x, unsigned& nloc, unsigned& nx) {
    const unsigned G = gridDim.x * gridDim.y * gridDim.z;
    unsigned sum, cnt, mine, sp = 0u;
    for (;;) {
        sum = 0u; cnt = 0u; mine = 0u;
#pragma unroll
        for (unsigned j = 0; j < 16; ++j) { const unsigned c = xb_ld(&bar[XB_XCNT(j)]); sum += c; cnt += (c > 0u) ? 1u : 0u; mine = (j == x) ? c : mine; }
        if (sum == G) break;
        __builtin_amdgcn_s_sleep(1);
        if ((++sp & 255u) == 0u) { if (xb_ld(&bar[XB_TMO])) break; if (sp > XB_SPIN_CAP) { atomicAdd(&bar[XB_TMO], 1u); break; } }
    }
    nloc = mine > 0u ? mine : 1u; nx = cnt > 0u ? cnt : 1u;
}

__device__ __forceinline__ void xcd_barrier(const XcdBarrier& b, const bool lane0w0) {
    asm volatile("s_waitcnt vmcnt(0)" ::: "memory");
    __syncthreads();
    if (lane0w0) {
        unsigned* bar = b.bar;
        __builtin_amdgcn_s_waitcnt(0);
        unsigned nloc = b.st[0], nx = b.st[1];
        if (nloc == 0u) { xcd_barrier_complete(bar, b.x, nloc, nx); b.st[0] = nloc; b.st[1] = nx; }
        const unsigned old = xb_add(&bar[XB_XSUB(b.x)], 1u);
        const unsigned gen = old / nloc;
        if (old + 1u == (gen + 1u) * nloc) {
            __builtin_amdgcn_fence(__ATOMIC_RELEASE, "agent");
            asm volatile("s_waitcnt vmcnt(0)" ::: "memory");
            const unsigned og = xb_add(&bar[XB_TOP], 1u);
            const unsigned tg = og / nx;
            if (og + 1u == (tg + 1u) * nx) xb_add(&bar[XB_TOPGEN], 1u);
            else XB_SPIN(xb_ld(&bar[XB_TOPGEN]) == tg, bar);
            __builtin_amdgcn_fence(__ATOMIC_ACQUIRE, "agent");
            xb_add(&bar[XB_XGEN(b.x)], 1u);
            asm volatile("s_waitcnt vmcnt(0)" ::: "memory");
        } else {
            XB_SPIN(xb_ld(&bar[XB_XGEN(b.x)]) == gen, bar);
            __builtin_amdgcn_fence(__ATOMIC_ACQUIRE, "agent");
            asm volatile("s_waitcnt vmcnt(0)" ::: "memory");
        }
    }
    __syncthreads();
}
namespace cg = cooperative_groups;
constexpr int NWAVES = 8;
constexpr int BATCH = 8, SEQ = 4096, D = 1024, M = BATCH * SEQ, NIN = 8192;
constexpr float NORM_EPS = 1e-6f;
constexpr float LAM_INIT = 0.2f;
constexpr size_t MiB = 1u << 20, SLOT = 64 * MiB;
constexpr size_t WS_XR = 0 * SLOT, WS_ZR = 1 * SLOT  , WS_Q = 2 * SLOT  , WS_K = 3 * SLOT  , WS_V = 4 * SLOT  , WS_ZA = 5 * SLOT  , WS_U = 6 * SLOT;
constexpr size_t WS_MISC = 7 * SLOT;
constexpr size_t WS_CTL = WS_MISC, CTL_ZERO_BYTES = 64 * 1024;
constexpr size_t WS_CARRY = WS_MISC + 1 * MiB;
constexpr size_t WS_STATS = WS_MISC + 2 * MiB;
constexpr size_t WS_WIN = WS_MISC + 4 * MiB;
constexpr size_t WS_WR = WS_MISC + 20 * MiB, WS_WA = WS_MISC + 22 * MiB, WS_WO = WS_MISC + 24 * MiB, WS_END = WS_MISC + 26 * MiB;
constexpr int LDS_BYTES = 147456;
constexpr int MISC_OFF = 131072 + 320;

typedef unsigned short bf16;
typedef unsigned v4u __attribute__((ext_vector_type(4)));
typedef float f32x4 __attribute__((ext_vector_type(4)));
typedef float f32x16 __attribute__((ext_vector_type(16)));
typedef short bf16x8 __attribute__((ext_vector_type(8)));
#define LDS_WAIT() asm volatile("s_waitcnt lgkmcnt(0)" ::: "memory")
__device__ __forceinline__ unsigned f2bf(float f) { unsigned u = __builtin_bit_cast(unsigned, f); return (u + 0x7fffu + ((u >> 16) & 1u)) >> 16; }
__device__ __forceinline__ unsigned pk2(float lo, float hi) { return f2bf(lo) | (f2bf(hi) << 16); }
__device__ __forceinline__ float bflo(unsigned w) { return __builtin_bit_cast(float, w << 16); }
__device__ __forceinline__ float bfhi(unsigned w) { return __builtin_bit_cast(float, w & 0xffff0000u); }
__device__ __forceinline__ float sigm(float v) { return __builtin_amdgcn_rcpf(1.0f + __builtin_amdgcn_exp2f(-1.4426950408889634f * v)); }
__device__ __forceinline__ float wave_sum(float v) {
#pragma unroll
    for (int o = 1; o < 64; o <<= 1) v += __shfl_xor(v, o);
    return v;
}

struct Frame {
    LAS unsigned char* lds;
    int wave, vcu, G;
    const float* in[19]; float* out; unsigned char* ws;
};
enum { I_X = 0, I_PREG, I_POSTG, I_WIN, I_CONVW, I_CONVB, I_WA, I_BA, I_WX, I_BX, I_LRUA, I_LQ1, I_LK1, I_LQ2, I_LK2, I_SUBG, I_WBR, I_WBA, I_WOUT };

__device__ __forceinline__ void p0_transpose_item(const float* W, int K, int N, bf16* WT, LAS float* scr, int item, int lane) {
    const int nblk = N / 32, kb = item / nblk, nb = item % nblk, k0 = 64 * kb, n0 = 32 * nb;
#pragma unroll 8
    for (int i = 0; i < 32; ++i) { const int kk = 2 * i + (lane >> 5); scr[kk * 33 + (lane & 31)] = W[(size_t)(k0 + kk) * N + n0 + (lane & 31)]; }
    LDS_WAIT(); asm volatile("" ::: "memory");
    const int c = lane & 7;
#pragma unroll
    for (int j = 0; j < 4; ++j) { const int n = (lane >> 3) + 8 * j; const LAS float* s = scr + (8 * c) * 33 + n;
        v4u o; o.x = pk2(s[0 * 33], s[1 * 33]); o.y = pk2(s[2 * 33], s[3 * 33]); o.z = pk2(s[4 * 33], s[5 * 33]); o.w = pk2(s[6 * 33], s[7 * 33]);
        *(GAS v4u*)(WT + (size_t)(n0 + n) * K + k0 + 8 * c) = o; }
    LDS_WAIT(); asm volatile("" ::: "memory");
}
__device__ __forceinline__ void p0_prologue(Frame& F) {
    LAS float* scr = (LAS float*)(F.lds + F.wave * 16384);
    const int gw = F.vcu * NWAVES + F.wave, NGW = F.G * NWAVES;
    constexpr int I_BIG = (D / 64) * (NIN / 32), I_SM = (D / 64) * (D / 32);
    constexpr int NITEMS = I_BIG + 3 * I_SM;
    for (int it = gw; it < NITEMS; it += NGW) {
        int r = it;
        if (r < I_BIG) { p0_transpose_item(F.in[I_WIN], D, NIN, (bf16*)(F.ws + WS_WIN), scr, r, lane_id_()); continue; } r -= I_BIG;
        if (r < I_SM) { p0_transpose_item(F.in[I_WBR], D, D, (bf16*)(F.ws + WS_WR), scr, r, lane_id_()); continue; } r -= I_SM;
        if (r < I_SM) { p0_transpose_item(F.in[I_WBA], D, D, (bf16*)(F.ws + WS_WA), scr, r, lane_id_()); continue; } r -= I_SM;
        p0_transpose_item(F.in[I_WOUT], D, D, (bf16*)(F.ws + WS_WO), scr, r, lane_id_());
    }
    const GAS f32x4* gp = (const GAS f32x4*)F.in[I_PREG] + lane_id_();
    f32x4 gg[4];
#pragma unroll
    for (int j = 0; j < 4; ++j) gg[j] = gp[64 * j];
    for (int m = gw; m < M; m += NGW) {
        const GAS f32x4* xr = (const GAS f32x4*)(F.in[I_X] + (size_t)m * D) + lane_id_();
        f32x4 v[4]; float s = 0.f;
#pragma unroll
        for (int j = 0; j < 4; ++j) { v[j] = xr[64 * j]; s += (v[j].x * v[j].x + v[j].y * v[j].y) + (v[j].z * v[j].z + v[j].w * v[j].w); }
        const float rstd = 1.0f / sqrtf(wave_sum(s) * (1.f / D) + NORM_EPS);
        GAS unsigned long long* o8 = (GAS unsigned long long*)((bf16*)(F.ws + WS_U) + (size_t)m * D) + lane_id_();
#pragma unroll
        for (int j = 0; j < 4; ++j) { const f32x4 y = v[j] * rstd * gg[j]; o8[64 * j] = (unsigned long long)pk2(y.x, y.y) | ((unsigned long long)pk2(y.z, y.w) << 32); }
    }
}

constexpr int SC_WFRAG = 0;
constexpr int SC_CONV = 16384;
constexpr int SC_WAVE = 16384 + 2048, SC_WAVE_BYTES = 5120 + 4608;
__device__ __forceinline__ int crow16(int r, int hi) { return (r & 3) + 8 * (r >> 2) + 4 * hi; }
template <bool PASS2> __device__ __forceinline__ void scan_phase(Frame& F) {
    const int lane = lane_id_(), tid_ = F.wave * 64 + lane, r32 = lane & 31, hi = lane >> 5;
    LAS unsigned char* const lw = F.lds + SC_WAVE + F.wave * SC_WAVE_BYTES;
    LAS unsigned char* const lz = lw + 5120;
    const LAS float* const lc = (const LAS float*)(F.lds + SC_CONV);
    const bf16* XR = (const bf16*)(F.ws + WS_XR); bf16* ZR = (bf16*)(F.ws + WS_ZR);
    float* carry = (float*)(F.ws + WS_CARRY);
    for (int wi = F.vcu; wi < BATCH * 16 * 2; wi += F.G) {
        const int b = wi >> 5, g = (wi >> 1) & 15, half = wi & 1, sc = half * 8 + F.wave, c0 = g * 64;
        __syncthreads();
        for (int idx = tid_; idx < 1024; idx += NWAVES * 64) {
            const int mat = idx >> 9, f = (idx >> 6) & 7, kk = f >> 1, nt = f & 1, ln = idx & 63, n = 32 * nt + (ln & 31), kb = 16 * kk + 8 * (ln >> 5);
            const float* W = F.in[mat ? I_WX : I_WA] + (size_t)(g * 64 + kb) * 64 + n;
            v4u o; o.x = pk2(W[0], W[64]); o.y = pk2(W[128], W[192]); o.z = pk2(W[256], W[320]); o.w = pk2(W[384], W[448]);
            *(LAS v4u*)(F.lds + SC_WFRAG + idx * 16) = o;
        }
        if (tid_ < 320) { const int tap = tid_ >> 6, ch = tid_ & 63; ((LAS float*)(F.lds + SC_CONV))[tid_] = (tap < 4) ? F.in[I_CONVW][tap * D + c0 + ch] : F.in[I_CONVB][c0 + ch]; }
        __syncthreads();
        float cba[2], cbx[2], ckc[2], H[2], P[2];
#pragma unroll
        for (int nt = 0; nt < 2; ++nt) { const int c = c0 + 32 * nt + r32; cba[nt] = F.in[I_BA][c]; cbx[nt] = F.in[I_BX][c];
            ckc[nt] = -8.0f * 1.4426950408889634f * log1pf(expf(-F.in[I_LRUA][c])); H[nt] = 0.f; P[nt] = 1.f; }
        if (PASS2) {
            for (int j = 0; j < sc; ++j) {
#pragma unroll
                for (int nt = 0; nt < 2; ++nt) { const float2 ab = *(const float2*)(carry + ((size_t)(b * 16 + j) * D + c0 + 32 * nt + r32) * 2); H[nt] = ab.x * H[nt] + ab.y; }
            }
        }
        bf16x8 idf[4];
#pragma unroll
        for (int kk = 0; kk < 4; ++kk) { const int d = (32 * (kk >> 1) + r32) - (16 * kk + 8 * hi); v4u w;
            w.x = (d == 0 ? 0x3F80u : 0u) | (d == 1 ? 0x3F800000u : 0u); w.y = (d == 2 ? 0x3F80u : 0u) | (d == 3 ? 0x3F800000u : 0u);
            w.z = (d == 4 ? 0x3F80u : 0u) | (d == 5 ? 0x3F800000u : 0u); w.w = (d == 6 ? 0x3F80u : 0u) | (d == 7 ? 0x3F800000u : 0u);
            idf[kk] = __builtin_bit_cast(bf16x8, w); }
        for (int sub = 0; sub < 8; ++sub) {
            const int t0 = sc * 256 + sub * 32;
#pragma unroll
            for (int i = 0; i < 5; ++i) { const int row = i * 8 + (lane >> 3), ch = lane & 7, t = t0 - 3 + row;
                if (row < 35) { v4u v = (v4u){0u, 0u, 0u, 0u}; if (t >= 0) v = *(const GAS v4u*)(XR + (size_t)(b * SEQ + t) * D + c0 + ch * 8);
                    *(LAS v4u*)(lw + row * 144 + ch * 16) = v; } }
            if (PASS2) {
#pragma unroll
                for (int i = 0; i < 4; ++i) { const int row = i * 8 + (lane >> 3), ch = lane & 7;
                    *(LAS v4u*)(lz + row * 144 + ch * 16) = *(const GAS v4u*)(ZR + (size_t)(b * SEQ + t0 + row) * D + c0 + ch * 8); }
            }
            bf16x8 af[4];
#pragma unroll
            for (int kk = 0; kk < 4; ++kk) { const int cb = 16 * kk + 8 * hi;
                f32x4 a0 = *(const LAS f32x4*)(lc + 256 + cb), a1 = *(const LAS f32x4*)(lc + 256 + cb + 4);
#pragma unroll
                for (int tap = 0; tap < 4; ++tap) { const v4u x = *(const LAS v4u*)(lw + (r32 + tap) * 144 + cb * 2);
                    const f32x4 w0 = *(const LAS f32x4*)(lc + tap * 64 + cb), w1 = *(const LAS f32x4*)(lc + tap * 64 + cb + 4);
                    a0[0] += w0[0] * bflo(x.x); a0[1] += w0[1] * bfhi(x.x); a0[2] += w0[2] * bflo(x.y); a0[3] += w0[3] * bfhi(x.y);
                    a1[0] += w1[0] * bflo(x.z); a1[1] += w1[1] * bfhi(x.z); a1[2] += w1[2] * bflo(x.w); a1[3] += w1[3] * bfhi(x.w); }
                v4u w; w.x = pk2(a0[0], a0[1]); w.y = pk2(a0[2], a0[3]); w.z = pk2(a1[0], a1[1]); w.w = pk2(a1[2], a1[3]);
                af[kk] = __builtin_bit_cast(bf16x8, w); }
#pragma unroll
            for (int nt = 0; nt < 2; ++nt) {
                f32x16 accR = {}, accI = {}, accX = {};
#pragma unroll
                for (int kk = 0; kk < 4; ++kk) {
                    const bf16x8 fa = *(const LAS bf16x8*)(F.lds + SC_WFRAG + ((0 * 8 + kk * 2 + nt) * 64 + lane) * 16);
                    const bf16x8 fx = *(const LAS bf16x8*)(F.lds + SC_WFRAG + ((1 * 8 + kk * 2 + nt) * 64 + lane) * 16);
                    accR = __builtin_amdgcn_mfma_f32_32x32x16_bf16(af[kk], fa, accR, 0, 0, 0);
                    accI = __builtin_amdgcn_mfma_f32_32x32x16_bf16(af[kk], fx, accI, 0, 0, 0);
                    if ((kk >> 1) == nt) accX = __builtin_amdgcn_mfma_f32_32x32x16_bf16(af[kk], idf[kk], accX, 0, 0, 0);
                }
                float Ap[16], hl[16], Aq[4], Bq[4];
#pragma unroll
                for (int q = 0; q < 4; ++q) { float pa = 1.f, hh = 0.f;
#pragma unroll
                    for (int j = 0; j < 4; ++j) { const int r = 4 * q + j;
                        const float rg = sigm(accR[r] + cba[nt]), ig = sigm(accI[r] + cbx[nt]);
                        const float a = __builtin_amdgcn_exp2f(ckc[nt] * rg);
                        const float bb = __builtin_amdgcn_sqrtf(fmaxf(1.0f - a * a, 0.f)) * ig * accX[r];
                        hh = a * hh + bb; pa *= a; Ap[r] = pa; hl[r] = hh; }
                    Aq[q] = pa; Bq[q] = hh; }
                float Ao[4], Bo[4];
#pragma unroll
                for (int q = 0; q < 4; ++q) { Ao[q] = __shfl_xor(Aq[q], 32); Bo[q] = __shfl_xor(Bq[q], 32); }
                float ci[4]; float Hc = H[nt], Pc = P[nt]; const bool up = (hi != 0);
#pragma unroll
                for (int q = 0; q < 4; ++q) { const float a0 = up ? Ao[q] : Aq[q], b0 = up ? Bo[q] : Bq[q], a1 = up ? Aq[q] : Ao[q], b1 = up ? Bq[q] : Bo[q];
                    const float mid = a0 * Hc + b0; ci[q] = up ? mid : Hc; Hc = a1 * mid + b1; Pc *= a0 * a1; }
                H[nt] = Hc; P[nt] = Pc;
                if (PASS2) {
#pragma unroll
                    for (int q = 0; q < 4; ++q) {
#pragma unroll
                        for (int j = 0; j < 4; ++j) { const int r = 4 * q + j; const float hv = Ap[r] * ci[q] + hl[r];
                            LAS unsigned short* zp = (LAS unsigned short*)(lz + crow16(r, hi) * 144 + (32 * nt + r32) * 2);
                            const float zs = __builtin_bit_cast(float, (unsigned)(*zp) << 16);
                            *zp = (unsigned short)f2bf(hv * zs); } }
                }
            }
            if (PASS2) {
#pragma unroll
                for (int i = 0; i < 4; ++i) { const int row = i * 8 + (lane >> 3), ch = lane & 7;
                    *(GAS v4u*)(ZR + (size_t)(b * SEQ + t0 + row) * D + c0 + ch * 8) = *(const LAS v4u*)(lz + row * 144 + ch * 16); }
            }
        }
        if (!PASS2) { if (hi == 0) {
#pragma unroll
            for (int nt = 0; nt < 2; ++nt) *(float2*)(carry + ((size_t)(b * 16 + sc) * D + c0 + 32 * nt + r32) * 2) = make_float2(P[nt], H[nt]); } }
    }
    __syncthreads();
}

__device__ __forceinline__ void combine_phase(Frame& F) {
    const int gw = F.vcu * NWAVES + F.wave, NGW = F.G * NWAVES, lane = lane_id_(), hd = lane >> 3, p = lane & 7;
    const float l1 = wave_sum(F.in[I_LQ1][lane] * F.in[I_LK1][lane]), l2 = wave_sum(F.in[I_LQ2][lane] * F.in[I_LK2][lane]);
    const float lam = expf(l1) - expf(l2) + LAM_INIT;
    float gsc[16];
#pragma unroll
    for (int i = 0; i < 16; ++i) gsc[i] = F.in[I_SUBG][p * 16 + i] * (1.0f - LAM_INIT);
    const bf16* OB = (const bf16*)F.out; bf16* ZA = (bf16*)(F.ws + WS_ZA);
    for (int m = gw; m < M; m += NGW) {
        const bf16* ob = OB + (size_t)m * 2048 + hd * 256 + p * 16;
        const v4u a0 = *(const GAS v4u*)ob, a1 = *(const GAS v4u*)(ob + 8), b0 = *(const GAS v4u*)(ob + 128), b1 = *(const GAS v4u*)(ob + 136);
        bf16* zp = ZA + (size_t)m * D + hd * 128 + p * 16;
        const v4u z0 = *(const GAS v4u*)zp, z1 = *(const GAS v4u*)(zp + 8);
        float o[16]; const unsigned aw[8] = {a0.x, a0.y, a0.z, a0.w, a1.x, a1.y, a1.z, a1.w}, bw[8] = {b0.x, b0.y, b0.z, b0.w, b1.x, b1.y, b1.z, b1.w}, zw[8] = {z0.x, z0.y, z0.z, z0.w, z1.x, z1.y, z1.z, z1.w};
        float ss = 0.f;
#pragma unroll
        for (int i = 0; i < 8; ++i) { o[2 * i] = bflo(aw[i]) - lam * bflo(bw[i]); o[2 * i + 1] = bfhi(aw[i]) - lam * bfhi(bw[i]); ss += o[2 * i] * o[2 * i] + o[2 * i + 1] * o[2 * i + 1]; }
        ss += __shfl_xor(ss, 1); ss += __shfl_xor(ss, 2); ss += __shfl_xor(ss, 4);
        const float rstd = 1.0f / sqrtf(ss * (1.f / 128.f) + NORM_EPS);
        unsigned yw[8];
#pragma unroll
        for (int i = 0; i < 8; ++i) yw[i] = pk2(o[2 * i] * rstd * gsc[2 * i] * bflo(zw[i]), o[2 * i + 1] * rstd * gsc[2 * i + 1] * bfhi(zw[i]));
        *(GAS v4u*)zp = (v4u){yw[0], yw[1], yw[2], yw[3]}; *(GAS v4u*)(zp + 8) = (v4u){yw[4], yw[5], yw[6], yw[7]};
    }
}

__device__ __forceinline__ void final_phase(Frame& F) {
    const int gw = F.vcu * NWAVES + F.wave, NGW = F.G * NWAVES, lane = lane_id_();
    const float* stats = (const float*)(F.ws + WS_STATS);
    f32x4 gg[4];
#pragma unroll
    for (int j = 0; j < 4; ++j) gg[j] = ((const GAS f32x4*)F.in[I_POSTG])[lane + 64 * j];
    for (int m = gw; m < M; m += NGW) {
        float s = stats[(size_t)m * 16 + (lane & 15)];
        s += __shfl_xor(s, 1); s += __shfl_xor(s, 2); s += __shfl_xor(s, 4); s += __shfl_xor(s, 8);
        const float rstd = 1.0f / sqrtf(s * (1.f / D) + NORM_EPS);
        GAS f32x4* yp = (GAS f32x4*)(F.out + (size_t)m * D) + lane; const GAS f32x4* xp = (const GAS f32x4*)(F.in[I_X] + (size_t)m * D) + lane;
#pragma unroll
        for (int j = 0; j < 4; ++j) { const f32x4 y = yp[64 * j], x = xp[64 * j]; yp[64 * j] = x + y * rstd * gg[j]; }
    }
}

struct Args { const float* in[19]; float* out; unsigned char* ws; int ph_lo, ph_hi; };
__global__ void __launch_bounds__(NWAVES * 64, 2) fwd_kernel(Args args) {
    extern __shared__ __attribute__((aligned(16))) unsigned char lds[];
    cg::grid_group grid = cg::this_grid();
    Frame F;
    F.lds = (LAS unsigned char*)lds;
    F.wave = __builtin_amdgcn_readfirstlane((int)threadIdx.x >> 6);
    F.G = gridDim.x; { const int bx = blockIdx.x; F.vcu = (F.G % 8 == 0) ? (bx % 8) * (F.G / 8) + bx / 8 : bx; }
#pragma unroll
    for (int i = 0; i < 19; ++i) F.in[i] = args.in[i];
    F.out = args.out; F.ws = args.ws;
    unsigned char* ws = args.ws;
    const int lo = args.ph_lo, hi = args.ph_hi;
#define IN(k) (lo <= (k) && (k) < hi)
    const bool lane0w0 = (F.wave == 0) && (lane_id_() == 0);
    if (lane0w0) { ((volatile LAS unsigned*)(F.lds + MISC_OFF))[0] = 0u; ((volatile LAS unsigned*)(F.lds + MISC_OFF))[1] = 0u; }
    __syncthreads();
    XcdBarrier bar = xcd_barrier_post((unsigned*)(ws + WS_CTL) + 1024, (volatile LAS unsigned*)(F.lds + MISC_OFF), lane0w0);
#define SEAM(k) do { if (IN(k) && IN((k) + 1)) { if ((k) == 0) { __syncthreads(); grid.sync(); } else { xcd_barrier(bar, (F.wave == 0) && (lane_id_() == 0)); } } } while (0)

    if (IN(0)) { p0_prologue(F); }
    SEAM(0);
    if (IN(1)) {
        pg8::Gemm g{(const pg8::bf16_t*)(ws + WS_U), (const pg8::bf16_t*)(ws + WS_WIN), M, 6144, D}; pg8::StaticOrder S; S.init(M, 6144, F.G, (int)blockIdx.x);
        pg8::EpiSplit E{(pg8::bf16_t*)(ws + WS_XR), SLOT / 2, 0x100310u, attn_body::C2};
        pg8::gemm_phase<pg8::EpiSplit, pg8::StaticOrder, PG8_ALIGN, PG8_SP2>(F.lds, g, S, E, F.wave);
    }
    SEAM(1);
    if (IN(2)) {
        scan_phase<false>(F);
        const attn_body::AttnTensors AT{(const attn_body::bf16*)(ws + WS_Q), (const attn_body::bf16*)(ws + WS_K), (const attn_body::bf16*)(ws + WS_V), (attn_body::bf16*)F.out};
        const attn_body::StaticOrder AS(F.vcu, F.G); attn_body::attn_phase<attn_body::StaticOrder>((char*)lds, AT, AS, F.wave);
    }
    SEAM(2);
    if (IN(3)) {
        { pg8::Gemm g{(const pg8::bf16_t*)(ws + WS_U), (const pg8::bf16_t*)(ws + WS_WIN) + (size_t)6144 * D, M, 2048, D}; pg8::StaticOrder S; S.init(M, 2048, F.G, (int)blockIdx.x);
          pg8::EpiSplit E{(pg8::bf16_t*)(ws + WS_Q), SLOT / 2, 0x22u, 1.0f};
          pg8::gemm_phase<pg8::EpiSplit, pg8::StaticOrder, PG8_ALIGN, PG8_SP2>(F.lds, g, S, E, F.wave); }
        scan_phase<true>(F);
        combine_phase(F);
    }
    SEAM(3);
    if (IN(4)) {
        { pg8::Gemm g{(const pg8::bf16_t*)(ws + WS_ZR), (const pg8::bf16_t*)(ws + WS_WR), M, D, D}; pg8::StaticOrder S; S.init(M, D, F.G, (int)blockIdx.x);
          pg8::EpiGate<false> E{(const pg8::bf16_t*)(ws + WS_Q), (pg8::bf16_t*)(ws + WS_V)};
          pg8::gemm_phase<pg8::EpiGate<false>, pg8::StaticOrder, PG8_ALIGN, PG8_SP2>(F.lds, g, S, E, F.wave); }
        { pg8::Gemm g{(const pg8::bf16_t*)(ws + WS_ZA), (const pg8::bf16_t*)(ws + WS_WA), M, D, D}; pg8::StaticOrder S; S.init(M, D, F.G, (int)blockIdx.x);
          pg8::EpiGate<true> E{(const pg8::bf16_t*)(ws + WS_K), (pg8::bf16_t*)(ws + WS_V)};
          pg8::gemm_phase<pg8::EpiGate<true>, pg8::StaticOrder, PG8_ALIGN, PG8_SP2>(F.lds, g, S, E, F.wave); }
    }
    SEAM(4);
    if (IN(5)) {
        pg8::Gemm g{(const pg8::bf16_t*)(ws + WS_V), (const pg8::bf16_t*)(ws + WS_WO), M, D, D}; pg8::StaticOrder S; S.init(M, D, F.G, (int)blockIdx.x);
        pg8::EpiF32Stats E{F.out, (float*)(ws + WS_STATS)};
        pg8::gemm_phase<pg8::EpiF32Stats, pg8::StaticOrder, PG8_ALIGN, PG8_SP2>(F.lds, g, S, E, F.wave);
    }
    SEAM(5);
    if (IN(6)) { final_phase(F); }
#undef IN
#undef SEAM
}

extern "C" void kernel_launch(void* const* d_in, const int* in_sizes, int n_in, void* d_out, int out_size, void* d_ws, size_t ws_size, hipStream_t stream) {
    static int grid = 0;
    if (grid == 0) {
        if (n_in != 19 || in_sizes[0] != M * D || out_size != M * D || ws_size < WS_END) { fprintf(stderr, "kernel_launch: unexpected shapes (n_in %d, in0 %d, out %d, ws %zu)\n", n_in, n_in > 0 ? in_sizes[0] : -1, out_size, ws_size); grid = -1; return; }
        int dev = 0, cus = 0, per_cu = 0;
        if (hipGetDevice(&dev) != hipSuccess || hipDeviceGetAttribute(&cus, hipDeviceAttributeMultiprocessorCount, dev) != hipSuccess) { grid = -1; return; }
        if (hipFuncSetAttribute((const void*)fwd_kernel, hipFuncAttributeMaxDynamicSharedMemorySize, LDS_BYTES) != hipSuccess) { fprintf(stderr, "kernel_launch: hipFuncSetAttribute failed\n"); grid = -1; return; }
        if (hipOccupancyMaxActiveBlocksPerMultiprocessor(&per_cu, (const void*)fwd_kernel, NWAVES * 64, LDS_BYTES) != hipSuccess || per_cu < 1) { fprintf(stderr, "kernel_launch: occupancy query says %d\n", per_cu); (void)hipGetLastError(); grid = -1; return; }
        grid = cus;
    }
    if (grid < 0) return;
    if (hipMemsetAsync((char*)d_ws + WS_CTL, 0, CTL_ZERO_BYTES, stream) != hipSuccess) { fprintf(stderr, "kernel_launch: hipMemsetAsync failed\n"); return; }
    Args a{};
    for (int i = 0; i < 19; ++i) a.in[i] = (const float*)d_in[i];
    a.out = (float*)d_out; a.ws = (unsigned char*)d_ws; a.ph_lo = 0; a.ph_hi = 7;
    void* kargs[] = {&a};
    const hipError_t e = hipLaunchCooperativeKernel((const void*)fwd_kernel, dim3(grid), dim3(NWAVES * 64), kargs, LDS_BYTES, stream);
    if (e != hipSuccess) fprintf(stderr, "kernel_launch: cooperative launch failed: %s (grid %d)\n", hipGetErrorString(e), grid);
}
```

```cpp
#include <hip/hip_runtime.h>
#include <hip/hip_cooperative_groups.h>
#include <cstdio>
#include <cstdint>
__device__ __forceinline__ int lane_id_() { return (int)__builtin_amdgcn_mbcnt_hi(~0u, __builtin_amdgcn_mbcnt_lo(~0u, 0u)); }
namespace pg8 {
#define PG8_LAS __attribute__((address_space(3)))
typedef unsigned short bf16_t;
typedef short bf16x8 __attribute__((ext_vector_type(8)));
typedef float f32x4 __attribute__((ext_vector_type(4)));
typedef unsigned u32x4 __attribute__((ext_vector_type(4)));
constexpr int BM = 256, BK = 64, HALF = 128, HTB = HALF * BK * 2  , STAGE_BYTES = 8 * HTB, NXCD = 8, WGM = 8;

__host__ __device__ __forceinline__ int lds_byte(int r, int c) { const int st = (r >> 4) * 2 + (c >> 5), rr = r & 15, cc = c & 31, ob = rr * 64 + cc * 2; return st * 1024 + (ob ^ (((ob >> 9) & 1) << 5)); }
__host__ __device__ __forceinline__ void stage_rc(int b, int& R, int& C) { const int st = b / 1024, sb = b % 1024, swz = sb ^ (((sb >> 9) & 1) << 5); R = (st >> 1) * 16 + swz / 64; C = (st & 1) * 32 + (swz % 64) / 2; }
__host__ __device__ __forceinline__ int perm32(int rho) { const int n = rho >> 4, i = rho & 15; return 8 * (i >> 2) + 4 * n + (i & 3); }

struct Unit { int pm, pn; };
struct Gemm { const bf16_t* A; const bf16_t* Bt; int M, N, K; };

struct StaticOrder {
    int nM, nN, nwg, G, c;
    __host__ __device__ void init(int M, int N, int G_, int c_) { nM = M / BM; nN = N / BM; nwg = nM * nN; G = G_; c = c_; }
    __host__ __device__ bool next(int i, Unit& u) const {
        const long L = (long)i * G + c; if (L >= nwg) return false;
        int wgid = (int)L; { const int q = nwg / NXCD, r = nwg % NXCD, xcd = wgid % NXCD, off = wgid / NXCD; wgid = (xcd < r ? xcd * (q + 1) : r * (q + 1) + (xcd - r) * q) + off; }
        const int nig = WGM * nN, gid = wgid / nig, fm = gid * WGM, gsz = (nM - fm) < WGM ? (nM - fm) : WGM;
        u.pm = fm + ((wgid % nig) % gsz); u.pn = (wgid % nig) / gsz; return true;
    }
    __device__ __forceinline__ void a_ready(const Unit&) const {}
    __device__ __forceinline__ void done(const Unit&) const {}
};

__device__ __forceinline__ unsigned cvt_pk_bf16(float lo, float hi) { unsigned r; asm volatile("v_cvt_pk_bf16_f32 %0, %1, %2" : "=v"(r) : "v"(lo), "v"(hi)); return r; }
typedef float f32x2 __attribute__((ext_vector_type(2)));
__device__ __forceinline__ float bf_lo(unsigned w) { return __builtin_bit_cast(float, w << 16); }
__device__ __forceinline__ float bf_hi(unsigned w) { return __builtin_bit_cast(float, w & 0xffff0000u); }
__device__ __forceinline__ float sigmoid_f(float v) { return __builtin_amdgcn_rcpf(1.0f + __builtin_amdgcn_exp2f(-1.4426950408889634f * v)); }
struct EpiSplit {
    static constexpr bool PERM = true, AFTER_DRAIN = false;
    bf16_t* O; size_t split_stride; unsigned acts; float scl;
    __device__ __forceinline__ void operator()(const f32x4 (&acc)[2][2][4][2], const Unit& u, int wr, int wc, int fr, int fq) const {
        const int row0 = u.pm * BM + wr * 64 + fr; int colt = u.pn * BM; const int t = colt >> 10; bf16_t* base = O + (size_t)t * split_stride; colt -= t << 10;
        const int act = (int)((acts >> (4 * t)) & 15u);
        const int col0 = colt + wc * 32 + 8 * fq;
#pragma unroll
        for (int ai = 0; ai < 2; ++ai)
#pragma unroll
            for (int m = 0; m < 4; ++m) { bf16_t* rowp = base + (size_t)(row0 + ai * HALF + m * 16) * 1024 + col0;
#pragma unroll
                for (int bj = 0; bj < 2; ++bj) { f32x4 v0 = acc[ai][bj][m][0], v1 = acc[ai][bj][m][1];
                    if (act == 1) {
#pragma unroll
                        for (int e = 0; e < 4; ++e) { v0[e] = v0[e] * sigmoid_f(v0[e]); v1[e] = v1[e] * sigmoid_f(v1[e]); }
                    } else if (act == 2) {
#pragma unroll
                        for (int e = 0; e < 4; ++e) { v0[e] = sigmoid_f(v0[e]); v1[e] = sigmoid_f(v1[e]); }
                    } else if (act == 3) { v0 = v0 * scl; v1 = v1 * scl; }
                    u32x4 w; w.x = cvt_pk_bf16(v0[0], v0[1]); w.y = cvt_pk_bf16(v0[2], v0[3]); w.z = cvt_pk_bf16(v1[0], v1[1]); w.w = cvt_pk_bf16(v1[2], v1[3]);
                    *(u32x4*)(rowp + bj * HALF) = w; } }
    }
};
template <bool ACCUM> struct EpiGate {
    static constexpr bool PERM = true, AFTER_DRAIN = false;
    const bf16_t* G; bf16_t* Mb;
    __device__ __forceinline__ void operator()(const f32x4 (&acc)[2][2][4][2], const Unit& u, int wr, int wc, int fr, int fq) const {
        const int row0 = u.pm * BM + wr * 64 + fr, col0 = u.pn * BM + wc * 32 + 8 * fq;
#pragma unroll
        for (int ai = 0; ai < 2; ++ai)
#pragma unroll
            for (int m = 0; m < 4; ++m) { const size_t off = (size_t)(row0 + ai * HALF + m * 16) * 1024 + col0;
#pragma unroll
                for (int bj = 0; bj < 2; ++bj) { const f32x4 a0 = acc[ai][bj][m][0], a1 = acc[ai][bj][m][1];
                    const u32x4 g = *(const u32x4*)(G + off + bj * HALF);
                    f32x4 v0, v1;
                    v0[0] = bf_lo(g.x) * a0[0]; v0[1] = bf_hi(g.x) * a0[1]; v0[2] = bf_lo(g.y) * a0[2]; v0[3] = bf_hi(g.y) * a0[3];
                    v1[0] = bf_lo(g.z) * a1[0]; v1[1] = bf_hi(g.z) * a1[1]; v1[2] = bf_lo(g.w) * a1[2]; v1[3] = bf_hi(g.w) * a1[3];
                    if (ACCUM) { const u32x4 o = *(const u32x4*)(Mb + off + bj * HALF);
                        v0[0] += bf_lo(o.x); v0[1] += bf_hi(o.x); v0[2] += bf_lo(o.y); v0[3] += bf_hi(o.y);
                        v1[0] += bf_lo(o.z); v1[1] += bf_hi(o.z); v1[2] += bf_lo(o.w); v1[3] += bf_hi(o.w); }
                    u32x4 w; w.x = cvt_pk_bf16(v0[0], v0[1]); w.y = cvt_pk_bf16(v0[2], v0[3]); w.z = cvt_pk_bf16(v1[0], v1[1]); w.w = cvt_pk_bf16(v1[2], v1[3]);
                    *(u32x4*)(Mb + off + bj * HALF) = w; } }
    }
};
struct EpiF32Stats {
    static constexpr bool PERM = false, AFTER_DRAIN = false;
    float* Y; float* stats;
    __device__ __forceinline__ void operator()(const f32x4 (&acc)[2][2][4][2], const Unit& u, int wr, int wc, int fr, int fq) const {
        const int col0 = u.pn * BM + wc * 32 + 4 * fq;
#pragma unroll
        for (int ai = 0; ai < 2; ++ai)
#pragma unroll
            for (int m = 0; m < 4; ++m) { const int r = u.pm * BM + ai * HALF + wr * 64 + m * 16 + fr; const size_t off = (size_t)r * 1024 + col0; float s = 0.f;
#pragma unroll
                for (int bj = 0; bj < 2; ++bj)
#pragma unroll
                    for (int n = 0; n < 2; ++n) { const f32x4 x = acc[ai][bj][m][n]; *(f32x4*)(Y + off + bj * HALF + n * 16) = x; s += (x[0] * x[0] + x[1] * x[1]) + (x[2] * x[2] + x[3] * x[3]); }
                s += __shfl_xor(s, 16); s += __shfl_xor(s, 32);
                if (fq == 0) stats[(size_t)r * 16 + u.pn * 4 + wc] = s; }
    }
};
template <class Epi, class Sched, bool ALIGN_EPI = false, bool SP2 = false>
__device__ __forceinline__ void gemm_phase(PG8_LAS unsigned char* lds, const Gemm g, const Sched& S, const Epi& E, const int wave_) {
    const int lane = lane_id_(), wid = wave_, tid = wid * 64 + lane, wr = wid >> 2, wc = wid & 3, fr = lane & 15, fq = lane >> 4;
    const int K = g.K, nt = K / BK;
    unsigned voffA[2], voffB[2];
#pragma unroll
    for (int i = 0; i < 2; ++i) { int R, C; stage_rc(tid * 16 + i * 8192, R, C); const int Rb = Epi::PERM ? ((R & ~31) + perm32(R & 31)) : R;
        voffA[i] = (unsigned)(R * K + C) * 2u; voffB[i] = (unsigned)(Rb * K + C) * 2u; }
    const size_t kstep = (size_t)(BK * 2);
    const size_t hstep = (size_t)HALF * K * 2;
    const size_t tstep = 2 * hstep;
    const unsigned ldsw = (unsigned)wid * 1024u;
    const int aoff = lds_byte(wr * 64 + fr, fq * 8), boff = lds_byte(wc * 32 + fr, fq * 8);
#define PG8_SA(b, h) (((b) * 2 + (h)) * HTB)
#define PG8_SB(b, h) ((4 + (b) * 2 + (h)) * HTB)
#define PG8_STAGE(bufoff, gbase, voff) do { _Pragma("unroll") for (int _i = 0; _i < 2; ++_i) \
        __builtin_amdgcn_global_load_lds((const unsigned*)((const char*)(gbase) + (voff)[_i]), (PG8_LAS unsigned*)(lds + (bufoff) + ldsw + _i * 8192), 16, 0, 0); } while (0)
#define PG8_LDA(dst, b, h) do { _Pragma("unroll") for (int m = 0; m < 4; ++m) _Pragma("unroll") for (int k = 0; k < 2; ++k) dst[m][k] = *(const PG8_LAS bf16x8*)(lds + PG8_SA(b, h) + aoff + m * 2048 + k * 1024); } while (0)
#define PG8_LDB(dst, b, h) do { _Pragma("unroll") for (int n = 0; n < 2; ++n) _Pragma("unroll") for (int k = 0; k < 2; ++k) dst[n][k] = *(const PG8_LAS bf16x8*)(lds + PG8_SB(b, h) + boff + n * 2048 + k * 1024); } while (0)
#define PG8_MMA(ai, bj, At, Bt) do { __builtin_amdgcn_s_setprio(1); _Pragma("unroll") for (int m = 0; m < 4; ++m) _Pragma("unroll") for (int n = 0; n < 2; ++n) _Pragma("unroll") for (int k = 0; k < 2; ++k) \
        acc[ai][bj][m][n] = __builtin_amdgcn_mfma_f32_16x16x32_bf16(Bt[n][k], At[m][k], acc[ai][bj][m][n], 0, 0, 0); __builtin_amdgcn_s_setprio(0); } while (0)
#define PG8_WAIT_V(n) asm volatile("s_waitcnt vmcnt(" #n ")" ::: "memory")
#define PG8_WAIT_L(n) asm volatile("s_waitcnt lgkmcnt(" #n ")" ::: "memory")
#define PG8_BAR __builtin_amdgcn_s_barrier()
#define PG8_SCHED __builtin_amdgcn_sched_barrier(0)
    Unit cur, nxt; int ui = 0;
    if (!S.next(0, cur)) return;
    f32x4 acc[2][2][4][2];
#pragma unroll
    for (int a = 0; a < 2; ++a)
#pragma unroll
        for (int b = 0; b < 2; ++b)
#pragma unroll
            for (int m = 0; m < 4; ++m)
#pragma unroll
                for (int n = 0; n < 2; ++n) acc[a][b][m][n] = (f32x4){0.f, 0.f, 0.f, 0.f};
    bf16x8 At[4][2], B0[2][2], B1[2][2];
    const char* cA = (const char*)g.A + (size_t)cur.pm * tstep; const char* cB = (const char*)g.Bt + (size_t)cur.pn * tstep;
    S.a_ready(cur);
    if constexpr (SP2) {
        PG8_STAGE(PG8_SB(0, 0), cB, voffB); PG8_STAGE(PG8_SB(0, 1), cB + hstep, voffB); PG8_STAGE(PG8_SA(0, 0), cA, voffA); PG8_STAGE(PG8_SA(0, 1), cA + hstep, voffA);
        if (wr == 1) PG8_BAR;
        PG8_WAIT_V(2); PG8_BAR;
        PG8_STAGE(PG8_SB(1, 0), cB + kstep, voffB); PG8_STAGE(PG8_SA(1, 0), cA + kstep, voffA); PG8_STAGE(PG8_SB(1, 1), cB + hstep + kstep, voffB);
        PG8_WAIT_V(6); PG8_BAR;
    } else {
        PG8_STAGE(PG8_SB(0, 0), cB, voffB); PG8_STAGE(PG8_SA(0, 0), cA, voffA); PG8_STAGE(PG8_SB(0, 1), cB + hstep, voffB); PG8_STAGE(PG8_SA(0, 1), cA + hstep, voffA);
        if (wr == 1) PG8_BAR;
        PG8_WAIT_V(4); PG8_BAR;
        PG8_STAGE(PG8_SB(1, 0), cB + kstep, voffB); PG8_STAGE(PG8_SA(1, 0), cA + kstep, voffA); PG8_STAGE(PG8_SB(1, 1), cB + hstep + kstep, voffB);
        PG8_WAIT_V(6); PG8_BAR;
    }
    for (;;) {
        const bool has_next = S.next(ui + 1, nxt);
        const char* nA = has_next ? (const char*)g.A + (size_t)nxt.pm * tstep : cA; const char* nB = has_next ? (const char*)g.Bt + (size_t)nxt.pn * tstep : cB;
        for (int t = 0; t < nt; t += 2) {
            const bool last = (t == nt - 2);
            const char* a1 = cA + (size_t)(t + 1) * kstep;
            const char* a2 = last ? nA : cA + (size_t)(t + 2) * kstep; const char* b2 = last ? nB : cB + (size_t)(t + 2) * kstep;
            const char* a3 = a2 + kstep; const char* b3 = b2 + kstep;
            if (last && has_next) S.a_ready(nxt);
            if constexpr (SP2) {
            PG8_LDB(B0, 0, 0); PG8_LDB(B1, 0, 1); PG8_SCHED; PG8_LDA(At, 0, 0); PG8_STAGE(PG8_SA(1, 1), a1 + hstep, voffA);
            PG8_WAIT_V(8); PG8_WAIT_L(0); PG8_BAR; PG8_MMA(0, 0, At, B0); PG8_MMA(0, 1, At, B1); PG8_BAR; PG8_SCHED;
            PG8_LDA(At, 0, 1); PG8_STAGE(PG8_SB(0, 0), b2, voffB); PG8_STAGE(PG8_SB(0, 1), b2 + hstep, voffB); PG8_STAGE(PG8_SA(0, 0), a2, voffA);
            PG8_WAIT_V(8); PG8_WAIT_L(0); PG8_BAR; PG8_MMA(1, 0, At, B0); PG8_MMA(1, 1, At, B1); PG8_BAR; PG8_SCHED;
            PG8_LDB(B0, 1, 0); PG8_LDB(B1, 1, 1); PG8_SCHED; PG8_LDA(At, 1, 0); PG8_STAGE(PG8_SA(0, 1), a2 + hstep, voffA);
            PG8_WAIT_V(8); PG8_WAIT_L(0); PG8_BAR; PG8_MMA(0, 0, At, B0); PG8_MMA(0, 1, At, B1); PG8_BAR; PG8_SCHED;
            PG8_LDA(At, 1, 1); PG8_STAGE(PG8_SB(1, 0), b3, voffB); PG8_STAGE(PG8_SB(1, 1), b3 + hstep, voffB); PG8_STAGE(PG8_SA(1, 0), a3, voffA);
            PG8_WAIT_V(8); PG8_WAIT_L(0); PG8_BAR; PG8_MMA(1, 0, At, B0); PG8_MMA(1, 1, At, B1); PG8_BAR; PG8_SCHED;
            } else {
            PG8_LDB(B0, 0, 0); PG8_SCHED; PG8_LDA(At, 0, 0); PG8_STAGE(PG8_SA(1, 1), a1 + hstep, voffA);
            PG8_WAIT_L(8); PG8_BAR; PG8_WAIT_L(0); PG8_MMA(0, 0, At, B0); PG8_BAR; PG8_SCHED;
            PG8_LDB(B1, 0, 1); PG8_STAGE(PG8_SB(0, 0), b2, voffB);
            PG8_BAR; PG8_WAIT_L(0); PG8_MMA(0, 1, At, B1); PG8_BAR;
            PG8_LDA(At, 0, 1); PG8_STAGE(PG8_SA(0, 0), a2, voffA);
            PG8_BAR; PG8_WAIT_L(0); PG8_MMA(1, 0, At, B0); PG8_BAR; PG8_SCHED;
            PG8_STAGE(PG8_SB(0, 1), b2 + hstep, voffB);
            PG8_WAIT_V(6); PG8_BAR; PG8_MMA(1, 1, At, B1); PG8_BAR;
            PG8_LDB(B0, 1, 0); PG8_SCHED; PG8_LDA(At, 1, 0); PG8_STAGE(PG8_SA(0, 1), a2 + hstep, voffA);
            PG8_WAIT_L(8); PG8_BAR; PG8_WAIT_L(0); PG8_MMA(0, 0, At, B0); PG8_BAR; PG8_SCHED;
            PG8_LDB(B1, 1, 1); PG8_STAGE(PG8_SB(1, 0), b3, voffB);
            PG8_BAR; PG8_WAIT_L(0); PG8_MMA(0, 1, At, B1); PG8_BAR;
            PG8_LDA(At, 1, 1); PG8_STAGE(PG8_SA(1, 0), a3, voffA);
            PG8_BAR; PG8_WAIT_L(0); PG8_MMA(1, 0, At, B0); PG8_BAR; PG8_SCHED;
            PG8_STAGE(PG8_SB(1, 1), b3 + hstep, voffB);
            PG8_WAIT_V(6); PG8_BAR; PG8_MMA(1, 1, At, B1); PG8_BAR;
            }
        }
        if constexpr (ALIGN_EPI) { if (wr == 0) PG8_BAR; }
        if constexpr (!Epi::AFTER_DRAIN) { E(acc, cur, wr, wc, fr, fq); S.done(cur); }
        if (!has_next) break;
#pragma unroll
        for (int a = 0; a < 2; ++a)
#pragma unroll
            for (int b = 0; b < 2; ++b)
#pragma unroll
                for (int m = 0; m < 4; ++m)
#pragma unroll
                    for (int n = 0; n < 2; ++n) acc[a][b][m][n] = (f32x4){0.f, 0.f, 0.f, 0.f};
        cur = nxt; cA = nA; cB = nB; ++ui;
        if constexpr (ALIGN_EPI) { if (wr == 1) PG8_BAR; }
    }
    PG8_WAIT_V(0);
    if constexpr (!ALIGN_EPI) { if (wr == 0) PG8_BAR; }
    PG8_BAR;
    if constexpr (Epi::AFTER_DRAIN) { E.fused(acc, cur, wr, wc, fr, fq, lds, wid, lane); S.done(cur); }
#undef PG8_SA
#undef PG8_SB
#undef PG8_STAGE
#undef PG8_LDA
#undef PG8_LDB
#undef PG8_MMA
#undef PG8_WAIT_V
#undef PG8_WAIT_L
#undef PG8_BAR
#undef PG8_SCHED
}
}

#ifndef PG8_SP2
#define PG8_SP2 true
#endif
#ifndef PG8_ALIGN
#define PG8_ALIGN true
#endif
#include <hip/hip_bf16.h>
#include <cmath>
#include <hip/hip_bf16.h>
#include <cmath>
namespace attn_body {
using bf16=__hip_bfloat16;
using bf16x8=__attribute__((ext_vector_type(8)))short;
using s16x4=__attribute__((ext_vector_type(4)))short;
using f32x16=__attribute__((ext_vector_type(16)))float;
using u32x4=__attribute__((ext_vector_type(4)))unsigned;
constexpr int BATCH=8,NHEAD=16,SEQ=4096,D=64,DM=NHEAD*D,OPITCH=2048;
constexpr int NW=8,QBLK=32,QB=QBLK*NW,KVBLK=64,NQB=SEQ/QB;
constexpr int ATTN_PITCH=DM, ATTN_UNIT_ROWS=QB;
__device__ __forceinline__ int crow(int r,int hi){return (r&3)+8*(r>>2)+4*hi;}
#define SBAR() __builtin_amdgcn_sched_barrier(0)
__device__ __forceinline__ void cmask(f32x16&p0,f32x16&p1,int jb,int qrel,int hi){
  const float NEG=-INFINITY; int kb=64*jb+4*hi;
  #pragma unroll
  for(int r=0;r<16;++r){int kv=kb+(r&3)+8*(r>>2); if(kv>qrel)p0[r]=NEG; if(kv+32>qrel)p1[r]=NEG;}
}

constexpr int NSLOT=3, SLOTB=8192;
constexpr int LDS_K=0, LDS_V=NSLOT*SLOTB, LDS_WS=2*NSLOT*SLOTB, LDS_OST=LDS_WS+NW*64*4, LDS_BYTES=LDS_OST+NW*4096;
constexpr float C2=0.125f*1.4426950408889634f;
__device__ __forceinline__ void glds16(const void*gsrc,unsigned lds_dst){unsigned keep;
  asm volatile("s_mov_b32 %0, m0\n\ts_mov_b32 m0, %2\n\ts_nop 0\n\tglobal_load_lds_dwordx4 %1, off\n\ts_mov_b32 m0, %0":"=&s"(keep):"v"(gsrc),"s"(lds_dst):"memory");}
__device__ __forceinline__ float max3f(float a,float b,float c){float r;asm("v_max3_f32 %0, %1, %2, %3":"=v"(r):"v"(a),"v"(b),"v"(c));return r;}
__device__ __forceinline__ float max2f(float a,float b){float r;asm("v_max_f32_e32 %0, %1, %2":"=v"(r):"v"(a),"v"(b));return r;}
__device__ __forceinline__ float fadd_s(float a,float b){float r;asm("v_add_f32_e32 %0, %1, %2":"=v"(r):"v"(a),"v"(b));return r;}
__device__ __forceinline__ float fsub_s(float a,float b){float r;asm("v_sub_f32_e32 %0, %1, %2":"=v"(r):"v"(a),"v"(b));return r;}
typedef float f32x2_t __attribute__((ext_vector_type(2))); typedef __bf16 bf16x2_t __attribute__((ext_vector_type(2)));
__device__ __forceinline__ unsigned cvtpk_s(float lo,float hi){f32x2_t v={lo,hi};bf16x2_t b=__builtin_convertvector(v,bf16x2_t);return __builtin_bit_cast(unsigned,b);}
#define WAIT_BAR(N) asm volatile("s_waitcnt vmcnt(" #N ") lgkmcnt(0)\n\ts_barrier":::"memory")

__device__ __forceinline__ void qkt(f32x16&p0,f32x16&p1,const char*Kslot,const bf16x8*qr,const f32x16&negm,int r32,int hi){
  const char*kb=Kslot+hi*1024+r32*16;
  #pragma unroll
  for(int d0=0;d0<4;++d0){
    const bf16x8 b0=*reinterpret_cast<const bf16x8*>(kb+d0*2048);
    const bf16x8 b1=*reinterpret_cast<const bf16x8*>(kb+d0*2048+512);
    if(d0==0){p0=__builtin_amdgcn_mfma_f32_32x32x16_bf16(b0,qr[0],negm,0,0,0);p1=__builtin_amdgcn_mfma_f32_32x32x16_bf16(b1,qr[0],negm,0,0,0);}
    else{p0=__builtin_amdgcn_mfma_f32_32x32x16_bf16(b0,qr[d0],p0,0,0,0);p1=__builtin_amdgcn_mfma_f32_32x32x16_bf16(b1,qr[d0],p1,0,0,0);}}
}
typedef __attribute__((address_space(3))) const char* lds_cptr;
typedef short v4i16_t __attribute__((ext_vector_type(4)));
__device__ __forceinline__ void kload8(bf16x8*kf,lds_cptr kp){
  kf[0]=*(const __attribute__((address_space(3))) bf16x8*)(kp);      kf[1]=*(const __attribute__((address_space(3))) bf16x8*)(kp+512);
  kf[2]=*(const __attribute__((address_space(3))) bf16x8*)(kp+2048); kf[3]=*(const __attribute__((address_space(3))) bf16x8*)(kp+2560);
  kf[4]=*(const __attribute__((address_space(3))) bf16x8*)(kp+4096); kf[5]=*(const __attribute__((address_space(3))) bf16x8*)(kp+4608);
  kf[6]=*(const __attribute__((address_space(3))) bf16x8*)(kp+6144); kf[7]=*(const __attribute__((address_space(3))) bf16x8*)(kp+6656);
}
__device__ __forceinline__ void kload2(bf16x8*kf,lds_cptr kp,int j){ kf[2*j]=*(const __attribute__((address_space(3))) bf16x8*)(kp+j*2048); kf[2*j+1]=*(const __attribute__((address_space(3))) bf16x8*)(kp+j*2048+512); }
__device__ __forceinline__ s16x4 vtr(lds_cptr p){ return __builtin_bit_cast(s16x4,__builtin_amdgcn_ds_read_tr16_b64_v4i16((__attribute__((address_space(3))) v4i16_t*)p)); }
__device__ __forceinline__ float rowmax(const f32x16&p0,const f32x16&p1){
  float a=max3f(p0[0],p0[1],p1[0]),b=max3f(p0[2],p0[3],p1[1]);a=max3f(a,p1[2],p1[3]);
  #pragma unroll
  for(int r=4;r<16;r+=4){a=max3f(a,p0[r],p0[r+1]);b=max3f(b,p0[r+2],p0[r+3]);a=max3f(a,p1[r],p1[r+1]);b=max3f(b,p1[r+2],p1[r+3]);}
  const float m=max2f(a,b);
  auto rr=__builtin_amdgcn_permlane32_swap(__float_as_uint(m),__float_as_uint(m),false,false);
  return max2f(__uint_as_float(rr[0]),__uint_as_float(rr[1]));
}
__device__ __forceinline__ void pv(f32x16*o,int vb,bf16x8 pa0,bf16x8 pa1,bf16x8 pa2,bf16x8 pa3){
  #pragma unroll
  for(int d0=0;d0<2;++d0){s16x4 lo[4],hi[4];
    #pragma unroll
    for(int ks=0;ks<4;++ks){
      asm volatile("ds_read_b64_tr_b16 %0,%1 offset:%c2":"=&v"(lo[ks]):"v"(vb),"i"(d0*4096+ks*1024):"memory");
      asm volatile("ds_read_b64_tr_b16 %0,%1 offset:%c2":"=&v"(hi[ks]):"v"(vb),"i"(d0*4096+ks*1024+512):"memory");}
    asm volatile("s_waitcnt lgkmcnt(0)":::"memory");SBAR();
    #define PK(k) (bf16x8){lo[k][0],lo[k][1],lo[k][2],lo[k][3],hi[k][0],hi[k][1],hi[k][2],hi[k][3]}
    o[d0]=__builtin_amdgcn_mfma_f32_32x32x16_bf16(pa0,PK(0),o[d0],0,0,0);
    o[d0]=__builtin_amdgcn_mfma_f32_32x32x16_bf16(pa1,PK(1),o[d0],0,0,0);
    o[d0]=__builtin_amdgcn_mfma_f32_32x32x16_bf16(pa2,PK(2),o[d0],0,0,0);
    o[d0]=__builtin_amdgcn_mfma_f32_32x32x16_bf16(pa3,PK(3),o[d0],0,0,0);
    #undef PK
  }
}

#ifndef ATTN_STORE16
#define ATTN_STORE16(p,v) (*(u32x4*)(p)=(v))
#endif
template<int THRL> __device__ __forceinline__ void attn_unit(int b,int h,int vh,int qb,const bf16*Q,const bf16*__restrict__ K,const bf16*__restrict__ V,bf16*O,char*shm,const int wave_){
  const int lane=lane_id_(),r32=lane&31,hi=lane>>5; const int wid=wave_; const int tid=wid*64+lane;
  const long rowbase=(long)b*SEQ; const int q0=qb*QB;
  const bf16*Qw=Q+(rowbase+q0+wid*QBLK)*DM+h*D;
  const bf16*Kh=K+rowbase*DM+h*D,*Vh=V+rowbase*DM+(h>>1)*128+vh*64;
  const unsigned lds0=(unsigned)(uintptr_t)shm;
  float*wsf=(float*)(shm+LDS_WS)+wid*64;
  const bf16*ksrc=Kh+(long)lane*DM+wid*8;
  const bf16*vsrc=Vh+(long)(16*(wid&3)+(lane>>2))*DM+(wid>>2)*32+(lane&3)*8;
  const unsigned kdst=lds0+LDS_K+wid*1024, vdst=lds0+LDS_V+wid*1024;
  #define DMA_K(t,slot) glds16(ksrc+(long)(t)*KVBLK*DM,(unsigned)__builtin_amdgcn_readfirstlane(kdst+(slot)))
  #define DMA_V(t,slot) glds16(vsrc+(long)(t)*KVBLK*DM,(unsigned)__builtin_amdgcn_readfirstlane(vdst+(slot)))
  const int vb0=(int)(lds0+LDS_V)+((lane>>4)&1)*32+(lane&3)*8+(4*hi+((lane&15)>>2))*64;
  const char*Kbase=shm+LDS_K; bf16x8 kf[8];
  const lds_cptr shm3=(lds_cptr)shm; const lds_cptr kp0=shm3+LDS_K+hi*1024+r32*16; const lds_cptr vp0=shm3+LDS_V+((lane>>4)&1)*32+(lane&3)*8+(4*hi+((lane&15)>>2))*64;
  const int NT=(q0+QB)/KVBLK;
  DMA_K(0,0);DMA_V(0,0);DMA_K(1,SLOTB);
  bf16x8 qr[4];
  #pragma unroll
  for(int d0=0;d0<4;++d0)qr[d0]=*reinterpret_cast<const bf16x8*>(&Qw[(long)r32*DM+d0*16+hi*8]);
  float mhat=0.f,l_reg=0.f;f32x16 o[2];o[0]=f32x16{};o[1]=f32x16{};f32x16 negm=f32x16{};asm volatile("":"+v"(negm));
  const int qrel=wid*QBLK+r32;
  #define CMASK(P0,P1,t) do{int jb_=(t)-(NT-4); if(jb_>=0)cmask(P0,P1,jb_,qrel,hi);}while(0)
  bool resc=false;
  #define START(P0,P1) do{ const float rm=rowmax(P0,P1); resc=false; \
    { const float dl=rm; mhat=fadd_s(mhat,dl); \
      _Pragma("unroll") for(int r=0;r<16;++r){P0[r]=fsub_s(P0[r],dl);P1[r]=fsub_s(P1[r],dl);} \
      _Pragma("unroll") for(int r=0;r<16;++r)negm[r]=-mhat; asm volatile("":"+v"(negm)); } \
    _Pragma("unroll") for(int r=0;r<16;++r)P0[r]=__builtin_amdgcn_exp2f(P0[r]); }while(0)
  #define RESC() do{ if(resc){ asm volatile("s_waitcnt lgkmcnt(0)":::"memory"); \
      _Pragma("unroll") for(int d_=0;d_<2;++d_) _Pragma("unroll") for(int r=0;r<16;++r)o[d_][r]*=wsf[crow(r,hi)]; } }while(0)
  f32x16 pA0,pA1,pB0,pB1;
  int sl_prev=0,sl_cur=0,sl_next=SLOTB;
  #define ROT() do{sl_prev=sl_cur;sl_cur=sl_next;sl_next=(sl_next==(NSLOT-1)*SLOTB)?0:sl_next+SLOTB;}while(0)
  DMA_K(2,2*SLOTB);
  WAIT_BAR(3);
  qkt(pA0,pA1,Kbase,qr,negm,r32,hi);asm volatile("s_nop 15\n\ts_nop 7":"+v"(pA0),"+v"(pA1));CMASK(pA0,pA1,0);
  START(pA0,pA1);
  _Pragma("unroll") for(int r=0;r<16;++r)pA1[r]=__builtin_amdgcn_exp2f(pA1[r]);
  WAIT_BAR(0);
  DMA_K(3,0);DMA_V(1,SLOTB);
  ROT();
  kload8(kf,kp0+sl_cur);
  WAIT_BAR(2);
  s16x4 vlo[8],vhi[8]; u32x4 pw0,pw1,pw2,pw3;
  #define PKW(P,B) cvtpk_s(P[B],P[B+1])
  #define PAF(k) __builtin_bit_cast(bf16x8,pw##k)
  #define VFR(i) (bf16x8){vlo[i][0],vlo[i][1],vlo[i][2],vlo[i][3],vhi[i][0],vhi[i][1],vhi[i][2],vhi[i][3]}
  #define PIN(x) asm volatile("":"+v"(x))
  #define MX3(a,b,c) __builtin_fmaxf(__builtin_fmaxf((a),(b)),(c))
  #define GAPA(MF,A0,A1,A2,A3,W0,W1,PW) do{ MF; sacc+=A0; sacc+=A1; sacc+=A2; sacc+=A3; PIN(sacc); W0; W1; PIN(PW); SBAR(); }while(0)
  #define EX(v) __builtin_amdgcn_exp2f(v)
  #define GAPB(MF,X,B) do{ MF; X[B]=EX(X[B]); X[B+1]=EX(X[B+1]); X[B+2]=EX(X[B+2]); X[B+3]=EX(X[B+3]); PIN(X); SBAR(); }while(0)
  #define VRD(i) do{ vlo[i]=vtr(vp_+(((i)>>2)*4096+((i)&3)*1024)); vhi[i]=vtr(vp_+(((i)>>2)*4096+((i)&3)*1024+512)); }while(0)
  #define KRD(G,j) do{ if(G){ kload2(kf,kp0+sl_next,j); SBAR(); } }while(0)
  #define STEP(C0,C1,P0,P1,t,GK,GV,GL) do{ SBAR(); \
    const lds_cptr vp_=vp0+sl_prev; \
    VRD(0); SBAR(); float sacc=(P0[0]+P0[1]); \
    GAPA(C0=__builtin_amdgcn_mfma_f32_32x32x16_bf16(kf[0],qr[0],negm,0,0,0), P0[2],P0[3],P0[4],P0[5],     pw0[0]=PKW(P0,0), pw0[1]=PKW(P0,2), pw0); \
    GAPA(C1=__builtin_amdgcn_mfma_f32_32x32x16_bf16(kf[1],qr[0],negm,0,0,0), P0[6],P0[7],P0[8],P0[9],     pw0[2]=PKW(P0,4), pw0[3]=PKW(P0,6), pw0); \
    VRD(4); SBAR(); GAPA(C0=__builtin_amdgcn_mfma_f32_32x32x16_bf16(kf[2],qr[1],C0,0,0,0),   P0[10],P0[11],P0[12],P0[13], pw1[0]=PKW(P0,8), pw1[1]=PKW(P0,10), pw1); \
    GAPA(C1=__builtin_amdgcn_mfma_f32_32x32x16_bf16(kf[3],qr[1],C1,0,0,0),   P0[14],P0[15],P1[0],P1[1],   pw1[2]=PKW(P0,12),pw1[3]=PKW(P0,14), pw1); \
    VRD(1); SBAR(); GAPA(C0=__builtin_amdgcn_mfma_f32_32x32x16_bf16(kf[4],qr[2],C0,0,0,0),   P1[2],P1[3],P1[4],P1[5],     pw2[0]=PKW(P1,0), pw2[1]=PKW(P1,2), pw2); \
    GAPA(C1=__builtin_amdgcn_mfma_f32_32x32x16_bf16(kf[5],qr[2],C1,0,0,0),   P1[6],P1[7],P1[8],P1[9],     pw2[2]=PKW(P1,4), pw2[3]=PKW(P1,6), pw2); \
    VRD(5); SBAR(); GAPA(C0=__builtin_amdgcn_mfma_f32_32x32x16_bf16(kf[6],qr[3],C0,0,0,0),   P1[10],P1[11],P1[12],P1[13], pw3[0]=PKW(P1,8), pw3[1]=PKW(P1,10), pw3); \
    GAPA(C1=__builtin_amdgcn_mfma_f32_32x32x16_bf16(kf[7],qr[3],C1,0,0,0),   P1[14],P1[15],0.f,0.f,       pw3[2]=PKW(P1,12),pw3[3]=PKW(P1,14), pw3); \
    l_reg+=sacc; \
    if(GK){DMA_K((t)+3,sl_cur);} if(GV){DMA_V((t)+1,sl_next);} \
    CMASK(C0,C1,t); \
    { float a=MX3(C0[0],C0[1],C1[0]),b=MX3(C0[2],C0[3],C1[1]); a=MX3(a,C1[2],C1[3]); \
      _Pragma("unroll") for(int r=4;r<16;r+=4){a=MX3(a,C0[r],C0[r+1]);b=MX3(b,C0[r+2],C0[r+3]);a=MX3(a,C1[r],C1[r+1]);b=MX3(b,C1[r+2],C1[r+3]);} \
      float rm=__builtin_fmaxf(a,b); { auto rr=__builtin_amdgcn_permlane32_swap(__float_as_uint(rm),__float_as_uint(rm),false,false); rm=__builtin_fmaxf(__uint_as_float(rr[0]),__uint_as_float(rr[1])); } \
      resc=false; \
      if(__builtin_expect(__any(rm>(float)THRL),0)){ const float dl=__builtin_fmaxf(rm,0.f); mhat+=dl; \
        _Pragma("unroll") for(int r=0;r<16;++r){C0[r]-=dl;C1[r]-=dl;} \
        _Pragma("unroll") for(int r=0;r<16;++r)negm[r]=-mhat; asm volatile("":"+v"(negm)); \
        const float f=__builtin_amdgcn_exp2f(-dl); l_reg*=f; if(hi==0)wsf[r32]=f; resc=true; } } \
    SBAR(); \
    VRD(2); SBAR(); GAPB(o[0]=__builtin_amdgcn_mfma_f32_32x32x16_bf16(PAF(0),VFR(0),o[0],0,0,0), C0,0); \
    VRD(6); SBAR(); GAPB(o[1]=__builtin_amdgcn_mfma_f32_32x32x16_bf16(PAF(0),VFR(4),o[1],0,0,0), C0,4); \
    VRD(3); SBAR(); KRD(GL,0); GAPB(o[0]=__builtin_amdgcn_mfma_f32_32x32x16_bf16(PAF(1),VFR(1),o[0],0,0,0), C0,8); \
    VRD(7); SBAR(); KRD(GL,1); GAPB(o[1]=__builtin_amdgcn_mfma_f32_32x32x16_bf16(PAF(1),VFR(5),o[1],0,0,0), C0,12); \
    KRD(GL,2); GAPB(o[0]=__builtin_amdgcn_mfma_f32_32x32x16_bf16(PAF(2),VFR(2),o[0],0,0,0), C1,0); \
    KRD(GL,3); GAPB(o[1]=__builtin_amdgcn_mfma_f32_32x32x16_bf16(PAF(2),VFR(6),o[1],0,0,0), C1,4); \
    GAPB(o[0]=__builtin_amdgcn_mfma_f32_32x32x16_bf16(PAF(3),VFR(3),o[0],0,0,0), C1,8); \
    GAPB(o[1]=__builtin_amdgcn_mfma_f32_32x32x16_bf16(PAF(3),VFR(7),o[1],0,0,0), C1,12); \
    }while(0)
  int t=1;
  #undef CMASK
  #define CMASK(P0,P1,t) do{}while(0)
  for(;t+5<NT;t+=2){
    STEP(pB0,pB1,pA0,pA1,t,true,true,true);     WAIT_BAR(2); RESC(); ROT();
    STEP(pA0,pA1,pB0,pB1,t+1,true,true,true);   WAIT_BAR(2); RESC(); ROT();
  }
  #undef CMASK
  #define CMASK(P0,P1,t) do{int jb_=(t)-(NT-4); if(jb_>=0)cmask(P0,P1,jb_,qrel,hi);}while(0)
  #define ENDW(tt) do{ if((tt)+3<NT){WAIT_BAR(2);} else if((tt)+2<NT){WAIT_BAR(1);} else {WAIT_BAR(0);} }while(0)
  for(;t+1<NT;t+=2){
    STEP(pB0,pB1,pA0,pA1,t,(t+3<NT),(t+1<NT),(t+1<NT));       ENDW(t);   RESC(); ROT();
    STEP(pA0,pA1,pB0,pB1,t+1,(t+4<NT),(t+2<NT),(t+2<NT));     ENDW(t+1); RESC(); ROT();
  }
  STEP(pB0,pB1,pA0,pA1,NT-1,false,false,false); RESC();
  { float sacc=pB0[0]+pB0[1]; _Pragma("unroll") for(int r=2;r<16;++r)sacc+=pB0[r]; _Pragma("unroll") for(int r=0;r<16;++r)sacc+=pB1[r]; l_reg+=sacc;
    pw0=(u32x4){PKW(pB0,0),PKW(pB0,2),PKW(pB0,4),PKW(pB0,6)};pw1=(u32x4){PKW(pB0,8),PKW(pB0,10),PKW(pB0,12),PKW(pB0,14)};pw2=(u32x4){PKW(pB1,0),PKW(pB1,2),PKW(pB1,4),PKW(pB1,6)};pw3=(u32x4){PKW(pB1,8),PKW(pB1,10),PKW(pB1,12),PKW(pB1,14)};
    SBAR(); pv(o,vb0+sl_cur,PAF(0),PAF(1),PAF(2),PAF(3)); }
  #undef PKW
  #undef PAF
  #undef VFR
  #undef PIN
  #undef MX3
  #undef GAPA
  #undef GAPB
  #undef EX
  #undef VRD
  #undef KRD
  #undef STEP
  #undef ENDW
  {auto rr=__builtin_amdgcn_permlane32_swap(__float_as_uint(l_reg),__float_as_uint(l_reg),false,false);l_reg=__uint_as_float(rr[0])+__uint_as_float(rr[1]);}
  if(hi==0)wsf[32+r32]=l_reg;asm volatile("s_waitcnt lgkmcnt(0)":::"memory");
  float rli[16];
  #pragma unroll
  for(int r=0;r<16;++r)rli[r]=__builtin_amdgcn_rcpf(wsf[32+crow(r,hi)]);
  bf16*Ow=O+(rowbase+q0+wid*QBLK)*OPITCH+h*128+vh*64;
  { bf16*stg=(bf16*)(shm+LDS_OST)+wid*2048;
    #pragma unroll
    for(int r=0;r<16;++r){const int orow=crow(r,hi);
      #pragma unroll
      for(int d0=0;d0<2;++d0)stg[orow*64+d0*32+r32]=__float2bfloat16(o[d0][r]*rli[r]);}
    asm volatile("s_waitcnt lgkmcnt(0)":::"memory");
    #pragma unroll
    for(int i=0;i<4;++i){const int row=i*8+(lane>>3),ch=lane&7; const u32x4 v=*(const u32x4*)(stg+row*64+ch*8); ATTN_STORE16(Ow+(long)row*OPITCH+ch*8,v);} }
  asm volatile("s_waitcnt lgkmcnt(0)\n\ts_barrier":::"memory");
  #undef DMA_K
  #undef DMA_V
  #undef CMASK
  #undef START
  #undef RESC
  #undef ROT
}
constexpr int ATTN_LDS_BYTES=LDS_BYTES;
struct AttnTensors { const bf16* Q; const bf16* K; const bf16* V; bf16* O; };
struct AttnUnit { int bh; int vh; int qb; };
struct StaticOrder {
  int vcu, G;
  __device__ __forceinline__ explicit StaticOrder(int vcu_,int G_):vcu(vcu_),G(G_){}
  __device__ __forceinline__ bool next(int i,AttnUnit&u)const{ const int s=vcu+(i>>4)*G; if(s>=BATCH*NHEAD*2)return false; u.bh=s>>1; u.vh=s&1; const int j=i&15; u.qb=(j&1)?(j>>1):(NQB-1-(j>>1)); return true; }
};
template<class Sched,int THRL=8> __device__ __forceinline__ void attn_phase(char*lds,const AttnTensors&T,const Sched&S,const int wave_){
  AttnUnit u;
  for(int i=0;S.next(i,u);++i){ attn_unit<THRL>(u.bh/NHEAD,u.bh%NHEAD,u.vh,u.qb,T.Q,T.K,T.V,T.O,lds,wave_); }
}
#undef SBAR
#undef WAIT_BAR
}
#define GAS __attribute__((address_space(1)))
#define LAS __attribute__((address_space(3)))
#define XB_TMO      128
#define XB_XCNT(j)  (256  + 64 * (j))
#define XB_XSUB(j)  (1280 + 64 * (j))
#define XB_XGEN(j)  (2304 + 64 * (j))
#define XB_TOP      3328
#define XB_TOPGEN   3392
#define XCD_BAR_WORDS 3456
#define XB_SPIN_CAP (1u << 18)

__device__ __forceinline__ unsigned xb_ld(unsigned* p)              { return __hip_atomic_load(p, __ATOMIC_RELAXED, __HIP_MEMORY_SCOPE_AGENT); }
__device__ __forceinline__ unsigned xb_add(unsigned* p, unsigned v) { return __hip_atomic_fetch_add(p, v, __ATOMIC_RELAXED, __HIP_MEMORY_SCOPE_AGENT); }
__device__ __forceinline__ unsigned xb_xcc_id() { return (unsigned)__builtin_amdgcn_s_getreg((3 << 11) | 20) & 0xFu; }
#define XB_SPIN(cond, bar) do { unsigned _sp = 0; while (cond) { __builtin_amdgcn_s_sleep(1); \
    if ((++_sp & 255u) == 0u) { if (xb_ld(&(bar)[XB_TMO])) break; if (_sp > XB_SPIN_CAP) { atomicAdd(&(bar)[XB_TMO], 1u); break; } } } } while (0)

struct XcdBarrier {
    unsigned* bar; unsigned x;
    volatile LAS unsigned* st;
};

__device__ __forceinline__ XcdBarrier xcd_barrier_post(unsigned* bar, volatile LAS unsigned* st, const bool lane0w0) {
    XcdBarrier b; b.bar = bar; b.x = xb_xcc_id(); b.st = st;
    if (lane0w0) (void)xb_add(&bar[XB_XCNT(b.x)], 1u);
    return b;
}
__device__ __forceinline__ void xcd_barrier_complete(unsigned* bar, unsigned x, unsigned& nloc, unsigned& nx) {
    const unsigned G = gridDim.x * gridDim.y * gridDim.z;
    unsigned sum, cnt, mine, sp = 0u;
    for (;;) {
        sum = 0u; cnt = 0u; mine = 0u;
#pragma unroll
        for (unsigned j = 0; j < 16; ++j) { const unsigned c = xb_ld(&bar[XB_XCNT(j)]); sum += c; cnt += (c > 0u) ? 1u : 0u; mine = (j == x) ? c : mine; }
        if (sum == G) break;
        __builtin_amdgcn_s_sleep(1);
        if ((++sp & 255u) == 0u) { if (xb_ld(&bar[XB_TMO])) break; if (sp > XB_SPIN_CAP) { atomicAdd(&bar[XB_TMO], 1u); break; } }
    }
    nloc = mine > 0u ? mine : 1u; nx = cnt > 0u ? cnt : 1u;
}

__device__ __forceinline__ void xcd_barrier(const XcdBarrier& b, const bool lane0w0) {
    asm volatile("s_waitcnt vmcnt(0)" ::: "memory");
    __syncthreads();
    if (lane0w0) {
        unsigned* bar = b.bar;
        __builtin_amdgcn_s_waitcnt(0);
        unsigned nloc = b.st[0], nx = b.st[1];
        if (nloc == 0u) { xcd_barrier_complete(bar, b.x, nloc, nx); b.st[0] = nloc; b.st[1] = nx; }
        const unsigned old = xb_add(&bar[XB_XSUB(b.x)], 1u);
        const unsigned gen = old / nloc;
        if (old + 1u == (gen + 1u) * nloc) {
            __builtin_amdgcn_fence(__ATOMIC_RELEASE, "agent");
            asm volatile("s_waitcnt vmcnt(0)" ::: "memory");
            const unsigned og = xb_add(&bar[XB_TOP], 1u);
            const unsigned tg = og / nx;
            if (og + 1u == (tg + 1u) * nx) xb_add(&bar[XB_TOPGEN], 1u);
            else XB_SPIN(xb_ld(&bar[XB_TOPGEN]) == tg, bar);
            __builtin_amdgcn_fence(__ATOMIC_ACQUIRE, "agent");
            xb_add(&bar[XB_XGEN(b.x)], 1u);
            asm volatile("s_waitcnt vmcnt(0)" ::: "memory");
        } else {
            XB_SPIN(xb_ld(&bar[XB_XGEN(b.x)]) == gen, bar);
            __builtin_amdgcn_fence(__ATOMIC_ACQUIRE, "agent");
            asm volatile("s_waitcnt vmcnt(0)" ::: "memory");
        }
    }
    __syncthreads();
}
namespace cg = cooperative_groups;
constexpr int NWAVES = 8;
constexpr int BATCH = 8, SEQ = 4096, D = 1024, M = BATCH * SEQ, NIN = 8192;
constexpr float NORM_EPS = 1e-6f;
constexpr float LAM_INIT = 0.2f;
constexpr size_t MiB = 1u << 20, SLOT = 64 * MiB;
constexpr size_t WS_XR = 0 * SLOT, WS_ZR = 1 * SLOT  , WS_Q = 2 * SLOT  , WS_K = 3 * SLOT  , WS_V = 4 * SLOT  , WS_ZA = 5 * SLOT  , WS_U = 6 * SLOT;
constexpr size_t WS_MISC = 7 * SLOT;
constexpr size_t WS_CTL = WS_MISC, CTL_ZERO_BYTES = 64 * 1024;
constexpr size_t WS_CARRY = WS_MISC + 1 * MiB;
constexpr size_t WS_STATS = WS_MISC + 2 * MiB;
constexpr size_t WS_WIN = WS_MISC + 4 * MiB;
constexpr size_t WS_WR = WS_MISC + 20 * MiB, WS_WA = WS_MISC + 22 * MiB, WS_WO = WS_MISC + 24 * MiB, WS_END = WS_MISC + 26 * MiB;
constexpr int LDS_BYTES = 147456;
constexpr int MISC_OFF = 131072 + 320;

typedef unsigned short bf16;
typedef unsigned v4u __attribute__((ext_vector_type(4)));
typedef float f32x4 __attribute__((ext_vector_type(4)));
typedef float f32x16 __attribute__((ext_vector_type(16)));
typedef short bf16x8 __attribute__((ext_vector_type(8)));
#define LDS_WAIT() asm volatile("s_waitcnt lgkmcnt(0)" ::: "memory")
__device__ __forceinline__ unsigned f2bf(float f) { unsigned u = __builtin_bit_cast(unsigned, f); return (u + 0x7fffu + ((u >> 16) & 1u)) >> 16; }
__device__ __forceinline__ unsigned pk2(float lo, float hi) { return f2bf(lo) | (f2bf(hi) << 16); }
__device__ __forceinline__ float bflo(unsigned w) { return __builtin_bit_cast(float, w << 16); }
__device__ __forceinline__ float bfhi(unsigned w) { return __builtin_bit_cast(float, w & 0xffff0000u); }
__device__ __forceinline__ float sigm(float v) { return __builtin_amdgcn_rcpf(1.0f + __builtin_amdgcn_exp2f(-1.4426950408889634f * v)); }
__device__ __forceinline__ float wave_sum(float v) {
#pragma unroll
    for (int o = 1; o < 64; o <<= 1) v += __shfl_xor(v, o);
    return v;
}

struct Frame {
    LAS unsigned char* lds;
    int wave, vcu, G;
    const float* in[19]; float* out; unsigned char* ws;
};
enum { I_X = 0, I_PREG, I_POSTG, I_WIN, I_CONVW, I_CONVB, I_WA, I_BA, I_WX, I_BX, I_LRUA, I_LQ1, I_LK1, I_LQ2, I_LK2, I_SUBG, I_WBR, I_WBA, I_WOUT };

__device__ __forceinline__ void p0_transpose_item(const float* W, int K, int N, bf16* WT, LAS float* scr, int item, int lane) {
    const int nblk = N / 32, kb = item / nblk, nb = item % nblk, k0 = 64 * kb, n0 = 32 * nb;
#pragma unroll 8
    for (int i = 0; i < 32; ++i) { const int kk = 2 * i + (lane >> 5); scr[kk * 33 + (lane & 31)] = W[(size_t)(k0 + kk) * N + n0 + (lane & 31)]; }
    LDS_WAIT(); asm volatile("" ::: "memory");
    const int c = lane & 7;
#pragma unroll
    for (int j = 0; j < 4; ++j) { const int n = (lane >> 3) + 8 * j; const LAS float* s = scr + (8 * c) * 33 + n;
        v4u o; o.x = pk2(s[0 * 33], s[1 * 33]); o.y = pk2(s[2 * 33], s[3 * 33]); o.z = pk2(s[4 * 33], s[5 * 33]); o.w = pk2(s[6 * 33], s[7 * 33]);
        *(GAS v4u*)(WT + (size_t)(n0 + n) * K + k0 + 8 * c) = o; }
    LDS_WAIT(); asm volatile("" ::: "memory");
}
__device__ __forceinline__ void p0_prologue(Frame& F) {
    LAS float* scr = (LAS float*)(F.lds + F.wave * 16384);
    const int gw = F.vcu * NWAVES + F.wave, NGW = F.G * NWAVES;
    constexpr int I_BIG = (D / 64) * (NIN / 32), I_SM = (D / 64) * (D / 32);
    constexpr int NITEMS = I_BIG + 3 * I_SM;
    for (int it = gw; it < NITEMS; it += NGW) {
        int r = it;
        if (r < I_BIG) { p0_transpose_item(F.in[I_WIN], D, NIN, (bf16*)(F.ws + WS_WIN), scr, r, lane_id_()); continue; } r -= I_BIG;
        if (r < I_SM) { p0_transpose_item(F.in[I_WBR], D, D, (bf16*)(F.ws + WS_WR), scr, r, lane_id_()); continue; } r -= I_SM;
        if (r < I_SM) { p0_transpose_item(F.in[I_WBA], D, D, (bf16*)(F.ws + WS_WA), scr, r, lane_id_()); continue; } r -= I_SM;
        p0_transpose_item(F.in[I_WOUT], D, D, (bf16*)(F.ws + WS_WO), scr, r, lane_id_());
    }
    const GAS f32x4* gp = (const GAS f32x4*)F.in[I_PREG] + lane_id_();
    f32x4 gg[4];
#pragma unroll
    for (int j = 0; j < 4; ++j) gg[j] = gp[64 * j];
    for (int m = gw; m < M; m += NGW) {
        const GAS f32x4* xr = (const GAS f32x4*)(F.in[I_X] + (size_t)m * D) + lane_id_();
        f32x4 v[4]; float s = 0.f;
#pragma unroll
        for (int j = 0; j < 4; ++j) { v[j] = xr[64 * j]; s += (v[j].x * v[j].x + v[j].y * v[j].y) + (v[j].z * v[j].z + v[j].w * v[j].w); }
        const float rstd = 1.0f / sqrtf(wave_sum(s) * (1.f / D) + NORM_EPS);
        GAS unsigned long long* o8 = (GAS unsigned long long*)((bf16*)(F.ws + WS_U) + (size_t)m * D) + lane_id_();
#pragma unroll
        for (int j = 0; j < 4; ++j) { const f32x4 y = v[j] * rstd * gg[j]; o8[64 * j] = (unsigned long long)pk2(y.x, y.y) | ((unsigned long long)pk2(y.z, y.w) << 32); }
    }
}

constexpr int SC_WFRAG = 0;
constexpr int SC_CONV = 16384;
constexpr int SC_WAVE = 16384 + 2048, SC_WAVE_BYTES = 5120 + 4608;
__device__ __forceinline__ int crow16(int r, int hi) { return (r & 3) + 8 * (r >> 2) + 4 * hi; }
template <bool PASS2> __device__ __forceinline__ void scan_phase(Frame& F) {
    const int lane = lane_id_(), tid_ = F.wave * 64 + lane, r32 = lane & 31, hi = lane >> 5;
    LAS unsigned char* const lw = F.lds + SC_WAVE + F.wave * SC_WAVE_BYTES;
    LAS unsigned char* const lz = lw + 5120;
    const LAS float* const lc = (const LAS float*)(F.lds + SC_CONV);
    const bf16* XR = (const bf16*)(F.ws + WS_XR); bf16* ZR = (bf16*)(F.ws + WS_ZR);
    float* carry = (float*)(F.ws + WS_CARRY);
    for (int wi = F.vcu; wi < BATCH * 16 * 2; wi += F.G) {
        const int b = wi >> 5, g = (wi >> 1) & 15, half = wi & 1, sc = half * 8 + F.wave, c0 = g * 64;
        __syncthreads();
        for (int idx = tid_; idx < 1024; idx += NWAVES * 64) {
            const int mat = idx >> 9, f = (idx >> 6) & 7, kk = f >> 1, nt = f & 1, ln = idx & 63, n = 32 * nt + (ln & 31), kb = 16 * kk + 8 * (ln >> 5);
            const float* W = F.in[mat ? I_WX : I_WA] + (size_t)(g * 64 + kb) * 64 + n;
            v4u o; o.x = pk2(W[0], W[64]); o.y = pk2(W[128], W[192]); o.z = pk2(W[256], W[320]); o.w = pk2(W[384], W[448]);
            *(LAS v4u*)(F.lds + SC_WFRAG + idx * 16) = o;
        }
        if (tid_ < 320) { const int tap = tid_ >> 6, ch = tid_ & 63; ((LAS float*)(F.lds + SC_CONV))[tid_] = (tap < 4) ? F.in[I_CONVW][tap * D + c0 + ch] : F.in[I_CONVB][c0 + ch]; }
        __syncthreads();
        float cba[2], cbx[2], ckc[2], H[2], P[2];
#pragma unroll
        for (int nt = 0; nt < 2; ++nt) { const int c = c0 + 32 * nt + r32; cba[nt] = F.in[I_BA][c]; cbx[nt] = F.in[I_BX][c];
            ckc[nt] = -8.0f * 1.4426950408889634f * log1pf(expf(-F.in[I_LRUA][c])); H[nt] = 0.f; P[nt] = 1.f; }
        if (PASS2) {
            for (int j = 0; j < sc; ++j) {
#pragma unroll
                for (int nt = 0; nt < 2; ++nt) { const float2 ab = *(const float2*)(carry + ((size_t)(b * 16 + j) * D + c0 + 32 * nt + r32) * 2); H[nt] = ab.x * H[nt] + ab.y; }
            }
        }
        bf16x8 idf[4];
#pragma unroll
        for (int kk = 0; kk < 4; ++kk) { const int d = (32 * (kk >> 1) + r32) - (16 * kk + 8 * hi); v4u w;
            w.x = (d == 0 ? 0x3F80u : 0u) | (d == 1 ? 0x3F800000u : 0u); w.y = (d == 2 ? 0x3F80u : 0u) | (d == 3 ? 0x3F800000u : 0u);
            w.z = (d == 4 ? 0x3F80u : 0u) | (d == 5 ? 0x3F800000u : 0u); w.w = (d == 6 ? 0x3F80u : 0u) | (d == 7 ? 0x3F800000u : 0u);
            idf[kk] = __builtin_bit_cast(bf16x8, w); }
        for (int sub = 0; sub < 8; ++sub) {
            const int t0 = sc * 256 + sub * 32;
#pragma unroll
            for (int i = 0; i < 5; ++i) { const int row = i * 8 + (lane >> 3), ch = lane & 7, t = t0 - 3 + row;
                if (row < 35) { v4u v = (v4u){0u, 0u, 0u, 0u}; if (t >= 0) v = *(const GAS v4u*)(XR + (size_t)(b * SEQ + t) * D + c0 + ch * 8);
                    *(LAS v4u*)(lw + row * 144 + ch * 16) = v; } }
            if (PASS2) {
#pragma unroll
                for (int i = 0; i < 4; ++i) { const int row = i * 8 + (lane >> 3), ch = lane & 7;
                    *(LAS v4u*)(lz + row * 144 + ch * 16) = *(const GAS v4u*)(ZR + (size_t)(b * SEQ + t0 + row) * D + c0 + ch * 8); }
            }
            bf16x8 af[4];
#pragma unroll
            for (int kk = 0; kk < 4; ++kk) { const int cb = 16 * kk + 8 * hi;
                f32x4 a0 = *(const LAS f32x4*)(lc + 256 + cb), a1 = *(const LAS f32x4*)(lc + 256 + cb + 4);
#pragma unroll
                for (int tap = 0; tap < 4; ++tap) { const v4u x = *(const LAS v4u*)(lw + (r32 + tap) * 144 + cb * 2);
                    const f32x4 w0 = *(const LAS f32x4*)(lc + tap * 64 + cb), w1 = *(const LAS f32x4*)(lc + tap * 64 + cb + 4);
                    a0[0] += w0[0] * bflo(x.x); a0[1] += w0[1] * bfhi(x.x); a0[2] += w0[2] * bflo(x.y); a0[3] += w0[3] * bfhi(x.y);
                    a1[0] += w1[0] * bflo(x.z); a1[1] += w1[1] * bfhi(x.z); a1[2] += w1[2] * bflo(x.w); a1[3] += w1[3] * bfhi(x.w); }
                v4u w; w.x = pk2(a0[0], a0[1]); w.y = pk2(a0[2], a0[3]); w.z = pk2(a1[0], a1[1]); w.w = pk2(a1[2], a1[3]);
                af[kk] = __builtin_bit_cast(bf16x8, w); }
#pragma unroll
            for (int nt = 0; nt < 2; ++nt) {
                f32x16 accR = {}, accI = {}, accX = {};
#pragma unroll
                for (int kk = 0; kk < 4; ++kk) {
                    const bf16x8 fa = *(const LAS bf16x8*)(F.lds + SC_WFRAG + ((0 * 8 + kk * 2 + nt) * 64 + lane) * 16);
                    const bf16x8 fx = *(const LAS bf16x8*)(F.lds + SC_WFRAG + ((1 * 8 + kk * 2 + nt) * 64 + lane) * 16);
                    accR = __builtin_amdgcn_mfma_f32_32x32x16_bf16(af[kk], fa, accR, 0, 0, 0);
                    accI = __builtin_amdgcn_mfma_f32_32x32x16_bf16(af[kk], fx, accI, 0, 0, 0);
                    if ((kk >> 1) == nt) accX = __builtin_amdgcn_mfma_f32_32x32x16_bf16(af[kk], idf[kk], accX, 0, 0, 0);
                }
                float Ap[16], hl[16], Aq[4], Bq[4];
#pragma unroll
                for (int q = 0; q < 4; ++q) { float pa = 1.f, hh = 0.f;
#pragma unroll
                    for (int j = 0; j < 4; ++j) { const int r = 4 * q + j;
                        const float rg = sigm(accR[r] + cba[nt]), ig = sigm(accI[r] + cbx[nt]);
                        const float a = __builtin_amdgcn_exp2f(ckc[nt] * rg);
                        const float bb = __builtin_amdgcn_sqrtf(fmaxf(1.0f - a * a, 0.f)) * ig * accX[r];
                        hh = a * hh + bb; pa *= a; Ap[r] = pa; hl[r] = hh; }
                    Aq[q] = pa; Bq[q] = hh; }
                float Ao[4], Bo[4];
#pragma unroll
                for (int q = 0; q < 4; ++q) { Ao[q] = __shfl_xor(Aq[q], 32); Bo[q] = __shfl_xor(Bq[q], 32); }
                float ci[4]; float Hc = H[nt], Pc = P[nt]; const bool up = (hi != 0);
#pragma unroll
                for (int q = 0; q < 4; ++q) { const float a0 = up ? Ao[q] : Aq[q], b0 = up ? Bo[q] : Bq[q], a1 = up ? Aq[q] : Ao[q], b1 = up ? Bq[q] : Bo[q];
                    const float mid = a0 * Hc + b0; ci[q] = up ? mid : Hc; Hc = a1 * mid + b1; Pc *= a0 * a1; }
                H[nt] = Hc; P[nt] = Pc;
                if (PASS2) {
#pragma unroll
                    for (int q = 0; q < 4; ++q) {
#pragma unroll
                        for (int j = 0; j < 4; ++j) { const int r = 4 * q + j; const float hv = Ap[r] * ci[q] + hl[r];
                            LAS unsigned short* zp = (LAS unsigned short*)(lz + crow16(r, hi) * 144 + (32 * nt + r32) * 2);
                            const float zs = __builtin_bit_cast(float, (unsigned)(*zp) << 16);
                            *zp = (unsigned short)f2bf(hv * zs); } }
                }
            }
            if (PASS2) {
#pragma unroll
                for (int i = 0; i < 4; ++i) { const int row = i * 8 + (lane >> 3), ch = lane & 7;
                    *(GAS v4u*)(ZR + (size_t)(b * SEQ + t0 + row) * D + c0 + ch * 8) = *(const LAS v4u*)(lz + row * 144 + ch * 16); }
            }
        }
        if (!PASS2) { if (hi == 0) {
#pragma unroll
            for (int nt = 0; nt < 2; ++nt) *(float2*)(carry + ((size_t)(b * 16 + sc) * D + c0 + 32 * nt + r32) * 2) = make_float2(P[nt], H[nt]); } }
    }
    __syncthreads();
}

__device__ __forceinline__ void combine_phase(Frame& F) {
    const int gw = F.vcu * NWAVES + F.wave, NGW = F.G * NWAVES, lane = lane_id_(), hd = lane >> 3, p = lane & 7;
    const float l1 = wave_sum(F.in[I_LQ1][lane] * F.in[I_LK1][lane]), l2 = wave_sum(F.in[I_LQ2][lane] * F.in[I_LK2][lane]);
    const float lam = expf(l1) - expf(l2) + LAM_INIT;
    float gsc[16];
#pragma unroll
    for (int i = 0; i < 16; ++i) gsc[i] = F.in[I_SUBG][p * 16 + i] * (1.0f - LAM_INIT);
    const bf16* OB = (const bf16*)F.out; bf16* ZA = (bf16*)(F.ws + WS_ZA);
    for (int m = gw; m < M; m += NGW) {
        const bf16* ob = OB + (size_t)m * 2048 + hd * 256 + p * 16;
        const v4u a0 = *(const GAS v4u*)ob, a1 = *(const GAS v4u*)(ob + 8), b0 = *(const GAS v4u*)(ob + 128), b1 = *(const GAS v4u*)(ob + 136);
        bf16* zp = ZA + (size_t)m * D + hd * 128 + p * 16;
        const v4u z0 = *(const GAS v4u*)zp, z1 = *(const GAS v4u*)(zp + 8);
        float o[16]; const unsigned aw[8] = {a0.x, a0.y, a0.z, a0.w, a1.x, a1.y, a1.z, a1.w}, bw[8] = {b0.x, b0.y, b0.z, b0.w, b1.x, b1.y, b1.z, b1.w}, zw[8] = {z0.x, z0.y, z0.z, z0.w, z1.x, z1.y, z1.z, z1.w};
        float ss = 0.f;
#pragma unroll
        for (int i = 0; i < 8; ++i) { o[2 * i] = bflo(aw[i]) - lam * bflo(bw[i]); o[2 * i + 1] = bfhi(aw[i]) - lam * bfhi(bw[i]); ss += o[2 * i] * o[2 * i] + o[2 * i + 1] * o[2 * i + 1]; }
        ss += __shfl_xor(ss, 1); ss += __shfl_xor(ss, 2); ss += __shfl_xor(ss, 4);
        const float rstd = 1.0f / sqrtf(ss * (1.f / 128.f) + NORM_EPS);
        unsigned yw[8];
#pragma unroll
        for (int i = 0; i < 8; ++i) yw[i] = pk2(o[2 * i] * rstd * gsc[2 * i] * bflo(zw[i]), o[2 * i + 1] * rstd * gsc[2 * i + 1] * bfhi(zw[i]));
        *(GAS v4u*)zp = (v4u){yw[0], yw[1], yw[2], yw[3]}; *(GAS v4u*)(zp + 8) = (v4u){yw[4], yw[5], yw[6], yw[7]};
    }
}

__device__ __forceinline__ void final_phase(Frame& F) {
    const int gw = F.vcu * NWAVES + F.wave, NGW = F.G * NWAVES, lane = lane_id_();
    const float* stats = (const float*)(F.ws + WS_STATS);
    f32x4 gg[4];
#pragma unroll
    for (int j = 0; j < 4; ++j) gg[j] = ((const GAS f32x4*)F.in[I_POSTG])[lane + 64 * j];
    for (int m = gw; m < M; m += NGW) {
        float s = stats[(size_t)m * 16 + (lane & 15)];
        s += __shfl_xor(s, 1); s += __shfl_xor(s, 2); s += __shfl_xor(s, 4); s += __shfl_xor(s, 8);
        const float rstd = 1.0f / sqrtf(s * (1.f / D) + NORM_EPS);
        GAS f32x4* yp = (GAS f32x4*)(F.out + (size_t)m * D) + lane; const GAS f32x4* xp = (const GAS f32x4*)(F.in[I_X] + (size_t)m * D) + lane;
#pragma unroll
        for (int j = 0; j < 4; ++j) { const f32x4 y = yp[64 * j], x = xp[64 * j]; yp[64 * j] = x + y * rstd * gg[j]; }
    }
}

struct Args { const float* in[19]; float* out; unsigned char* ws; int ph_lo, ph_hi; };
__global__ void __launch_bounds__(NWAVES * 64, 2) fwd_kernel(Args args) {
    extern __shared__ __attribute__((aligned(16))) unsigned char lds[];
    cg::grid_group grid = cg::this_grid();
    Frame F;
    F.lds = (LAS unsigned char*)lds;
    F.wave = __builtin_amdgcn_readfirstlane((int)threadIdx.x >> 6);
    F.G = gridDim.x; { const int bx = blockIdx.x; F.vcu = (F.G % 8 == 0) ? (bx % 8) * (F.G / 8) + bx / 8 : bx; }
#pragma unroll
    for (int i = 0; i < 19; ++i) F.in[i] = args.in[i];
    F.out = args.out; F.ws = args.ws;
    unsigned char* ws = args.ws;
    const int lo = args.ph_lo, hi = args.ph_hi;
#define IN(k) (lo <= (k) && (k) < hi)
    const bool lane0w0 = (F.wave == 0) && (lane_id_() == 0);
    if (lane0w0) { ((volatile LAS unsigned*)(F.lds + MISC_OFF))[0] = 0u; ((volatile LAS unsigned*)(F.lds + MISC_OFF))[1] = 0u; }
    __syncthreads();
    XcdBarrier bar = xcd_barrier_post((unsigned*)(ws + WS_CTL) + 1024, (volatile LAS unsigned*)(F.lds + MISC_OFF), lane0w0);
#define SEAM(k) do { if (IN(k) && IN((k) + 1)) { if ((k) == 0) { __syncthreads(); grid.sync(); } else { xcd_barrier(bar, (F.wave == 0) && (lane_id_() == 0)); } } } while (0)

    if (IN(0)) { p0_prologue(F); }
    SEAM(0);
    if (IN(1)) {
        pg8::Gemm g{(const pg8::bf16_t*)(ws + WS_U), (const pg8::bf16_t*)(ws + WS_WIN), M, 6144, D}; pg8::StaticOrder S; S.init(M, 6144, F.G, (int)blockIdx.x);
        pg8::EpiSplit E{(pg8::bf16_t*)(ws + WS_XR), SLOT / 2, 0x100310u, attn_body::C2};
        pg8::gemm_phase<pg8::EpiSplit, pg8::StaticOrder, PG8_ALIGN, PG8_SP2>(F.lds, g, S, E, F.wave);
    }
    SEAM(1);
    if (IN(2)) {
        scan_phase<false>(F);
        const attn_body::AttnTensors AT{(const attn_body::bf16*)(ws + WS_Q), (const attn_body::bf16*)(ws + WS_K), (const attn_body::bf16*)(ws + WS_V), (attn_body::bf16*)F.out};
        const attn_body::StaticOrder AS(F.vcu, F.G); attn_body::attn_phase<attn_body::StaticOrder>((char*)lds, AT, AS, F.wave);
    }
    SEAM(2);
    if (IN(3)) {
        { pg8::Gemm g{(const pg8::bf16_t*)(ws + WS_U), (const pg8::bf16_t*)(ws + WS_WIN) + (size_t)6144 * D, M, 2048, D}; pg8::StaticOrder S; S.init(M, 2048, F.G, (int)blockIdx.x);
          pg8::EpiSplit E{(pg8::bf16_t*)(ws + WS_Q), SLOT / 2, 0x22u, 1.0f};
          pg8::gemm_phase<pg8::EpiSplit, pg8::StaticOrder, PG8_ALIGN, PG8_SP2>(F.lds, g, S, E, F.wave); }
        scan_phase<true>(F);
        combine_phase(F);
    }
    SEAM(3);
    if (IN(4)) {
        { pg8::Gemm g{(const pg8::bf16_t*)(ws + WS_ZR), (const pg8::bf16_t*)(ws + WS_WR), M, D, D}; pg8::StaticOrder S; S.init(M, D, F.G, (int)blockIdx.x);
          pg8::EpiGate<false> E{(const pg8::bf16_t*)(ws + WS_Q), (pg8::bf16_t*)(ws + WS_V)};
          pg8::gemm_phase<pg8::EpiGate<false>, pg8::StaticOrder, PG8_ALIGN, PG8_SP2>(F.lds, g, S, E, F.wave); }
        { pg8::Gemm g{(const pg8::bf16_t*)(ws + WS_ZA), (const pg8::bf16_t*)(ws + WS_WA), M, D, D}; pg8::StaticOrder S; S.init(M, D, F.G, (int)blockIdx.x);
          pg8::EpiGate<true> E{(const pg8::bf16_t*)(ws + WS_K), (pg8::bf16_t*)(ws + WS_V)};
          pg8::gemm_phase<pg8::EpiGate<true>, pg8::StaticOrder, PG8_ALIGN, PG8_SP2>(F.lds, g, S, E, F.wave); }
    }
    SEAM(4);
    if (IN(5)) {
        pg8::Gemm g{(const pg8::bf16_t*)(ws + WS_V), (const pg8::bf16_t*)(ws + WS_WO), M, D, D}; pg8::StaticOrder S; S.init(M, D, F.G, (int)blockIdx.x);
        pg8::EpiF32Stats E{F.out, (float*)(ws + WS_STATS)};
        pg8::gemm_phase<pg8::EpiF32Stats, pg8::StaticOrder, PG8_ALIGN, PG8_SP2>(F.lds, g, S, E, F.wave);
    }
    SEAM(5);
    if (IN(6)) { final_phase(F); }
#undef IN
#undef SEAM
}

extern "C" void kernel_launch(void* const* d_in, const int* in_sizes, int n_in, void* d_out, int out_size, void* d_ws, size_t ws_size, hipStream_t stream) {
    static int grid = 0;
    if (grid == 0) {
        if (n_in != 19 || in_sizes[0] != M * D || out_size != M * D || ws_size < WS_END) { fprintf(stderr, "kernel_launch: unexpected shapes (n_in %d, in0 %d, out %d, ws %zu)\n", n_in, n_in > 0 ? in_sizes[0] : -1, out_size, ws_size); grid = -1; return; }
        int dev = 0, cus = 0, per_cu = 0;
        if (hipGetDevice(&dev) != hipSuccess || hipDeviceGetAttribute(&cus, hipDeviceAttributeMultiprocessorCount, dev) != hipSuccess) { grid = -1; return; }
        if (hipFuncSetAttribute((const void*)fwd_kernel, hipFuncAttributeMaxDynamicSharedMemorySize, LDS_BYTES) != hipSuccess) { fprintf(stderr, "kernel_launch: hipFuncSetAttribute failed\n"); grid = -1; return; }
        if (hipOccupancyMaxActiveBlocksPerMultiprocessor(&per_cu, (const void*)fwd_kernel, NWAVES * 64, LDS_BYTES) != hipSuccess || per_cu < 1) { fprintf(stderr, "kernel_launch: occupancy query says %d\n", per_cu); (void)hipGetLastError(); grid = -1; return; }
        grid = cus;
    }
    if (grid < 0) return;
    if (hipMemsetAsync((char*)d_ws + WS_CTL, 0, CTL_ZERO_BYTES, stream) != hipSuccess) { fprintf(stderr, "kernel_launch: hipMemsetAsync failed\n"); return; }
    Args a{};
    for (int i = 0; i < 19; ++i) a.in[i] = (const float*)d_in[i];
    a.out = (float*)d_out; a.ws = (unsigned char*)d_ws; a.ph_lo = 0; a.ph_hi = 7;
    void* kargs[] = {&a};
    const hipError_t e = hipLaunchCooperativeKernel((const void*)fwd_kernel, dim3(grid), dim3(NWAVES * 64), kargs, LDS_BYTES, stream);
    if (e != hipSuccess) fprintf(stderr, "kernel_launch: cooperative launch failed: %s (grid %d)\n", hipGetErrorString(e), grid);
}
```

```cpp
#include <hip/hip_runtime.h>
#include <hip/hip_cooperative_groups.h>
#include <cstdio>
#include <cstdint>
__device__ __forceinline__ int lane_id_() { return (int)__builtin_amdgcn_mbcnt_hi(~0u, __builtin_amdgcn_mbcnt_lo(~0u, 0u)); }
namespace pg8 {
#define PG8_LAS __attribute__((address_space(3)))
typedef unsigned short bf16_t;
typedef short bf16x8 __attribute__((ext_vector_type(8)));
typedef float f32x4 __attribute__((ext_vector_type(4)));
typedef unsigned u32x4 __attribute__((ext_vector_type(4)));
constexpr int BM = 256, BK = 64, HALF = 128, HTB = HALF * BK * 2  , STAGE_BYTES = 8 * HTB, NXCD = 8, WGM = 8;

__host__ __device__ __forceinline__ int lds_byte(int r, int c) { const int st = (r >> 4) * 2 + (c >> 5), rr = r & 15, cc = c & 31, ob = rr * 64 + cc * 2; return st * 1024 + (ob ^ (((ob >> 9) & 1) << 5)); }
__host__ __device__ __forceinline__ void stage_rc(int b, int& R, int& C) { const int st = b / 1024, sb = b % 1024, swz = sb ^ (((sb >> 9) & 1) << 5); R = (st >> 1) * 16 + swz / 64; C = (st & 1) * 32 + (swz % 64) / 2; }
__host__ __device__ __forceinline__ int perm32(int rho) { const int n = rho >> 4, i = rho & 15; return 8 * (i >> 2) + 4 * n + (i & 3); }

struct Unit { int pm, pn; };
struct Gemm { const bf16_t* A; const bf16_t* Bt; int M, N, K; };

struct StaticOrder {
    int nM, nN, nwg, G, c;
    __host__ __device__ void init(int M, int N, int G_, int c_) { nM = M / BM; nN = N / BM; nwg = nM * nN; G = G_; c = c_; }
    __host__ __device__ bool next(int i, Unit& u) const {
        const long L = (long)i * G + c; if (L >= nwg) return false;
        int wgid = (int)L; { const int q = nwg / NXCD, r = nwg % NXCD, xcd = wgid % NXCD, off = wgid / NXCD; wgid = (xcd < r ? xcd * (q + 1) : r * (q + 1) + (xcd - r) * q) + off; }
        const int nig = WGM * nN, gid = wgid / nig, fm = gid * WGM, gsz = (nM - fm) < WGM ? (nM - fm) : WGM;
        u.pm = fm + ((wgid % nig) % gsz); u.pn = (wgid % nig) / gsz; return true;
    }
    __device__ __forceinline__ void a_ready(const Unit&) const {}
    __device__ __forceinline__ void done(const Unit&) const {}
};

__device__ __forceinline__ unsigned cvt_pk_bf16(float lo, float hi) { unsigned r; asm volatile("v_cvt_pk_bf16_f32 %0, %1, %2" : "=v"(r) : "v"(lo), "v"(hi)); return r; }
typedef float f32x2 __attribute__((ext_vector_type(2)));
__device__ __forceinline__ float bf_lo(unsigned w) { return __builtin_bit_cast(float, w << 16); }
__device__ __forceinline__ float bf_hi(unsigned w) { return __builtin_bit_cast(float, w & 0xffff0000u); }
__device__ __forceinline__ float sigmoid_f(float v) { return __builtin_amdgcn_rcpf(1.0f + __builtin_amdgcn_exp2f(-1.4426950408889634f * v)); }
struct EpiSplit {
    static constexpr bool PERM = true, AFTER_DRAIN = false;
    bf16_t* O; size_t split_stride; unsigned acts; float scl;
    __device__ __forceinline__ void operator()(const f32x4 (&acc)[2][2][4][2], const Unit& u, int wr, int wc, int fr, int fq) const {
        const int row0 = u.pm * BM + wr * 64 + fr; int colt = u.pn * BM; const int t = colt >> 10; bf16_t* base = O + (size_t)t * split_stride; colt -= t << 10;
        const int act = (int)((acts >> (4 * t)) & 15u);
        const int col0 = colt + wc * 32 + 8 * fq;
#pragma unroll
        for (int ai = 0; ai < 2; ++ai)
#pragma unroll
            for (int m = 0; m < 4; ++m) { bf16_t* rowp = base + (size_t)(row0 + ai * HALF + m * 16) * 1024 + col0;
#pragma unroll
                for (int bj = 0; bj < 2; ++bj) { f32x4 v0 = acc[ai][bj][m][0], v1 = acc[ai][bj][m][1];
                    if (act == 1) {
#pragma unroll
                        for (int e = 0; e < 4; ++e) { v0[e] = v0[e] * sigmoid_f(v0[e]); v1[e] = v1[e] * sigmoid_f(v1[e]); }
                    } else if (act == 2) {
#pragma unroll
                        for (int e = 0; e < 4; ++e) { v0[e] = sigmoid_f(v0[e]); v1[e] = sigmoid_f(v1[e]); }
                    } else if (act == 3) { v0 = v0 * scl; v1 = v1 * scl; }
                    u32x4 w; w.x = cvt_pk_bf16(v0[0], v0[1]); w.y = cvt_pk_bf16(v0[2], v0[3]); w.z = cvt_pk_bf16(v1[0], v1[1]); w.w = cvt_pk_bf16(v1[2], v1[3]);
                    *(u32x4*)(rowp + bj * HALF) = w; } }
    }
};
template <bool ACCUM> struct EpiGate {
    static constexpr bool PERM = true, AFTER_DRAIN = false;
    const bf16_t* G; bf16_t* Mb;
    __device__ __forceinline__ void operator()(const f32x4 (&acc)[2][2][4][2], const Unit& u, int wr, int wc, int fr, int fq) const {
        const int row0 = u.pm * BM + wr * 64 + fr, col0 = u.pn * BM + wc * 32 + 8 * fq;
#pragma unroll
        for (int ai = 0; ai < 2; ++ai)
#pragma unroll
            for (int m = 0; m < 4; ++m) { const size_t off = (size_t)(row0 + ai * HALF + m * 16) * 1024 + col0;
#pragma unroll
                for (int bj = 0; bj < 2; ++bj) { const f32x4 a0 = acc[ai][bj][m][0], a1 = acc[ai][bj][m][1];
                    const u32x4 g = *(const u32x4*)(G + off + bj * HALF);
                    f32x4 v0, v1;
                    v0[0] = bf_lo(g.x) * a0[0]; v0[1] = bf_hi(g.x) * a0[1]; v0[2] = bf_lo(g.y) * a0[2]; v0[3] = bf_hi(g.y) * a0[3];
                    v1[0] = bf_lo(g.z) * a1[0]; v1[1] = bf_hi(g.z) * a1[1]; v1[2] = bf_lo(g.w) * a1[2]; v1[3] = bf_hi(g.w) * a1[3];
                    if (ACCUM) { const u32x4 o = *(const u32x4*)(Mb + off + bj * HALF);
                        v0[0] += bf_lo(o.x); v0[1] += bf_hi(o.x); v0[2] += bf_lo(o.y); v0[3] += bf_hi(o.y);
                        v1[0] += bf_lo(o.z); v1[1] += bf_hi(o.z); v1[2] += bf_lo(o.w); v1[3] += bf_hi(o.w); }
                    u32x4 w; w.x = cvt_pk_bf16(v0[0], v0[1]); w.y = cvt_pk_bf16(v0[2], v0[3]); w.z = cvt_pk_bf16(v1[0], v1[1]); w.w = cvt_pk_bf16(v1[2], v1[3]);
                    *(u32x4*)(Mb + off + bj * HALF) = w; } }
    }
};
struct EpiF32Stats {
    static constexpr bool PERM = false, AFTER_DRAIN = false;
    float* Y; float* stats;
    __device__ __forceinline__ void operator()(const f32x4 (&acc)[2][2][4][2], const Unit& u, int wr, int wc, int fr, int fq) const {
        const int col0 = u.pn * BM + wc * 32 + 4 * fq;
#pragma unroll
        for (int ai = 0; ai < 2; ++ai)
#pragma unroll
            for (int m = 0; m < 4; ++m) { const int r = u.pm * BM + ai * HALF + wr * 64 + m * 16 + fr; const size_t off = (size_t)r * 1024 + col0; float s = 0.f;
#pragma unroll
                for (int bj = 0; bj < 2; ++bj)
#pragma unroll
                    for (int n = 0; n < 2; ++n) { const f32x4 x = acc[ai][bj][m][n]; *(f32x4*)(Y + off + bj * HALF + n * 16) = x; s += (x[0] * x[0] + x[1] * x[1]) + (x[2] * x[2] + x[3] * x[3]); }
                s += __shfl_xor(s, 16); s += __shfl_xor(s, 32);
                if (fq == 0) stats[(size_t)r * 16 + u.pn * 4 + wc] = s; }
    }
};
template <class Epi, class Sched, bool ALIGN_EPI = false, bool SP2 = false>
__device__ __forceinline__ void gemm_phase(PG8_LAS unsigned char* lds, const Gemm g, const Sched& S, const Epi& E, const int wave_) {
    const int lane = lane_id_(), wid = wave_, tid = wid * 64 + lane, wr = wid >> 2, wc = wid & 3, fr = lane & 15, fq = lane >> 4;
    const int K = g.K, nt = K / BK;
    unsigned voffA[2], voffB[2];
#pragma unroll
    for (int i = 0; i < 2; ++i) { int R, C; stage_rc(tid * 16 + i * 8192, R, C); const int Rb = Epi::PERM ? ((R & ~31) + perm32(R & 31)) : R;
        voffA[i] = (unsigned)(R * K + C) * 2u; voffB[i] = (unsigned)(Rb * K + C) * 2u; }
    const size_t kstep = (size_t)(BK * 2);
    const size_t hstep = (size_t)HALF * K * 2;
    const size_t tstep = 2 * hstep;
    const unsigned ldsw = (unsigned)wid * 1024u;
    const int aoff = lds_byte(wr * 64 + fr, fq * 8), boff = lds_byte(wc * 32 + fr, fq * 8);
#define PG8_SA(b, h) (((b) * 2 + (h)) * HTB)
#define PG8_SB(b, h) ((4 + (b) * 2 + (h)) * HTB)
#define PG8_STAGE(bufoff, gbase, voff) do { _Pragma("unroll") for (int _i = 0; _i < 2; ++_i) \
        __builtin_amdgcn_global_load_lds((const unsigned*)((const char*)(gbase) + (voff)[_i]), (PG8_LAS unsigned*)(lds + (bufoff) + ldsw + _i * 8192), 16, 0, 0); } while (0)
#define PG8_LDA(dst, b, h) do { _Pragma("unroll") for (int m = 0; m < 4; ++m) _Pragma("unroll") for (int k = 0; k < 2; ++k) dst[m][k] = *(const PG8_LAS bf16x8*)(lds + PG8_SA(b, h) + aoff + m * 2048 + k * 1024); } while (0)
#define PG8_LDB(dst, b, h) do { _Pragma("unroll") for (int n = 0; n < 2; ++n) _Pragma("unroll") for (int k = 0; k < 2; ++k) dst[n][k] = *(const PG8_LAS bf16x8*)(lds + PG8_SB(b, h) + boff + n * 2048 + k * 1024); } while (0)
#define PG8_MMA(ai, bj, At, Bt) do { __builtin_amdgcn_s_setprio(1); _Pragma("unroll") for (int m = 0; m < 4; ++m) _Pragma("unroll") for (int n = 0; n < 2; ++n) _Pragma("unroll") for (int k = 0; k < 2; ++k) \
        acc[ai][bj][m][n] = __builtin_amdgcn_mfma_f32_16x16x32_bf16(Bt[n][k], At[m][k], acc[ai][bj][m][n], 0, 0, 0); __builtin_amdgcn_s_setprio(0); } while (0)
#define PG8_WAIT_V(n) asm volatile("s_waitcnt vmcnt(" #n ")" ::: "memory")
#define PG8_WAIT_L(n) asm volatile("s_waitcnt lgkmcnt(" #n ")" ::: "memory")
#define PG8_BAR __builtin_amdgcn_s_barrier()
#define PG8_SCHED __builtin_amdgcn_sched_barrier(0)
    Unit cur, nxt; int ui = 0;
    if (!S.next(0, cur)) return;
    f32x4 acc[2][2][4][2];
#pragma unroll
    for (int a = 0; a < 2; ++a)
#pragma unroll
        for (int b = 0; b < 2; ++b)
#pragma unroll
            for (int m = 0; m < 4; ++m)
#pragma unroll
                for (int n = 0; n < 2; ++n) acc[a][b][m][n] = (f32x4){0.f, 0.f, 0.f, 0.f};
    bf16x8 At[4][2], B0[2][2], B1[2][2];
    const char* cA = (const char*)g.A + (size_t)cur.pm * tstep; const char* cB = (const char*)g.Bt + (size_t)cur.pn * tstep;
    S.a_ready(cur);
    if constexpr (SP2) {
        PG8_STAGE(PG8_SB(0, 0), cB, voffB); PG8_STAGE(PG8_SB(0, 1), cB + hstep, voffB); PG8_STAGE(PG8_SA(0, 0), cA, voffA); PG8_STAGE(PG8_SA(0, 1), cA + hstep, voffA);
        if (wr == 1) PG8_BAR;
        PG8_WAIT_V(2); PG8_BAR;
        PG8_STAGE(PG8_SB(1, 0), cB + kstep, voffB); PG8_STAGE(PG8_SA(1, 0), cA + kstep, voffA); PG8_STAGE(PG8_SB(1, 1), cB + hstep + kstep, voffB);
        PG8_WAIT_V(6); PG8_BAR;
    } else {
        PG8_STAGE(PG8_SB(0, 0), cB, voffB); PG8_STAGE(PG8_SA(0, 0), cA, voffA); PG8_STAGE(PG8_SB(0, 1), cB + hstep, voffB); PG8_STAGE(PG8_SA(0, 1), cA + hstep, voffA);
        if (wr == 1) PG8_BAR;
        PG8_WAIT_V(4); PG8_BAR;
        PG8_STAGE(PG8_SB(1, 0), cB + kstep, voffB); PG8_STAGE(PG8_SA(1, 0), cA + kstep, voffA); PG8_STAGE(PG8_SB(1, 1), cB + hstep + kstep, voffB);
        PG8_WAIT_V(6); PG8_BAR;
    }
    for (;;) {
        const bool has_next = S.next(ui + 1, nxt);
        const char* nA = has_next ? (const char*)g.A + (size_t)nxt.pm * tstep : cA; const char* nB = has_next ? (const char*)g.Bt + (size_t)nxt.pn * tstep : cB;
        for (int t = 0; t < nt; t += 2) {
            const bool last = (t == nt - 2);
            const char* a1 = cA + (size_t)(t + 1) * kstep;
            const char* a2 = last ? nA : cA + (size_t)(t + 2) * kstep; const char* b2 = last ? nB : cB + (size_t)(t + 2) * kstep;
            const char* a3 = a2 + kstep; const char* b3 = b2 + kstep;
            if (last && has_next) S.a_ready(nxt);
            if constexpr (SP2) {
            PG8_LDB(B0, 0, 0); PG8_LDB(B1, 0, 1); PG8_SCHED; PG8_LDA(At, 0, 0); PG8_STAGE(PG8_SA(1, 1), a1 + hstep, voffA);
            PG8_WAIT_V(8); PG8_WAIT_L(0); PG8_BAR; PG8_MMA(0, 0, At, B0); PG8_MMA(0, 1, At, B1); PG8_BAR; PG8_SCHED;
            PG8_LDA(At, 0, 1); PG8_STAGE(PG8_SB(0, 0), b2, voffB); PG8_STAGE(PG8_SB(0, 1), b2 + hstep, voffB); PG8_STAGE(PG8_SA(0, 0), a2, voffA);
            PG8_WAIT_V(8); PG8_WAIT_L(0); PG8_BAR; PG8_MMA(1, 0, At, B0); PG8_MMA(1, 1, At, B1); PG8_BAR; PG8_SCHED;
            PG8_LDB(B0, 1, 0); PG8_LDB(B1, 1, 1); PG8_SCHED; PG8_LDA(At, 1, 0); PG8_STAGE(PG8_SA(0, 1), a2 + hstep, voffA);
            PG8_WAIT_V(8); PG8_WAIT_L(0); PG8_BAR; PG8_MMA(0, 0, At, B0); PG8_MMA(0, 1, At, B1); PG8_BAR; PG8_SCHED;
            PG8_LDA(At, 1, 1); PG8_STAGE(PG8_SB(1, 0), b3, voffB); PG8_STAGE(PG8_SB(1, 1), b3 + hstep, voffB); PG8_STAGE(PG8_SA(1, 0), a3, voffA);
            PG8_WAIT_V(8); PG8_WAIT_L(0); PG8_BAR; PG8_MMA(1, 0, At, B0); PG8_MMA(1, 1, At, B1); PG8_BAR; PG8_SCHED;
            } else {
            PG8_LDB(B0, 0, 0); PG8_SCHED; PG8_LDA(At, 0, 0); PG8_STAGE(PG8_SA(1, 1), a1 + hstep, voffA);
            PG8_WAIT_L(8); PG8_BAR; PG8_WAIT_L(0); PG8_MMA(0, 0, At, B0); PG8_BAR; PG8_SCHED;
            PG8_LDB(B1, 0, 1); PG8_STAGE(PG8_SB(0, 0), b2, voffB);
            PG8_BAR; PG8_WAIT_L(0); PG8_MMA(0, 1, At, B1); PG8_BAR;
            PG8_LDA(At, 0, 1); PG8_STAGE(PG8_SA(0, 0), a2, voffA);
            PG8_BAR; PG8_WAIT_L(0); PG8_MMA(1, 0, At, B0); PG8_BAR; PG8_SCHED;
            PG8_STAGE(PG8_SB(0, 1), b2 + hstep, voffB);
            PG8_WAIT_V(6); PG8_BAR; PG8_MMA(1, 1, At, B1); PG8_BAR;
            PG8_LDB(B0, 1, 0); PG8_SCHED; PG8_LDA(At, 1, 0); PG8_STAGE(PG8_SA(0, 1), a2 + hstep, voffA);
            PG8_WAIT_L(8); PG8_BAR; PG8_WAIT_L(0); PG8_MMA(0, 0, At, B0); PG8_BAR; PG8_SCHED;
            PG8_LDB(B1, 1, 1); PG8_STAGE(PG8_SB(1, 0), b3, voffB);
            PG8_BAR; PG8_WAIT_L(0); PG8_MMA(0, 1, At, B1); PG8_BAR;
            PG8_LDA(At, 1, 1); PG8_STAGE(PG8_SA(1, 0), a3, voffA);
            PG8_BAR; PG8_WAIT_L(0); PG8_MMA(1, 0, At, B0); PG8_BAR; PG8_SCHED;
            PG8_STAGE(PG8_SB(1, 1), b3 + hstep, voffB);
            PG8_WAIT_V(6); PG8_BAR; PG8_MMA(1, 1, At, B1); PG8_BAR;
            }
        }
        if constexpr (ALIGN_EPI) { if (wr == 0) PG8_BAR; }
        if constexpr (!Epi::AFTER_DRAIN) { E(acc, cur, wr, wc, fr, fq); S.done(cur); }
        if (!has_next) break;
#pragma unroll
        for (int a = 0; a < 2; ++a)
#pragma unroll
            for (int b = 0; b < 2; ++b)
#pragma unroll
                for (int m = 0; m < 4; ++m)
#pragma unroll
                    for (int n = 0; n < 2; ++n) acc[a][b][m][n] = (f32x4){0.f, 0.f, 0.f, 0.f};
        cur = nxt; cA = nA; cB = nB; ++ui;
        if constexpr (ALIGN_EPI) { if (wr == 1) PG8_BAR; }
    }
    PG8_WAIT_V(0);
    if constexpr (!ALIGN_EPI) { if (wr == 0) PG8_BAR; }
    PG8_BAR;
    if constexpr (Epi::AFTER_DRAIN) { E.fused(acc, cur, wr, wc, fr, fq, lds, wid, lane); S.done(cur); }
#undef PG8_SA
#undef PG8_SB
#undef PG8_STAGE
#undef PG8_LDA
#undef PG8_LDB
#undef PG8_MMA
#undef PG8_WAIT_V
#undef PG8_WAIT_L
#undef PG8_BAR
#undef PG8_SCHED
}
}

#ifndef PG8_SP2
#define PG8_SP2 true
#endif
#ifndef PG8_ALIGN
#define PG8_ALIGN true
#endif
#include <hip/hip_bf16.h>
#include <cmath>
#include <hip/hip_bf16.h>
#include <cmath>
namespace attn_body {
using bf16=__hip_bfloat16;
using bf16x8=__attribute__((ext_vector_type(8)))short;
using s16x4=__attribute__((ext_vector_type(4)))short;
using f32x16=__attribute__((ext_vector_type(16)))float;
using u32x4=__attribute__((ext_vector_type(4)))unsigned;
constexpr int BATCH=8,NHEAD=16,SEQ=4096,D=64,DM=NHEAD*D,OPITCH=2048;
constexpr int NW=8,QBLK=32,QB=QBLK*NW,KVBLK=64,NQB=SEQ/QB;
constexpr int ATTN_PITCH=DM, ATTN_UNIT_ROWS=QB;
__device__ __forceinline__ int crow(int r,int hi){return (r&3)+8*(r>>2)+4*hi;}
#define SBAR() __builtin_amdgcn_sched_barrier(0)
__device__ __forceinline__ void cmask(f32x16&p0,f32x16&p1,int jb,int qrel,int hi){
  const float NEG=-INFINITY; int kb=64*jb+4*hi;
  #pragma unroll
  for(int r=0;r<16;++r){int kv=kb+(r&3)+8*(r>>2); if(kv>qrel)p0[r]=NEG; if(kv+32>qrel)p1[r]=NEG;}
}

constexpr int NSLOT=3, SLOTB=8192;
constexpr int LDS_K=0, LDS_V=NSLOT*SLOTB, LDS_WS=2*NSLOT*SLOTB, LDS_OST=LDS_WS+NW*64*4, LDS_BYTES=LDS_OST+NW*4096;
constexpr float C2=0.125f*1.4426950408889634f;
__device__ __forceinline__ void glds16(const void*gsrc,unsigned lds_dst){unsigned keep;
  asm volatile("s_mov_b32 %0, m0\n\ts_mov_b32 m0, %2\n\ts_nop 0\n\tglobal_load_lds_dwordx4 %1, off\n\ts_mov_b32 m0, %0":"=&s"(keep):"v"(gsrc),"s"(lds_dst):"memory");}
__device__ __forceinline__ float max3f(float a,float b,float c){float r;asm("v_max3_f32 %0, %1, %2, %3":"=v"(r):"v"(a),"v"(b),"v"(c));return r;}
__device__ __forceinline__ float max2f(float a,float b){float r;asm("v_max_f32_e32 %0, %1, %2":"=v"(r):"v"(a),"v"(b));return r;}
__device__ __forceinline__ float fadd_s(float a,float b){float r;asm("v_add_f32_e32 %0, %1, %2":"=v"(r):"v"(a),"v"(b));return r;}
__device__ __forceinline__ float fsub_s(float a,float b){float r;asm("v_sub_f32_e32 %0, %1, %2":"=v"(r):"v"(a),"v"(b));return r;}
typedef float f32x2_t __attribute__((ext_vector_type(2))); typedef __bf16 bf16x2_t __attribute__((ext_vector_type(2)));
__device__ __forceinline__ unsigned cvtpk_s(float lo,float hi){f32x2_t v={lo,hi};bf16x2_t b=__builtin_convertvector(v,bf16x2_t);return __builtin_bit_cast(unsigned,b);}
#define WAIT_BAR(N) asm volatile("s_waitcnt vmcnt(" #N ") lgkmcnt(0)\n\ts_barrier":::"memory")

__device__ __forceinline__ void qkt(f32x16&p0,f32x16&p1,const char*Kslot,const bf16x8*qr,const f32x16&negm,int r32,int hi){
  const char*kb=Kslot+hi*1024+r32*16;
  #pragma unroll
  for(int d0=0;d0<4;++d0){
    const bf16x8 b0=*reinterpret_cast<const bf16x8*>(kb+d0*2048);
    const bf16x8 b1=*reinterpret_cast<const bf16x8*>(kb+d0*2048+512);
    if(d0==0){p0=__builtin_amdgcn_mfma_f32_32x32x16_bf16(b0,qr[0],negm,0,0,0);p1=__builtin_amdgcn_mfma_f32_32x32x16_bf16(b1,qr[0],negm,0,0,0);}
    else{p0=__builtin_amdgcn_mfma_f32_32x32x16_bf16(b0,qr[d0],p0,0,0,0);p1=__builtin_amdgcn_mfma_f32_32x32x16_bf16(b1,qr[d0],p1,0,0,0);}}
}
typedef __attribute__((address_space(3))) const char* lds_cptr;
typedef short v4i16_t __attribute__((ext_vector_type(4)));
__device__ __forceinline__ void kload8(bf16x8*kf,lds_cptr kp){
  kf[0]=*(const __attribute__((address_space(3))) bf16x8*)(kp);      kf[1]=*(const __attribute__((address_space(3))) bf16x8*)(kp+512);
  kf[2]=*(const __attribute__((address_space(3))) bf16x8*)(kp+2048); kf[3]=*(const __attribute__((address_space(3))) bf16x8*)(kp+2560);
  kf[4]=*(const __attribute__((address_space(3))) bf16x8*)(kp+4096); kf[5]=*(const __attribute__((address_space(3))) bf16x8*)(kp+4608);
  kf[6]=*(const __attribute__((address_space(3))) bf16x8*)(kp+6144); kf[7]=*(const __attribute__((address_space(3))) bf16x8*)(kp+6656);
}
__device__ __forceinline__ void kload2(bf16x8*kf,lds_cptr kp,int j){ kf[2*j]=*(const __attribute__((address_space(3))) bf16x8*)(kp+j*2048); kf[2*j+1]=*(const __attribute__((address_space(3))) bf16x8*)(kp+j*2048+512); }
__device__ __forceinline__ s16x4 vtr(lds_cptr p){ return __builtin_bit_cast(s16x4,__builtin_amdgcn_ds_read_tr16_b64_v4i16((__attribute__((address_space(3))) v4i16_t*)p)); }
__device__ __forceinline__ float rowmax(const f32x16&p0,const f32x16&p1){
  float a=max3f(p0[0],p0[1],p1[0]),b=max3f(p0[2],p0[3],p1[1]);a=max3f(a,p1[2],p1[3]);
  #pragma unroll
  for(int r=4;r<16;r+=4){a=max3f(a,p0[r],p0[r+1]);b=max3f(b,p0[r+2],p0[r+3]);a=max3f(a,p1[r],p1[r+1]);b=max3f(b,p1[r+2],p1[r+3]);}
  const float m=max2f(a,b);
  auto rr=__builtin_amdgcn_permlane32_swap(__float_as_uint(m),__float_as_uint(m),false,false);
  return max2f(__uint_as_float(rr[0]),__uint_as_float(rr[1]));
}
__device__ __forceinline__ void pv(f32x16*o,int vb,bf16x8 pa0,bf16x8 pa1,bf16x8 pa2,bf16x8 pa3){
  #pragma unroll
  for(int d0=0;d0<2;++d0){s16x4 lo[4],hi[4];
    #pragma unroll
    for(int ks=0;ks<4;++ks){
      asm volatile("ds_read_b64_tr_b16 %0,%1 offset:%c2":"=&v"(lo[ks]):"v"(vb),"i"(d0*4096+ks*1024):"memory");
      asm volatile("ds_read_b64_tr_b16 %0,%1 offset:%c2":"=&v"(hi[ks]):"v"(vb),"i"(d0*4096+ks*1024+512):"memory");}
    asm volatile("s_waitcnt lgkmcnt(0)":::"memory");SBAR();
    #define PK(k) (bf16x8){lo[k][0],lo[k][1],lo[k][2],lo[k][3],hi[k][0],hi[k][1],hi[k][2],hi[k][3]}
    o[d0]=__builtin_amdgcn_mfma_f32_32x32x16_bf16(pa0,PK(0),o[d0],0,0,0);
    o[d0]=__builtin_amdgcn_mfma_f32_32x32x16_bf16(pa1,PK(1),o[d0],0,0,0);
    o[d0]=__builtin_amdgcn_mfma_f32_32x32x16_bf16(pa2,PK(2),o[d0],0,0,0);
    o[d0]=__builtin_amdgcn_mfma_f32_32x32x16_bf16(pa3,PK(3),o[d0],0,0,0);
    #undef PK
  }
}

#ifndef ATTN_STORE16
#define ATTN_STORE16(p,v) (*(u32x4*)(p)=(v))
#endif
template<int THRL> __device__ __forceinline__ void attn_unit(int b,int h,int vh,int qb,const bf16*Q,const bf16*__restrict__ K,const bf16*__restrict__ V,bf16*O,char*shm,const int wave_){
  const int lane=lane_id_(),r32=lane&31,hi=lane>>5; const int wid=wave_; const int tid=wid*64+lane;
  const long rowbase=(long)b*SEQ; const int q0=qb*QB;
  const bf16*Qw=Q+(rowbase+q0+wid*QBLK)*DM+h*D;
  const bf16*Kh=K+rowbase*DM+h*D,*Vh=V+rowbase*DM+(h>>1)*128+vh*64;
  const unsigned lds0=(unsigned)(uintptr_t)shm;
  float*wsf=(float*)(shm+LDS_WS)+wid*64;
  const bf16*ksrc=Kh+(long)lane*DM+wid*8;
  const bf16*vsrc=Vh+(long)(16*(wid&3)+(lane>>2))*DM+(wid>>2)*32+(lane&3)*8;
  const unsigned kdst=lds0+LDS_K+wid*1024, vdst=lds0+LDS_V+wid*1024;
  #define DMA_K(t,slot) glds16(ksrc+(long)(t)*KVBLK*DM,(unsigned)__builtin_amdgcn_readfirstlane(kdst+(slot)))
  #define DMA_V(t,slot) glds16(vsrc+(long)(t)*KVBLK*DM,(unsigned)__builtin_amdgcn_readfirstlane(vdst+(slot)))
  const char*Kbase=shm+LDS_K; bf16x8 kf[8];
  const lds_cptr shm3=(lds_cptr)shm; const lds_cptr kp0=shm3+LDS_K+hi*1024+r32*16; const lds_cptr vp0=shm3+LDS_V+((lane>>4)&1)*32+(lane&3)*8+(4*hi+((lane&15)>>2))*64;
  const int NT=(q0+QB)/KVBLK;
  DMA_K(0,0);DMA_V(0,0);DMA_K(1,SLOTB);
  bf16x8 qr[4];
  #pragma unroll
  for(int d0=0;d0<4;++d0)qr[d0]=*reinterpret_cast<const bf16x8*>(&Qw[(long)r32*DM+d0*16+hi*8]);
  float mhat=0.f,l_reg=0.f;f32x16 o[2];o[0]=f32x16{};o[1]=f32x16{};f32x16 negm=f32x16{};asm volatile("":"+v"(negm));
  const int qrel=wid*QBLK+r32;
  #define CMASK(P0,P1,t) do{int jb_=(t)-(NT-4); if(jb_>=0)cmask(P0,P1,jb_,qrel,hi);}while(0)
  bool resc=false;
  #define START(P0,P1) do{ const float rm=rowmax(P0,P1); resc=false; \
    { const float dl=rm; mhat=fadd_s(mhat,dl); \
      _Pragma("unroll") for(int r=0;r<16;++r){P0[r]=fsub_s(P0[r],dl);P1[r]=fsub_s(P1[r],dl);} \
      _Pragma("unroll") for(int r=0;r<16;++r)negm[r]=-mhat; asm volatile("":"+v"(negm)); } \
    _Pragma("unroll") for(int r=0;r<16;++r)P0[r]=__builtin_amdgcn_exp2f(P0[r]); }while(0)
  #define RESC() do{ if(resc){ asm volatile("s_waitcnt lgkmcnt(0)":::"memory"); \
      _Pragma("unroll") for(int d_=0;d_<2;++d_) _Pragma("unroll") for(int r=0;r<16;++r)o[d_][r]*=wsf[crow(r,hi)]; } }while(0)
  f32x16 pA0,pA1,pB0,pB1;
  int sl_prev=0,sl_cur=0,sl_next=SLOTB;
  #define ROT() do{sl_prev=sl_cur;sl_cur=sl_next;sl_next=(sl_next==(NSLOT-1)*SLOTB)?0:sl_next+SLOTB;}while(0)
  DMA_K(2,2*SLOTB);
  WAIT_BAR(3);
  qkt(pA0,pA1,Kbase,qr,negm,r32,hi);asm volatile("s_nop 15\n\ts_nop 7":"+v"(pA0),"+v"(pA1));CMASK(pA0,pA1,0);
  START(pA0,pA1);
  _Pragma("unroll") for(int r=0;r<16;++r)pA1[r]=__builtin_amdgcn_exp2f(pA1[r]);
  WAIT_BAR(0);
  DMA_K(3,0);DMA_V(1,SLOTB);
  ROT();
  kload8(kf,kp0+sl_cur);
  WAIT_BAR(2);
  s16x4 vlo[8],vhi[8]; u32x4 pw0,pw1,pw2,pw3;
  #define PKW(P,B) cvtpk_s(P[B],P[B+1])
  #define PAF(k) __builtin_bit_cast(bf16x8,pw##k)
  #define VFR(i) (bf16x8){vlo[i][0],vlo[i][1],vlo[i][2],vlo[i][3],vhi[i][0],vhi[i][1],vhi[i][2],vhi[i][3]}
  #define PIN(x) asm volatile("":"+v"(x))
  #define MX3(a,b,c) __builtin_fmaxf(__builtin_fmaxf((a),(b)),(c))
  #define GAPA(MF,A0,A1,A2,A3,W0,W1,PW) do{ MF; sacc+=A0; sacc+=A1; sacc+=A2; sacc+=A3; PIN(sacc); W0; W1; PIN(PW); SBAR(); }while(0)
  #define EX(v) __builtin_amdgcn_exp2f(v)
  #define GAPB(MF,X,B) do{ MF; X[B]=EX(X[B]); X[B+1]=EX(X[B+1]); X[B+2]=EX(X[B+2]); X[B+3]=EX(X[B+3]); PIN(X); SBAR(); }while(0)
  #define VRD(i) do{ vlo[i]=vtr(vp_+(((i)>>2)*4096+((i)&3)*1024)); vhi[i]=vtr(vp_+(((i)>>2)*4096+((i)&3)*1024+512)); }while(0)
  #define KRD(G,j) do{ if(G){ kload2(kf,kp0+sl_next,j); SBAR(); } }while(0)
  #define STEP(C0,C1,P0,P1,t,GK,GV,GL) do{ SBAR(); \
    const lds_cptr vp_=vp0+sl_prev; \
    VRD(0); SBAR(); float sacc=(P0[0]+P0[1]); \
    GAPA(C0=__builtin_amdgcn_mfma_f32_32x32x16_bf16(kf[0],qr[0],negm,0,0,0), P0[2],P0[3],P0[4],P0[5],     pw0[0]=PKW(P0,0), pw0[1]=PKW(P0,2), pw0); \
    GAPA(C1=__builtin_amdgcn_mfma_f32_32x32x16_bf16(kf[1],qr[0],negm,0,0,0), P0[6],P0[7],P0[8],P0[9],     pw0[2]=PKW(P0,4), pw0[3]=PKW(P0,6), pw0); \
    VRD(4); SBAR(); GAPA(C0=__builtin_amdgcn_mfma_f32_32x32x16_bf16(kf[2],qr[1],C0,0,0,0),   P0[10],P0[11],P0[12],P0[13], pw1[0]=PKW(P0,8), pw1[1]=PKW(P0,10), pw1); \
    GAPA(C1=__builtin_amdgcn_mfma_f32_32x32x16_bf16(kf[3],qr[1],C1,0,0,0),   P0[14],P0[15],P1[0],P1[1],   pw1[2]=PKW(P0,12),pw1[3]=PKW(P0,14), pw1); \
    VRD(1); SBAR(); GAPA(C0=__builtin_amdgcn_mfma_f32_32x32x16_bf16(kf[4],qr[2],C0,0,0,0),   P1[2],P1[3],P1[4],P1[5],     pw2[0]=PKW(P1,0), pw2[1]=PKW(P1,2), pw2); \
    GAPA(C1=__builtin_amdgcn_mfma_f32_32x32x16_bf16(kf[5],qr[2],C1,0,0,0),   P1[6],P1[7],P1[8],P1[9],     pw2[2]=PKW(P1,4), pw2[3]=PKW(P1,6), pw2); \
    VRD(5); SBAR(); GAPA(C0=__builtin_amdgcn_mfma_f32_32x32x16_bf16(kf[6],qr[3],C0,0,0,0),   P1[10],P1[11],P1[12],P1[13], pw3[0]=PKW(P1,8), pw3[1]=PKW(P1,10), pw3); \
    GAPA(C1=__builtin_amdgcn_mfma_f32_32x32x16_bf16(kf[7],qr[3],C1,0,0,0),   P1[14],P1[15],0.f,0.f,       pw3[2]=PKW(P1,12),pw3[3]=PKW(P1,14), pw3); \
    l_reg+=sacc; \
    if(GK){DMA_K((t)+3,sl_cur);} if(GV){DMA_V((t)+1,sl_next);} \
    CMASK(C0,C1,t); \
    { float a=MX3(C0[0],C0[1],C1[0]),b=MX3(C0[2],C0[3],C1[1]); a=MX3(a,C1[2],C1[3]); \
      _Pragma("unroll") for(int r=4;r<16;r+=4){a=MX3(a,C0[r],C0[r+1]);b=MX3(b,C0[r+2],C0[r+3]);a=MX3(a,C1[r],C1[r+1]);b=MX3(b,C1[r+2],C1[r+3]);} \
      float rm=__builtin_fmaxf(a,b); { auto rr=__builtin_amdgcn_permlane32_swap(__float_as_uint(rm),__float_as_uint(rm),false,false); rm=__builtin_fmaxf(__uint_as_float(rr[0]),__uint_as_float(rr[1])); } \
      resc=false; \
      if(__builtin_expect(__any(rm>(float)THRL),0)){ const float dl=__builtin_fmaxf(rm,0.f); mhat+=dl; \
        _Pragma("unroll") for(int r=0;r<16;++r){C0[r]-=dl;C1[r]-=dl;} \
        _Pragma("unroll") for(int r=0;r<16;++r)negm[r]=-mhat; asm volatile("":"+v"(negm)); \
        const float f=__builtin_amdgcn_exp2f(-dl); l_reg*=f; { int l2_=lane_id_(); asm volatile("":"+v"(l2_)); if(l2_<32)((float*)(shm+LDS_WS))[wid*64+l2_]=f; } resc=true; } } \
    SBAR(); \
    VRD(2); SBAR(); GAPB(o[0]=__builtin_amdgcn_mfma_f32_32x32x16_bf16(PAF(0),VFR(0),o[0],0,0,0), C0,0); \
    VRD(6); SBAR(); GAPB(o[1]=__builtin_amdgcn_mfma_f32_32x32x16_bf16(PAF(0),VFR(4),o[1],0,0,0), C0,4); \
    VRD(3); SBAR(); KRD(GL,0); GAPB(o[0]=__builtin_amdgcn_mfma_f32_32x32x16_bf16(PAF(1),VFR(1),o[0],0,0,0), C0,8); \
    VRD(7); SBAR(); KRD(GL,1); GAPB(o[1]=__builtin_amdgcn_mfma_f32_32x32x16_bf16(PAF(1),VFR(5),o[1],0,0,0), C0,12); \
    KRD(GL,2); GAPB(o[0]=__builtin_amdgcn_mfma_f32_32x32x16_bf16(PAF(2),VFR(2),o[0],0,0,0), C1,0); \
    KRD(GL,3); GAPB(o[1]=__builtin_amdgcn_mfma_f32_32x32x16_bf16(PAF(2),VFR(6),o[1],0,0,0), C1,4); \
    GAPB(o[0]=__builtin_amdgcn_mfma_f32_32x32x16_bf16(PAF(3),VFR(3),o[0],0,0,0), C1,8); \
    GAPB(o[1]=__builtin_amdgcn_mfma_f32_32x32x16_bf16(PAF(3),VFR(7),o[1],0,0,0), C1,12); \
    }while(0)
  int t=1;
  #undef CMASK
  #define CMASK(P0,P1,t) do{}while(0)
  for(;t+5<NT;t+=2){
    STEP(pB0,pB1,pA0,pA1,t,true,true,true);     WAIT_BAR(2); RESC(); ROT();
    STEP(pA0,pA1,pB0,pB1,t+1,true,true,true);   WAIT_BAR(2); RESC(); ROT();
  }
  #undef CMASK
  #define CMASK(P0,P1,t) do{int jb_=(t)-(NT-4); if(jb_>=0)cmask(P0,P1,jb_,qrel,hi);}while(0)
  #define ENDW(tt) do{ if((tt)+3<NT){WAIT_BAR(2);} else if((tt)+2<NT){WAIT_BAR(1);} else {WAIT_BAR(0);} }while(0)
  for(;t+1<NT;t+=2){
    STEP(pB0,pB1,pA0,pA1,t,(t+3<NT),(t+1<NT),(t+1<NT));       ENDW(t);   RESC(); ROT();
    STEP(pA0,pA1,pB0,pB1,t+1,(t+4<NT),(t+2<NT),(t+2<NT));     ENDW(t+1); RESC(); ROT();
  }
  STEP(pB0,pB1,pA0,pA1,NT-1,false,false,false); RESC();
  { float sacc=pB0[0]+pB0[1]; _Pragma("unroll") for(int r=2;r<16;++r)sacc+=pB0[r]; _Pragma("unroll") for(int r=0;r<16;++r)sacc+=pB1[r]; l_reg+=sacc;
    pw0=(u32x4){PKW(pB0,0),PKW(pB0,2),PKW(pB0,4),PKW(pB0,6)};pw1=(u32x4){PKW(pB0,8),PKW(pB0,10),PKW(pB0,12),PKW(pB0,14)};pw2=(u32x4){PKW(pB1,0),PKW(pB1,2),PKW(pB1,4),PKW(pB1,6)};pw3=(u32x4){PKW(pB1,8),PKW(pB1,10),PKW(pB1,12),PKW(pB1,14)};
    SBAR(); pv(o,(int)(unsigned long)(vp0+sl_cur),PAF(0),PAF(1),PAF(2),PAF(3)); }
  #undef PKW
  #undef PAF
  #undef VFR
  #undef PIN
  #undef MX3
  #undef GAPA
  #undef GAPB
  #undef EX
  #undef VRD
  #undef KRD
  #undef STEP
  #undef ENDW
  {auto rr=__builtin_amdgcn_permlane32_swap(__float_as_uint(l_reg),__float_as_uint(l_reg),false,false);l_reg=__uint_as_float(rr[0])+__uint_as_float(rr[1]);}
  if(hi==0)wsf[32+r32]=l_reg;asm volatile("s_waitcnt lgkmcnt(0)":::"memory");
  float rli[16];
  #pragma unroll
  for(int r=0;r<16;++r)rli[r]=__builtin_amdgcn_rcpf(wsf[32+crow(r,hi)]);
  bf16*Ow=O+(rowbase+q0+wid*QBLK)*OPITCH+h*128+vh*64;
  { bf16*stg=(bf16*)(shm+LDS_OST)+wid*2048;
    #pragma unroll
    for(int r=0;r<16;++r){const int orow=crow(r,hi);
      #pragma unroll
      for(int d0=0;d0<2;++d0)stg[orow*64+d0*32+r32]=__float2bfloat16(o[d0][r]*rli[r]);}
    asm volatile("s_waitcnt lgkmcnt(0)":::"memory");
    #pragma unroll
    for(int i=0;i<4;++i){const int row=i*8+(lane>>3),ch=lane&7; const u32x4 v=*(const u32x4*)(stg+row*64+ch*8); ATTN_STORE16(Ow+(long)row*OPITCH+ch*8,v);} }
  asm volatile("s_waitcnt lgkmcnt(0)\n\ts_barrier":::"memory");
  #undef DMA_K
  #undef DMA_V
  #undef CMASK
  #undef START
  #undef RESC
  #undef ROT
}
constexpr int ATTN_LDS_BYTES=LDS_BYTES;
struct AttnTensors { const bf16* Q; const bf16* K; const bf16* V; bf16* O; };
struct AttnUnit { int bh; int vh; int qb; };
struct StaticOrder {
  int vcu, G;
  __device__ __forceinline__ explicit StaticOrder(int vcu_,int G_):vcu(vcu_),G(G_){}
  __device__ __forceinline__ bool next(int i,AttnUnit&u)const{ const int s=vcu+(i>>4)*G; if(s>=BATCH*NHEAD*2)return false; u.bh=s>>1; u.vh=s&1; const int j=i&15; u.qb=(j&1)?(j>>1):(NQB-1-(j>>1)); return true; }
};
template<class Sched,int THRL=8> __device__ __forceinline__ void attn_phase(char*lds,const AttnTensors&T,const Sched&S,const int wave_){
  AttnUnit u;
  for(int i=0;S.next(i,u);++i){ attn_unit<THRL>(u.bh/NHEAD,u.bh%NHEAD,u.vh,u.qb,T.Q,T.K,T.V,T.O,lds,wave_); }
}
#undef SBAR
#undef WAIT_BAR
}
#define GAS __attribute__((address_space(1)))
#define LAS __attribute__((address_space(3)))
#define XB_TMO      128
#define XB_XCNT(j)  (256  + 64 * (j))
#define XB_XSUB(j)  (1280 + 64 * (j))
#define XB_XGEN(j)  (2304 + 64 * (j))
#define XB_TOP      3328
#define XB_TOPGEN   3392
#define XCD_BAR_WORDS 3456
#define XB_SPIN_CAP (1u << 18)

__device__ __forceinline__ unsigned xb_ld(unsigned* p)              { return __hip_atomic_load(p, __ATOMIC_RELAXED, __HIP_MEMORY_SCOPE_AGENT); }
__device__ __forceinline__ unsigned xb_add(unsigned* p, unsigned v) { return __hip_atomic_fetch_add(p, v, __ATOMIC_RELAXED, __HIP_MEMORY_SCOPE_AGENT); }
__device__ __forceinline__ unsigned xb_xcc_id() { return (unsigned)__builtin_amdgcn_s_getreg((3 << 11) | 20) & 0xFu; }
#define XB_SPIN(cond, bar) do { unsigned _sp = 0; while (cond) { __builtin_amdgcn_s_sleep(1); \
    if ((++_sp & 255u) == 0u) { if (xb_ld(&(bar)[XB_TMO])) break; if (_sp > XB_SPIN_CAP) { atomicAdd(&(bar)[XB_TMO], 1u); break; } } } } while (0)

struct XcdBarrier {
    unsigned* bar; unsigned x;
    volatile LAS unsigned* st;
};

__device__ __forceinline__ XcdBarrier xcd_barrier_post(unsigned* bar, volatile LAS unsigned* st, const bool lane0w0) {
    XcdBarrier b; b.bar = bar; b.x = xb_xcc_id(); b.st = st;
    if (lane0w0) (void)xb_add(&bar[XB_XCNT(b.x)], 1u);
    return b;
}
__device__ __forceinline__ void xcd_barrier_complete(unsigned* bar, unsigned x, unsigned& nloc, unsigned& nx) {
    const unsigned G = gridDim.x * gridDim.y * gridDim.z;
    unsigned sum, cnt, mine, sp = 0u;
    for (;;) {
        sum = 0u; cnt = 0u; mine = 0u;
#pragma unroll
        for (unsigned j = 0; j < 16; ++j) { const unsigned c = xb_ld(&bar[XB_XCNT(j)]); sum += c; cnt += (c > 0u) ? 1u : 0u; mine = (j == x) ? c : mine; }
        if (sum == G) break;
        __builtin_amdgcn_s_sleep(1);
        if ((++sp & 255u) == 0u) { if (xb_ld(&bar[XB_TMO])) break; if (sp > XB_SPIN_CAP) { atomicAdd(&bar[XB_TMO], 1u); break; } }
    }
    nloc = mine > 0u ? mine : 1u; nx = cnt > 0u ? cnt : 1u;
}

__device__ __forceinline__ void xcd_barrier(const XcdBarrier& b, const bool lane0w0) {
    asm volatile("s_waitcnt vmcnt(0)" ::: "memory");
    __syncthreads();
    if (lane0w0) {
        unsigned* bar = b.bar;
        __builtin_amdgcn_s_waitcnt(0);
        unsigned nloc = b.st[0], nx = b.st[1];
        if (nloc == 0u) { xcd_barrier_complete(bar, b.x, nloc, nx); b.st[0] = nloc; b.st[1] = nx; }
        const unsigned old = xb_add(&bar[XB_XSUB(b.x)], 1u);
        const unsigned gen = old / nloc;
        if (old + 1u == (gen + 1u) * nloc) {
            __builtin_amdgcn_fence(__ATOMIC_RELEASE, "agent");
            asm volatile("s_waitcnt vmcnt(0)" ::: "memory");
            const unsigned og = xb_add(&bar[XB_TOP], 1u);
            const unsigned tg = og / nx;
            if (og + 1u == (tg + 1u) * nx) xb_add(&bar[XB_TOPGEN], 1u);
            else XB_SPIN(xb_ld(&bar[XB_TOPGEN]) == tg, bar);
            __builtin_amdgcn_fence(__ATOMIC_ACQUIRE, "agent");
            xb_add(&bar[XB_XGEN(b.x)], 1u);
            asm volatile("s_waitcnt vmcnt(0)" ::: "memory");
        } else {
            XB_SPIN(xb_ld(&bar[XB_XGEN(b.x)]) == gen, bar);
            __builtin_amdgcn_fence(__ATOMIC_ACQUIRE, "agent");
            asm volatile("s_waitcnt vmcnt(0)" ::: "memory");
        }
    }
    __syncthreads();
}
namespace cg = cooperative_groups;
constexpr int NWAVES = 8;
constexpr int BATCH = 8, SEQ = 4096, D = 1024, M = BATCH * SEQ, NIN = 8192;
constexpr float NORM_EPS = 1e-6f;
constexpr float LAM_INIT = 0.2f;
constexpr size_t MiB = 1u << 20, SLOT = 64 * MiB;
constexpr size_t WS_XR = 0 * SLOT, WS_ZR = 1 * SLOT  , WS_Q = 2 * SLOT  , WS_K = 3 * SLOT  , WS_V = 4 * SLOT  , WS_ZA = 5 * SLOT  , WS_U = 6 * SLOT;
constexpr size_t WS_MISC = 7 * SLOT;
constexpr size_t WS_CTL = WS_MISC, CTL_ZERO_BYTES = 64 * 1024;
constexpr size_t WS_CARRY = WS_MISC + 1 * MiB;
constexpr size_t WS_STATS = WS_MISC + 2 * MiB;
constexpr size_t WS_WIN = WS_MISC + 4 * MiB;
constexpr size_t WS_WR = WS_MISC + 20 * MiB, WS_WA = WS_MISC + 22 * MiB, WS_WO = WS_MISC + 24 * MiB, WS_END = WS_MISC + 26 * MiB;
constexpr int LDS_BYTES = 147456;
constexpr int MISC_OFF = 131072 + 320;

typedef unsigned short bf16;
typedef unsigned v4u __attribute__((ext_vector_type(4)));
typedef float f32x4 __attribute__((ext_vector_type(4)));
typedef float f32x16 __attribute__((ext_vector_type(16)));
typedef short bf16x8 __attribute__((ext_vector_type(8)));
#define LDS_WAIT() asm volatile("s_waitcnt lgkmcnt(0)" ::: "memory")
__device__ __forceinline__ unsigned f2bf(float f) { unsigned u = __builtin_bit_cast(unsigned, f); return (u + 0x7fffu + ((u >> 16) & 1u)) >> 16; }
typedef float f32x2_ __attribute__((ext_vector_type(2))); typedef __bf16 bf16x2_ __attribute__((ext_vector_type(2)));
__device__ __forceinline__ unsigned pk2(float lo, float hi) { f32x2_ v = {lo, hi}; return __builtin_bit_cast(unsigned, __builtin_convertvector(v, bf16x2_)); }
__device__ __forceinline__ float bflo(unsigned w) { return __builtin_bit_cast(float, w << 16); }
__device__ __forceinline__ float bfhi(unsigned w) { return __builtin_bit_cast(float, w & 0xffff0000u); }
__device__ __forceinline__ float sigm(float v) { return __builtin_amdgcn_rcpf(1.0f + __builtin_amdgcn_exp2f(-1.4426950408889634f * v)); }
__device__ __forceinline__ float wave_sum(float v) {
#pragma unroll
    for (int o = 1; o < 64; o <<= 1) v += __shfl_xor(v, o);
    return v;
}

struct Frame {
    LAS unsigned char* lds;
    int wave, vcu, G;
    const float* in[19]; float* out; unsigned char* ws;
};
enum { I_X = 0, I_PREG, I_POSTG, I_WIN, I_CONVW, I_CONVB, I_WA, I_BA, I_WX, I_BX, I_LRUA, I_LQ1, I_LK1, I_LQ2, I_LK2, I_SUBG, I_WBR, I_WBA, I_WOUT };

__device__ __forceinline__ void p0_transpose_item(const float* W, int K, int N, bf16* WT, LAS float* scr, int item, int lane) {
    const int nblk = N / 32, kb = item / nblk, nb = item % nblk, k0 = 64 * kb, n0 = 32 * nb;
#pragma unroll 8
    for (int i = 0; i < 32; ++i) { const int kk = 2 * i + (lane >> 5); scr[kk * 33 + (lane & 31)] = W[(size_t)(k0 + kk) * N + n0 + (lane & 31)]; }
    LDS_WAIT(); asm volatile("" ::: "memory");
    const int c = lane & 7;
#pragma unroll
    for (int j = 0; j < 4; ++j) { const int n = (lane >> 3) + 8 * j; const LAS float* s = scr + (8 * c) * 33 + n;
        v4u o; o.x = pk2(s[0 * 33], s[1 * 33]); o.y = pk2(s[2 * 33], s[3 * 33]); o.z = pk2(s[4 * 33], s[5 * 33]); o.w = pk2(s[6 * 33], s[7 * 33]);
        *(GAS v4u*)(WT + (size_t)(n0 + n) * K + k0 + 8 * c) = o; }
    LDS_WAIT(); asm volatile("" ::: "memory");
}
__device__ __forceinline__ void p0_prologue(Frame& F) {
    LAS float* scr = (LAS float*)(F.lds + F.wave * 16384);
    const int gw = F.vcu * NWAVES + F.wave, NGW = F.G * NWAVES;
    constexpr int I_BIG = (D / 64) * (NIN / 32), I_SM = (D / 64) * (D / 32);
    constexpr int NITEMS = I_BIG + 3 * I_SM;
    for (int it = gw; it < NITEMS; it += NGW) {
        int r = it;
        if (r < I_BIG) { p0_transpose_item(F.in[I_WIN], D, NIN, (bf16*)(F.ws + WS_WIN), scr, r, lane_id_()); continue; } r -= I_BIG;
        if (r < I_SM) { p0_transpose_item(F.in[I_WBR], D, D, (bf16*)(F.ws + WS_WR), scr, r, lane_id_()); continue; } r -= I_SM;
        if (r < I_SM) { p0_transpose_item(F.in[I_WBA], D, D, (bf16*)(F.ws + WS_WA), scr, r, lane_id_()); continue; } r -= I_SM;
        p0_transpose_item(F.in[I_WOUT], D, D, (bf16*)(F.ws + WS_WO), scr, r, lane_id_());
    }
    const GAS f32x4* gp = (const GAS f32x4*)F.in[I_PREG] + lane_id_();
    f32x4 gg[4];
#pragma unroll
    for (int j = 0; j < 4; ++j) gg[j] = gp[64 * j];
    for (int m = gw; m < M; m += NGW) {
        const GAS f32x4* xr = (const GAS f32x4*)(F.in[I_X] + (size_t)m * D) + lane_id_();
        f32x4 v[4]; float s = 0.f;
#pragma unroll
        for (int j = 0; j < 4; ++j) { v[j] = xr[64 * j]; s += (v[j].x * v[j].x + v[j].y * v[j].y) + (v[j].z * v[j].z + v[j].w * v[j].w); }
        const float rstd = 1.0f / sqrtf(wave_sum(s) * (1.f / D) + NORM_EPS);
        GAS unsigned long long* o8 = (GAS unsigned long long*)((bf16*)(F.ws + WS_U) + (size_t)m * D) + lane_id_();
#pragma unroll
        for (int j = 0; j < 4; ++j) { const f32x4 y = v[j] * rstd * gg[j]; o8[64 * j] = (unsigned long long)pk2(y.x, y.y) | ((unsigned long long)pk2(y.z, y.w) << 32); }
    }
}

constexpr int SC_WFRAG = 0;
constexpr int SC_CONV = 16384;
constexpr int SC_WAVE = 16384 + 2048, SC_WAVE_BYTES = 5120 + 4608;
__device__ __forceinline__ int crow16(int r, int hi) { return (r & 3) + 8 * (r >> 2) + 4 * hi; }
template <bool PASS2> __device__ __forceinline__ void scan_phase(Frame& F) {
    const int lane = lane_id_(), tid_ = F.wave * 64 + lane, r32 = lane & 31, hi = lane >> 5;
    LAS unsigned char* const lw = F.lds + SC_WAVE + F.wave * SC_WAVE_BYTES;
    LAS unsigned char* const lz = lw + 5120;
    const LAS float* const lc = (const LAS float*)(F.lds + SC_CONV);
    const bf16* XR = (const bf16*)(F.ws + WS_XR); bf16* ZR = (bf16*)(F.ws + WS_ZR);
    float* carry = (float*)(F.ws + WS_CARRY);
    for (int wi = F.vcu; wi < BATCH * 16 * 2; wi += F.G) {
        const int b = wi >> 5, g = (wi >> 1) & 15, half = wi & 1, sc = half * 8 + F.wave, c0 = g * 64;
        __syncthreads();
        for (int idx = tid_; idx < 1024; idx += NWAVES * 64) {
            const int mat = idx >> 9, f = (idx >> 6) & 7, kk = f >> 1, nt = f & 1, ln = idx & 63, n = 32 * nt + (ln & 31), kb = 16 * kk + 8 * (ln >> 5);
            const float* W = F.in[mat ? I_WX : I_WA] + (size_t)(g * 64 + kb) * 64 + n;
            v4u o; o.x = pk2(W[0], W[64]); o.y = pk2(W[128], W[192]); o.z = pk2(W[256], W[320]); o.w = pk2(W[384], W[448]);
            *(LAS v4u*)(F.lds + SC_WFRAG + idx * 16) = o;
        }
        if (tid_ < 320) { const int tap = tid_ >> 6, ch = tid_ & 63; ((LAS float*)(F.lds + SC_CONV))[tid_] = (tap < 4) ? F.in[I_CONVW][tap * D + c0 + ch] : F.in[I_CONVB][c0 + ch]; }
        __syncthreads();
        float cba[2], cbx[2], ckc[2], H[2], P[2];
#pragma unroll
        for (int nt = 0; nt < 2; ++nt) { const int c = c0 + 32 * nt + r32; cba[nt] = F.in[I_BA][c]; cbx[nt] = F.in[I_BX][c];
            ckc[nt] = -8.0f * 1.4426950408889634f * log1pf(expf(-F.in[I_LRUA][c])); H[nt] = 0.f; P[nt] = 1.f; }
        if (PASS2) {
            for (int j0 = 0; j0 < sc; j0 += 8) {
                float2 ab[8][2];
#pragma unroll
                for (int jj = 0; jj < 8; ++jj)
#pragma unroll
                    for (int nt = 0; nt < 2; ++nt) ab[jj][nt] = *(const float2*)(carry + ((size_t)(b * 16 + ((j0 + jj) & 15)) * D + c0 + 32 * nt + r32) * 2);
#pragma unroll
                for (int jj = 0; jj < 8; ++jj) if (j0 + jj < sc) {
#pragma unroll
                    for (int nt = 0; nt < 2; ++nt) H[nt] = ab[jj][nt].x * H[nt] + ab[jj][nt].y; }
            }
        }
        bf16x8 idf[4];
#pragma unroll
        for (int kk = 0; kk < 4; ++kk) { const int d = (32 * (kk >> 1) + r32) - (16 * kk + 8 * hi); v4u w;
            w.x = (d == 0 ? 0x3F80u : 0u) | (d == 1 ? 0x3F800000u : 0u); w.y = (d == 2 ? 0x3F80u : 0u) | (d == 3 ? 0x3F800000u : 0u);
            w.z = (d == 4 ? 0x3F80u : 0u) | (d == 5 ? 0x3F800000u : 0u); w.w = (d == 6 ? 0x3F80u : 0u) | (d == 7 ? 0x3F800000u : 0u);
            idf[kk] = __builtin_bit_cast(bf16x8, w); }
        v4u nx[5], nz[4];
#define SC_LOAD(T0) do { _Pragma("unroll") for (int i = 0; i < 5; ++i) { const int row = i * 8 + (lane >> 3), ch = lane & 7, t = (T0) - 3 + row; \
                nx[i] = (v4u){0u, 0u, 0u, 0u}; if (row < 35 && t >= 0) nx[i] = *(const GAS v4u*)(XR + (size_t)(b * SEQ + t) * D + c0 + ch * 8); } \
            if (PASS2) { _Pragma("unroll") for (int i = 0; i < 4; ++i) { const int row = i * 8 + (lane >> 3), ch = lane & 7; \
                nz[i] = *(const GAS v4u*)(ZR + (size_t)(b * SEQ + (T0) + row) * D + c0 + ch * 8); } } } while (0)
        SC_LOAD(sc * 256);
        for (int sub = 0; sub < 8; ++sub) {
            const int t0 = sc * 256 + sub * 32;
#pragma unroll
            for (int i = 0; i < 5; ++i) { const int row = i * 8 + (lane >> 3), ch = lane & 7; if (row < 35) *(LAS v4u*)(lw + row * 144 + ch * 16) = nx[i]; }
            if (PASS2) {
#pragma unroll
                for (int i = 0; i < 4; ++i) { const int row = i * 8 + (lane >> 3), ch = lane & 7; *(LAS v4u*)(lz + row * 144 + ch * 16) = nz[i]; }
            }
            if (sub < 7) SC_LOAD(t0 + 32);
            bf16x8 af[4];
#pragma unroll
            for (int kk = 0; kk < 4; ++kk) { const int cb = 16 * kk + 8 * hi;
                f32x4 a0 = *(const LAS f32x4*)(lc + 256 + cb), a1 = *(const LAS f32x4*)(lc + 256 + cb + 4);
#pragma unroll
                for (int tap = 0; tap < 4; ++tap) { const v4u x = *(const LAS v4u*)(lw + (r32 + tap) * 144 + cb * 2);
                    const f32x4 w0 = *(const LAS f32x4*)(lc + tap * 64 + cb), w1 = *(const LAS f32x4*)(lc + tap * 64 + cb + 4);
                    a0[0] += w0[0] * bflo(x.x); a0[1] += w0[1] * bfhi(x.x); a0[2] += w0[2] * bflo(x.y); a0[3] += w0[3] * bfhi(x.y);
                    a1[0] += w1[0] * bflo(x.z); a1[1] += w1[1] * bfhi(x.z); a1[2] += w1[2] * bflo(x.w); a1[3] += w1[3] * bfhi(x.w); }
                v4u w; w.x = pk2(a0[0], a0[1]); w.y = pk2(a0[2], a0[3]); w.z = pk2(a1[0], a1[1]); w.w = pk2(a1[2], a1[3]);
                af[kk] = __builtin_bit_cast(bf16x8, w); }
#pragma unroll
            for (int nt = 0; nt < 2; ++nt) {
                f32x16 accR = {}, accI = {}, accX = {};
#pragma unroll
                for (int kk = 0; kk < 4; ++kk) {
                    const bf16x8 fa = *(const LAS bf16x8*)(F.lds + SC_WFRAG + ((0 * 8 + kk * 2 + nt) * 64 + lane) * 16);
                    const bf16x8 fx = *(const LAS bf16x8*)(F.lds + SC_WFRAG + ((1 * 8 + kk * 2 + nt) * 64 + lane) * 16);
                    accR = __builtin_amdgcn_mfma_f32_32x32x16_bf16(af[kk], fa, accR, 0, 0, 0);
                    accI = __builtin_amdgcn_mfma_f32_32x32x16_bf16(af[kk], fx, accI, 0, 0, 0);
                    if ((kk >> 1) == nt) accX = __builtin_amdgcn_mfma_f32_32x32x16_bf16(af[kk], idf[kk], accX, 0, 0, 0);
                }
                float Ap[16], hl[16], Aq[4], Bq[4];
#pragma unroll
                for (int q = 0; q < 4; ++q) { float pa = 1.f, hh = 0.f;
#pragma unroll
                    for (int j = 0; j < 4; ++j) { const int r = 4 * q + j;
                        const float rg = sigm(accR[r] + cba[nt]), ig = sigm(accI[r] + cbx[nt]);
                        const float a = __builtin_amdgcn_exp2f(ckc[nt] * rg);
                        const float bb = __builtin_amdgcn_sqrtf(fmaxf(1.0f - a * a, 0.f)) * ig * accX[r];
                        hh = a * hh + bb; pa *= a; Ap[r] = pa; hl[r] = hh; }
                    Aq[q] = pa; Bq[q] = hh; }
                float Ao[4], Bo[4];
#pragma unroll
                for (int q = 0; q < 4; ++q) { Ao[q] = __shfl_xor(Aq[q], 32); Bo[q] = __shfl_xor(Bq[q], 32); }
                float ci[4]; float Hc = H[nt], Pc = P[nt]; const bool up = (hi != 0);
#pragma unroll
                for (int q = 0; q < 4; ++q) { const float a0 = up ? Ao[q] : Aq[q], b0 = up ? Bo[q] : Bq[q], a1 = up ? Aq[q] : Ao[q], b1 = up ? Bq[q] : Bo[q];
                    const float mid = a0 * Hc + b0; ci[q] = up ? mid : Hc; Hc = a1 * mid + b1; Pc *= a0 * a1; }
                H[nt] = Hc; P[nt] = Pc;
                if (PASS2) {
#pragma unroll
                    for (int q = 0; q < 4; ++q) {
#pragma unroll
                        for (int j = 0; j < 4; ++j) { const int r = 4 * q + j; const float hv = Ap[r] * ci[q] + hl[r];
                            LAS unsigned short* zp = (LAS unsigned short*)(lz + crow16(r, hi) * 144 + (32 * nt + r32) * 2);
                            const float zs = __builtin_bit_cast(float, (unsigned)(*zp) << 16);
                            *zp = (unsigned short)pk2(hv * zs, 0.f); } }
                }
            }
            if (PASS2) {
#pragma unroll
                for (int i = 0; i < 4; ++i) { const int row = i * 8 + (lane >> 3), ch = lane & 7;
                    *(GAS v4u*)(ZR + (size_t)(b * SEQ + t0 + row) * D + c0 + ch * 8) = *(const LAS v4u*)(lz + row * 144 + ch * 16); }
            }
        }
#undef SC_LOAD
        if (!PASS2) { if (hi == 0) {
#pragma unroll
            for (int nt = 0; nt < 2; ++nt) *(float2*)(carry + ((size_t)(b * 16 + sc) * D + c0 + 32 * nt + r32) * 2) = make_float2(P[nt], H[nt]); } }
    }
    __syncthreads();
}

__device__ __forceinline__ void combine_phase(Frame& F) {
    const int gw = F.vcu * NWAVES + F.wave, NGW = F.G * NWAVES, lane = lane_id_(), hd = lane >> 3, p = lane & 7;
    const float l1 = wave_sum(F.in[I_LQ1][lane] * F.in[I_LK1][lane]), l2 = wave_sum(F.in[I_LQ2][lane] * F.in[I_LK2][lane]);
    const float lam = expf(l1) - expf(l2) + LAM_INIT;
    float gsc[16];
#pragma unroll
    for (int i = 0; i < 16; ++i) gsc[i] = F.in[I_SUBG][p * 16 + i] * (1.0f - LAM_INIT);
    const bf16* OB = (const bf16*)F.out; bf16* ZA = (bf16*)(F.ws + WS_ZA);
    for (int m = gw; m < M; m += NGW) {
        const bf16* ob = OB + (size_t)m * 2048 + hd * 256 + p * 16;
        const v4u a0 = *(const GAS v4u*)ob, a1 = *(const GAS v4u*)(ob + 8), b0 = *(const GAS v4u*)(ob + 128), b1 = *(const GAS v4u*)(ob + 136);
        bf16* zp = ZA + (size_t)m * D + hd * 128 + p * 16;
        const v4u z0 = *(const GAS v4u*)zp, z1 = *(const GAS v4u*)(zp + 8);
        float o[16]; const unsigned aw[8] = {a0.x, a0.y, a0.z, a0.w, a1.x, a1.y, a1.z, a1.w}, bw[8] = {b0.x, b0.y, b0.z, b0.w, b1.x, b1.y, b1.z, b1.w}, zw[8] = {z0.x, z0.y, z0.z, z0.w, z1.x, z1.y, z1.z, z1.w};
        float ss = 0.f;
#pragma unroll
        for (int i = 0; i < 8; ++i) { o[2 * i] = bflo(aw[i]) - lam * bflo(bw[i]); o[2 * i + 1] = bfhi(aw[i]) - lam * bfhi(bw[i]); ss += o[2 * i] * o[2 * i] + o[2 * i + 1] * o[2 * i + 1]; }
        ss += __shfl_xor(ss, 1); ss += __shfl_xor(ss, 2); ss += __shfl_xor(ss, 4);
        const float rstd = 1.0f / sqrtf(ss * (1.f / 128.f) + NORM_EPS);
        unsigned yw[8];
#pragma unroll
        for (int i = 0; i < 8; ++i) yw[i] = pk2(o[2 * i] * rstd * gsc[2 * i] * bflo(zw[i]), o[2 * i + 1] * rstd * gsc[2 * i + 1] * bfhi(zw[i]));
        *(GAS v4u*)zp = (v4u){yw[0], yw[1], yw[2], yw[3]}; *(GAS v4u*)(zp + 8) = (v4u){yw[4], yw[5], yw[6], yw[7]};
    }
}

__device__ __forceinline__ void final_phase(Frame& F) {
    const int gw = F.vcu * NWAVES + F.wave, NGW = F.G * NWAVES, lane = lane_id_();
    const float* stats = (const float*)(F.ws + WS_STATS);
    f32x4 gg[4];
#pragma unroll
    for (int j = 0; j < 4; ++j) gg[j] = ((const GAS f32x4*)F.in[I_POSTG])[lane + 64 * j];
    for (int m = gw; m < M; m += NGW) {
        float s = stats[(size_t)m * 16 + (lane & 15)];
        s += __shfl_xor(s, 1); s += __shfl_xor(s, 2); s += __shfl_xor(s, 4); s += __shfl_xor(s, 8);
        const float rstd = 1.0f / sqrtf(s * (1.f / D) + NORM_EPS);
        GAS f32x4* yp = (GAS f32x4*)(F.out + (size_t)m * D) + lane; const GAS f32x4* xp = (const GAS f32x4*)(F.in[I_X] + (size_t)m * D) + lane;
#pragma unroll
        for (int j = 0; j < 4; ++j) { const f32x4 y = yp[64 * j], x = xp[64 * j]; yp[64 * j] = x + y * rstd * gg[j]; }
    }
}

struct Args { const float* in[19]; float* out; unsigned char* ws; int ph_lo, ph_hi; };
__global__ void __launch_bounds__(NWAVES * 64, 2) fwd_kernel(Args args) {
    extern __shared__ __attribute__((aligned(16))) unsigned char lds[];
    cg::grid_group grid = cg::this_grid();
    Frame F;
    F.lds = (LAS unsigned char*)lds;
    F.wave = __builtin_amdgcn_readfirstlane((int)threadIdx.x >> 6);
    F.G = gridDim.x; { const int bx = blockIdx.x; F.vcu = (F.G % 8 == 0) ? (bx % 8) * (F.G / 8) + bx / 8 : bx; }
#pragma unroll
    for (int i = 0; i < 19; ++i) F.in[i] = args.in[i];
    F.out = args.out; F.ws = args.ws;
    unsigned char* ws = args.ws;
    const int lo = args.ph_lo, hi = args.ph_hi;
#define IN(k) (lo <= (k) && (k) < hi)
    const bool lane0w0 = (F.wave == 0) && (lane_id_() == 0);
    if (lane0w0) { ((volatile LAS unsigned*)(F.lds + MISC_OFF))[0] = 0u; ((volatile LAS unsigned*)(F.lds + MISC_OFF))[1] = 0u; }
    __syncthreads();
    XcdBarrier bar = xcd_barrier_post((unsigned*)(ws + WS_CTL) + 1024, (volatile LAS unsigned*)(F.lds + MISC_OFF), lane0w0);
#define SEAM(k) do { if (IN(k) && IN((k) + 1)) { if ((k) == 0) { __syncthreads(); grid.sync(); } else { xcd_barrier(bar, (F.wave == 0) && (lane_id_() == 0)); } } } while (0)

    if (IN(0)) { p0_prologue(F); }
    SEAM(0);
    if (IN(1)) {
        pg8::Gemm g{(const pg8::bf16_t*)(ws + WS_U), (const pg8::bf16_t*)(ws + WS_WIN), M, 6144, D}; pg8::StaticOrder S; S.init(M, 6144, F.G, (int)blockIdx.x);
        pg8::EpiSplit E{(pg8::bf16_t*)(ws + WS_XR), SLOT / 2, 0x100310u, attn_body::C2};
        pg8::gemm_phase<pg8::EpiSplit, pg8::StaticOrder, PG8_ALIGN, PG8_SP2>(F.lds, g, S, E, F.wave);
    }
    SEAM(1);
    if (IN(2)) {
        scan_phase<false>(F);
        const attn_body::AttnTensors AT{(const attn_body::bf16*)(ws + WS_Q), (const attn_body::bf16*)(ws + WS_K), (const attn_body::bf16*)(ws + WS_V), (attn_body::bf16*)F.out};
        const attn_body::StaticOrder AS(F.vcu, F.G); attn_body::attn_phase<attn_body::StaticOrder>((char*)lds, AT, AS, F.wave);
    }
    SEAM(2);
    if (IN(3)) {
        { pg8::Gemm g{(const pg8::bf16_t*)(ws + WS_U), (const pg8::bf16_t*)(ws + WS_WIN) + (size_t)6144 * D, M, 2048, D}; pg8::StaticOrder S; S.init(M, 2048, F.G, (int)blockIdx.x);
          pg8::EpiSplit E{(pg8::bf16_t*)(ws + WS_Q), SLOT / 2, 0x22u, 1.0f};
          pg8::gemm_phase<pg8::EpiSplit, pg8::StaticOrder, PG8_ALIGN, PG8_SP2>(F.lds, g, S, E, F.wave); }
        scan_phase<true>(F);
        combine_phase(F);
    }
    SEAM(3);
    if (IN(4)) {
        { pg8::Gemm g{(const pg8::bf16_t*)(ws + WS_ZR), (const pg8::bf16_t*)(ws + WS_WR), M, D, D}; pg8::StaticOrder S; S.init(M, D, F.G, (int)blockIdx.x);
          pg8::EpiGate<false> E{(const pg8::bf16_t*)(ws + WS_Q), (pg8::bf16_t*)(ws + WS_V)};
          pg8::gemm_phase<pg8::EpiGate<false>, pg8::StaticOrder, PG8_ALIGN, PG8_SP2>(F.lds, g, S, E, F.wave); }
        { pg8::Gemm g{(const pg8::bf16_t*)(ws + WS_ZA), (const pg8::bf16_t*)(ws + WS_WA), M, D, D}; pg8::StaticOrder S; S.init(M, D, F.G, (int)blockIdx.x);
          pg8::EpiGate<true> E{(const pg8::bf16_t*)(ws + WS_K), (pg8::bf16_t*)(ws + WS_V)};
          pg8::gemm_phase<pg8::EpiGate<true>, pg8::StaticOrder, PG8_ALIGN, PG8_SP2>(F.lds, g, S, E, F.wave); }
    }
    SEAM(4);
    if (IN(5)) {
        pg8::Gemm g{(const pg8::bf16_t*)(ws + WS_V), (const pg8::bf16_t*)(ws + WS_WO), M, D, D}; pg8::StaticOrder S; S.init(M, D, F.G, (int)blockIdx.x);
        pg8::EpiF32Stats E{F.out, (float*)(ws + WS_STATS)};
        pg8::gemm_phase<pg8::EpiF32Stats, pg8::StaticOrder, PG8_ALIGN, PG8_SP2>(F.lds, g, S, E, F.wave);
    }
    SEAM(5);
    if (IN(6)) { final_phase(F); }
#undef IN
#undef SEAM
}

extern "C" void kernel_launch(void* const* d_in, const int* in_sizes, int n_in, void* d_out, int out_size, void* d_ws, size_t ws_size, hipStream_t stream) {
    static int grid = 0;
    if (grid == 0) {
        if (n_in != 19 || in_sizes[0] != M * D || out_size != M * D || ws_size < WS_END) { fprintf(stderr, "kernel_launch: unexpected shapes (n_in %d, in0 %d, out %d, ws %zu)\n", n_in, n_in > 0 ? in_sizes[0] : -1, out_size, ws_size); grid = -1; return; }
        int dev = 0, cus = 0, per_cu = 0;
        if (hipGetDevice(&dev) != hipSuccess || hipDeviceGetAttribute(&cus, hipDeviceAttributeMultiprocessorCount, dev) != hipSuccess) { grid = -1; return; }
        if (hipFuncSetAttribute((const void*)fwd_kernel, hipFuncAttributeMaxDynamicSharedMemorySize, LDS_BYTES) != hipSuccess) { fprintf(stderr, "kernel_launch: hipFuncSetAttribute failed\n"); grid = -1; return; }
        if (hipOccupancyMaxActiveBlocksPerMultiprocessor(&per_cu, (const void*)fwd_kernel, NWAVES * 64, LDS_BYTES) != hipSuccess || per_cu < 1) { fprintf(stderr, "kernel_launch: occupancy query says %d\n", per_cu); (void)hipGetLastError(); grid = -1; return; }
        grid = cus;
    }
    if (grid < 0) return;
    if (hipMemsetAsync((char*)d_ws + WS_CTL, 0, CTL_ZERO_BYTES, stream) != hipSuccess) { fprintf(stderr, "kernel_launch: hipMemsetAsync failed\n"); return; }
    Args a{};
    for (int i = 0; i < 19; ++i) a.in[i] = (const float*)d_in[i];
    a.out = (float*)d_out; a.ws = (unsigned char*)d_ws; a.ph_lo = 0; a.ph_hi = 7;
    void* kargs[] = {&a};
    const hipError_t e = hipLaunchCooperativeKernel((const void*)fwd_kernel, dim3(grid), dim3(NWAVES * 64), kargs, LDS_BYTES, stream);
    if (e != hipSuccess) fprintf(stderr, "kernel_launch: cooperative launch failed: %s (grid %d)\n", hipGetErrorString(e), grid);
}
```

```cpp
#include <hip/hip_runtime.h>
#include <hip/hip_cooperative_groups.h>
#include <cstdio>
#include <cstdint>
__device__ __forceinline__ int lane_id_() { return (int)__builtin_amdgcn_mbcnt_hi(~0u, __builtin_amdgcn_mbcnt_lo(~0u, 0u)); }
namespace pg8 {
#define PG8_LAS __attribute__((address_space(3)))
typedef unsigned short bf16_t;
typedef short bf16x8 __attribute__((ext_vector_type(8)));
typedef float f32x4 __attribute__((ext_vector_type(4)));
typedef unsigned u32x4 __attribute__((ext_vector_type(4)));
constexpr int BM = 256, BK = 64, HALF = 128, HTB = HALF * BK * 2  , STAGE_BYTES = 8 * HTB, NXCD = 8, WGM = 8;

__host__ __device__ __forceinline__ int lds_byte(int r, int c) { const int st = (r >> 4) * 2 + (c >> 5), rr = r & 15, cc = c & 31, ob = rr * 64 + cc * 2; return st * 1024 + (ob ^ (((ob >> 9) & 1) << 5)); }
__host__ __device__ __forceinline__ void stage_rc(int b, int& R, int& C) { const int st = b / 1024, sb = b % 1024, swz = sb ^ (((sb >> 9) & 1) << 5); R = (st >> 1) * 16 + swz / 64; C = (st & 1) * 32 + (swz % 64) / 2; }
__host__ __device__ __forceinline__ int perm32(int rho) { const int n = rho >> 4, i = rho & 15; return 8 * (i >> 2) + 4 * n + (i & 3); }

struct Unit { int pm, pn; };
struct Gemm { const bf16_t* A; const bf16_t* Bt; int M, N, K; };

struct StaticOrder {
    int nM, nN, nwg, G, c;
    __host__ __device__ void init(int M, int N, int G_, int c_) { nM = M / BM; nN = N / BM; nwg = nM * nN; G = G_; c = c_; }
    __host__ __device__ bool next(int i, Unit& u) const {
        const long L = (long)i * G + c; if (L >= nwg) return false;
        int wgid = (int)L; { const int q = nwg / NXCD, r = nwg % NXCD, xcd = wgid % NXCD, off = wgid / NXCD; wgid = (xcd < r ? xcd * (q + 1) : r * (q + 1) + (xcd - r) * q) + off; }
        const int nig = WGM * nN, gid = wgid / nig, fm = gid * WGM, gsz = (nM - fm) < WGM ? (nM - fm) : WGM;
        u.pm = fm + ((wgid % nig) % gsz); u.pn = (wgid % nig) / gsz; return true;
    }
    __device__ __forceinline__ void a_ready(const Unit&) const {}
    __device__ __forceinline__ void done(const Unit&) const {}
};

__device__ __forceinline__ unsigned cvt_pk_bf16(float lo, float hi) { unsigned r; asm volatile("v_cvt_pk_bf16_f32 %0, %1, %2" : "=v"(r) : "v"(lo), "v"(hi)); return r; }
typedef float f32x2 __attribute__((ext_vector_type(2)));
__device__ __forceinline__ float bf_lo(unsigned w) { return __builtin_bit_cast(float, w << 16); }
__device__ __forceinline__ float bf_hi(unsigned w) { return __builtin_bit_cast(float, w & 0xffff0000u); }
__device__ __forceinline__ float sigmoid_f(float v) { return __builtin_amdgcn_rcpf(1.0f + __builtin_amdgcn_exp2f(-1.4426950408889634f * v)); }
struct EpiSplit {
    static constexpr bool PERM = true, AFTER_DRAIN = false;
    bf16_t* O; size_t split_stride; unsigned acts; float scl;
    __device__ __forceinline__ void operator()(const f32x4 (&acc)[2][2][4][2], const Unit& u, int wr, int wc, int fr, int fq) const {
        const int row0 = u.pm * BM + wr * 64 + fr; int colt = u.pn * BM; const int t = colt >> 10; bf16_t* base = O + (size_t)t * split_stride; colt -= t << 10;
        const int act = (int)((acts >> (4 * t)) & 15u);
        const int col0 = colt + wc * 32 + 8 * fq;
#pragma unroll
        for (int ai = 0; ai < 2; ++ai)
#pragma unroll
            for (int m = 0; m < 4; ++m) { bf16_t* rowp = base + (size_t)(row0 + ai * HALF + m * 16) * 1024 + col0;
#pragma unroll
                for (int bj = 0; bj < 2; ++bj) { f32x4 v0 = acc[ai][bj][m][0], v1 = acc[ai][bj][m][1];
                    if (act == 1) {
#pragma unroll
                        for (int e = 0; e < 4; ++e) { v0[e] = v0[e] * sigmoid_f(v0[e]); v1[e] = v1[e] * sigmoid_f(v1[e]); }
                    } else if (act == 2) {
#pragma unroll
                        for (int e = 0; e < 4; ++e) { v0[e] = sigmoid_f(v0[e]); v1[e] = sigmoid_f(v1[e]); }
                    } else if (act == 3) { v0 = v0 * scl; v1 = v1 * scl; }
                    u32x4 w; w.x = cvt_pk_bf16(v0[0], v0[1]); w.y = cvt_pk_bf16(v0[2], v0[3]); w.z = cvt_pk_bf16(v1[0], v1[1]); w.w = cvt_pk_bf16(v1[2], v1[3]);
                    *(u32x4*)(rowp + bj * HALF) = w; } }
    }
};
template <bool ACCUM> struct EpiGate {
    static constexpr bool PERM = true, AFTER_DRAIN = false;
    const bf16_t* G; bf16_t* Mb;
    __device__ __forceinline__ void operator()(const f32x4 (&acc)[2][2][4][2], const Unit& u, int wr, int wc, int fr, int fq) const {
        const int row0 = u.pm * BM + wr * 64 + fr, col0 = u.pn * BM + wc * 32 + 8 * fq;
#pragma unroll
        for (int ai = 0; ai < 2; ++ai)
#pragma unroll
            for (int m = 0; m < 4; ++m) { const size_t off = (size_t)(row0 + ai * HALF + m * 16) * 1024 + col0;
#pragma unroll
                for (int bj = 0; bj < 2; ++bj) { const f32x4 a0 = acc[ai][bj][m][0], a1 = acc[ai][bj][m][1];
                    const u32x4 g = *(const u32x4*)(G + off + bj * HALF);
                    f32x4 v0, v1;
                    v0[0] = bf_lo(g.x) * a0[0]; v0[1] = bf_hi(g.x) * a0[1]; v0[2] = bf_lo(g.y) * a0[2]; v0[3] = bf_hi(g.y) * a0[3];
                    v1[0] = bf_lo(g.z) * a1[0]; v1[1] = bf_hi(g.z) * a1[1]; v1[2] = bf_lo(g.w) * a1[2]; v1[3] = bf_hi(g.w) * a1[3];
                    if (ACCUM) { const u32x4 o = *(const u32x4*)(Mb + off + bj * HALF);
                        v0[0] += bf_lo(o.x); v0[1] += bf_hi(o.x); v0[2] += bf_lo(o.y); v0[3] += bf_hi(o.y);
                        v1[0] += bf_lo(o.z); v1[1] += bf_hi(o.z); v1[2] += bf_lo(o.w); v1[3] += bf_hi(o.w); }
                    u32x4 w; w.x = cvt_pk_bf16(v0[0], v0[1]); w.y = cvt_pk_bf16(v0[2], v0[3]); w.z = cvt_pk_bf16(v1[0], v1[1]); w.w = cvt_pk_bf16(v1[2], v1[3]);
                    *(u32x4*)(Mb + off + bj * HALF) = w; } }
    }
};
struct EpiF32Stats {
    static constexpr bool PERM = false, AFTER_DRAIN = false;
    float* Y; float* stats;
    __device__ __forceinline__ void operator()(const f32x4 (&acc)[2][2][4][2], const Unit& u, int wr, int wc, int fr, int fq) const {
        const int col0 = u.pn * BM + wc * 32 + 4 * fq;
#pragma unroll
        for (int ai = 0; ai < 2; ++ai)
#pragma unroll
            for (int m = 0; m < 4; ++m) { const int r = u.pm * BM + ai * HALF + wr * 64 + m * 16 + fr; const size_t off = (size_t)r * 1024 + col0; float s = 0.f;
#pragma unroll
                for (int bj = 0; bj < 2; ++bj)
#pragma unroll
                    for (int n = 0; n < 2; ++n) { const f32x4 x = acc[ai][bj][m][n]; *(f32x4*)(Y + off + bj * HALF + n * 16) = x; s += (x[0] * x[0] + x[1] * x[1]) + (x[2] * x[2] + x[3] * x[3]); }
                s += __shfl_xor(s, 16); s += __shfl_xor(s, 32);
                if (fq == 0) stats[(size_t)r * 16 + u.pn * 4 + wc] = s; }
    }
};
template <class Epi, class Sched, bool ALIGN_EPI = false, bool SP2 = false>
__device__ __forceinline__ void gemm_phase(PG8_LAS unsigned char* lds, const Gemm g, const Sched& S, const Epi& E, const int wave_) {
    const int lane = lane_id_(), wid = wave_, tid = wid * 64 + lane, wr = wid >> 2, wc = wid & 3, fr = lane & 15, fq = lane >> 4;
    const int K = g.K, nt = K / BK;
    unsigned voffA[2], voffB[2];
#pragma unroll
    for (int i = 0; i < 2; ++i) { int R, C; stage_rc(tid * 16 + i * 8192, R, C); const int Rb = Epi::PERM ? ((R & ~31) + perm32(R & 31)) : R;
        voffA[i] = (unsigned)(R * K + C) * 2u; voffB[i] = (unsigned)(Rb * K + C) * 2u; }
    const size_t kstep = (size_t)(BK * 2);
    const size_t hstep = (size_t)HALF * K * 2;
    const size_t tstep = 2 * hstep;
    const unsigned ldsw = (unsigned)wid * 1024u;
    const int aoff = lds_byte(wr * 64 + fr, fq * 8), boff = lds_byte(wc * 32 + fr, fq * 8);
#define PG8_SA(b, h) (((b) * 2 + (h)) * HTB)
#define PG8_SB(b, h) ((4 + (b) * 2 + (h)) * HTB)
#define PG8_STAGE(bufoff, gbase, voff) do { _Pragma("unroll") for (int _i = 0; _i < 2; ++_i) \
        __builtin_amdgcn_global_load_lds((const unsigned*)((const char*)(gbase) + (voff)[_i]), (PG8_LAS unsigned*)(lds + (bufoff) + ldsw + _i * 8192), 16, 0, 0); } while (0)
#define PG8_LDA(dst, b, h) do { _Pragma("unroll") for (int m = 0; m < 4; ++m) _Pragma("unroll") for (int k = 0; k < 2; ++k) dst[m][k] = *(const PG8_LAS bf16x8*)(lds + PG8_SA(b, h) + aoff + m * 2048 + k * 1024); } while (0)
#define PG8_LDB(dst, b, h) do { _Pragma("unroll") for (int n = 0; n < 2; ++n) _Pragma("unroll") for (int k = 0; k < 2; ++k) dst[n][k] = *(const PG8_LAS bf16x8*)(lds + PG8_SB(b, h) + boff + n * 2048 + k * 1024); } while (0)
#define PG8_MMA(ai, bj, At, Bt) do { __builtin_amdgcn_s_setprio(1); _Pragma("unroll") for (int m = 0; m < 4; ++m) _Pragma("unroll") for (int n = 0; n < 2; ++n) _Pragma("unroll") for (int k = 0; k < 2; ++k) \
        acc[ai][bj][m][n] = __builtin_amdgcn_mfma_f32_16x16x32_bf16(Bt[n][k], At[m][k], acc[ai][bj][m][n], 0, 0, 0); __builtin_amdgcn_s_setprio(0); } while (0)
#define PG8_WAIT_V(n) asm volatile("s_waitcnt vmcnt(" #n ")" ::: "memory")
#define PG8_WAIT_L(n) asm volatile("s_waitcnt lgkmcnt(" #n ")" ::: "memory")
#define PG8_BAR __builtin_amdgcn_s_barrier()
#define PG8_SCHED __builtin_amdgcn_sched_barrier(0)
    Unit cur, nxt; int ui = 0;
    if (!S.next(0, cur)) return;
    f32x4 acc[2][2][4][2];
#pragma unroll
    for (int a = 0; a < 2; ++a)
#pragma unroll
        for (int b = 0; b < 2; ++b)
#pragma unroll
            for (int m = 0; m < 4; ++m)
#pragma unroll
                for (int n = 0; n < 2; ++n) acc[a][b][m][n] = (f32x4){0.f, 0.f, 0.f, 0.f};
    bf16x8 At[4][2], B0[2][2], B1[2][2];
    const char* cA = (const char*)g.A + (size_t)cur.pm * tstep; const char* cB = (const char*)g.Bt + (size_t)cur.pn * tstep;
    S.a_ready(cur);
    if constexpr (SP2) {
        PG8_STAGE(PG8_SB(0, 0), cB, voffB); PG8_STAGE(PG8_SB(0, 1), cB + hstep, voffB); PG8_STAGE(PG8_SA(0, 0), cA, voffA); PG8_STAGE(PG8_SA(0, 1), cA + hstep, voffA);
        if (wr == 1) PG8_BAR;
        PG8_WAIT_V(2); PG8_BAR;
        PG8_STAGE(PG8_SB(1, 0), cB + kstep, voffB); PG8_STAGE(PG8_SA(1, 0), cA + kstep, voffA); PG8_STAGE(PG8_SB(1, 1), cB + hstep + kstep, voffB);
        PG8_WAIT_V(6); PG8_BAR;
    } else {
        PG8_STAGE(PG8_SB(0, 0), cB, voffB); PG8_STAGE(PG8_SA(0, 0), cA, voffA); PG8_STAGE(PG8_SB(0, 1), cB + hstep, voffB); PG8_STAGE(PG8_SA(0, 1), cA + hstep, voffA);
        if (wr == 1) PG8_BAR;
        PG8_WAIT_V(4); PG8_BAR;
        PG8_STAGE(PG8_SB(1, 0), cB + kstep, voffB); PG8_STAGE(PG8_SA(1, 0), cA + kstep, voffA); PG8_STAGE(PG8_SB(1, 1), cB + hstep + kstep, voffB);
        PG8_WAIT_V(6); PG8_BAR;
    }
    for (;;) {
        const bool has_next = S.next(ui + 1, nxt);
        const char* nA = has_next ? (const char*)g.A + (size_t)nxt.pm * tstep : cA; const char* nB = has_next ? (const char*)g.Bt + (size_t)nxt.pn * tstep : cB;
        for (int t = 0; t < nt; t += 2) {
            const bool last = (t == nt - 2);
            const char* a1 = cA + (size_t)(t + 1) * kstep;
            const char* a2 = last ? nA : cA + (size_t)(t + 2) * kstep; const char* b2 = last ? nB : cB + (size_t)(t + 2) * kstep;
            const char* a3 = a2 + kstep; const char* b3 = b2 + kstep;
            if (last && has_next) S.a_ready(nxt);
            if constexpr (SP2) {
            PG8_LDB(B0, 0, 0); PG8_LDB(B1, 0, 1); PG8_SCHED; PG8_LDA(At, 0, 0); PG8_STAGE(PG8_SA(1, 1), a1 + hstep, voffA);
            PG8_WAIT_V(8); PG8_WAIT_L(0); PG8_BAR; PG8_MMA(0, 0, At, B0); PG8_MMA(0, 1, At, B1); PG8_BAR; PG8_SCHED;
            PG8_LDA(At, 0, 1); PG8_STAGE(PG8_SB(0, 0), b2, voffB); PG8_STAGE(PG8_SB(0, 1), b2 + hstep, voffB); PG8_STAGE(PG8_SA(0, 0), a2, voffA);
            PG8_WAIT_V(8); PG8_WAIT_L(0); PG8_BAR; PG8_MMA(1, 0, At, B0); PG8_MMA(1, 1, At, B1); PG8_BAR; PG8_SCHED;
            PG8_LDB(B0, 1, 0); PG8_LDB(B1, 1, 1); PG8_SCHED; PG8_LDA(At, 1, 0); PG8_STAGE(PG8_SA(0, 1), a2 + hstep, voffA);
            PG8_WAIT_V(8); PG8_WAIT_L(0); PG8_BAR; PG8_MMA(0, 0, At, B0); PG8_MMA(0, 1, At, B1); PG8_BAR; PG8_SCHED;
            PG8_LDA(At, 1, 1); PG8_STAGE(PG8_SB(1, 0), b3, voffB); PG8_STAGE(PG8_SB(1, 1), b3 + hstep, voffB); PG8_STAGE(PG8_SA(1, 0), a3, voffA);
            PG8_WAIT_V(8); PG8_WAIT_L(0); PG8_BAR; PG8_MMA(1, 0, At, B0); PG8_MMA(1, 1, At, B1); PG8_BAR; PG8_SCHED;
            } else {
            PG8_LDB(B0, 0, 0); PG8_SCHED; PG8_LDA(At, 0, 0); PG8_STAGE(PG8_SA(1, 1), a1 + hstep, voffA);
            PG8_WAIT_L(8); PG8_BAR; PG8_WAIT_L(0); PG8_MMA(0, 0, At, B0); PG8_BAR; PG8_SCHED;
            PG8_LDB(B1, 0, 1); PG8_STAGE(PG8_SB(0, 0), b2, voffB);
            PG8_BAR; PG8_WAIT_L(0); PG8_MMA(0, 1, At, B1); PG8_BAR;
            PG8_LDA(At, 0, 1); PG8_STAGE(PG8_SA(0, 0), a2, voffA);
            PG8_BAR; PG8_WAIT_L(0); PG8_MMA(1, 0, At, B0); PG8_BAR; PG8_SCHED;
            PG8_STAGE(PG8_SB(0, 1), b2 + hstep, voffB);
            PG8_WAIT_V(6); PG8_BAR; PG8_MMA(1, 1, At, B1); PG8_BAR;
            PG8_LDB(B0, 1, 0); PG8_SCHED; PG8_LDA(At, 1, 0); PG8_STAGE(PG8_SA(0, 1), a2 + hstep, voffA);
            PG8_WAIT_L(8); PG8_BAR; PG8_WAIT_L(0); PG8_MMA(0, 0, At, B0); PG8_BAR; PG8_SCHED;
            PG8_LDB(B1, 1, 1); PG8_STAGE(PG8_SB(1, 0), b3, voffB);
            PG8_BAR; PG8_WAIT_L(0); PG8_MMA(0, 1, At, B1); PG8_BAR;
            PG8_LDA(At, 1, 1); PG8_STAGE(PG8_SA(1, 0), a3, voffA);
            PG8_BAR; PG8_WAIT_L(0); PG8_MMA(1, 0, At, B0); PG8_BAR; PG8_SCHED;
            PG8_STAGE(PG8_SB(1, 1), b3 + hstep, voffB);
            PG8_WAIT_V(6); PG8_BAR; PG8_MMA(1, 1, At, B1); PG8_BAR;
            }
        }
        if constexpr (ALIGN_EPI) { if (wr == 0) PG8_BAR; }
        if constexpr (!Epi::AFTER_DRAIN) { E(acc, cur, wr, wc, fr, fq); S.done(cur); }
        if (!has_next) break;
#pragma unroll
        for (int a = 0; a < 2; ++a)
#pragma unroll
            for (int b = 0; b < 2; ++b)
#pragma unroll
                for (int m = 0; m < 4; ++m)
#pragma unroll
                    for (int n = 0; n < 2; ++n) acc[a][b][m][n] = (f32x4){0.f, 0.f, 0.f, 0.f};
        cur = nxt; cA = nA; cB = nB; ++ui;
        if constexpr (ALIGN_EPI) { if (wr == 1) PG8_BAR; }
    }
    PG8_WAIT_V(0);
    if constexpr (!ALIGN_EPI) { if (wr == 0) PG8_BAR; }
    PG8_BAR;
    if constexpr (Epi::AFTER_DRAIN) { E.fused(acc, cur, wr, wc, fr, fq, lds, wid, lane); S.done(cur); }
#undef PG8_SA
#undef PG8_SB
#undef PG8_STAGE
#undef PG8_LDA
#undef PG8_LDB
#undef PG8_MMA
#undef PG8_WAIT_V
#undef PG8_WAIT_L
#undef PG8_BAR
#undef PG8_SCHED
}
}

#ifndef PG8_SP2
#define PG8_SP2 true
#endif
#ifndef PG8_ALIGN
#define PG8_ALIGN true
#endif
#include <hip/hip_bf16.h>
#include <cmath>
#include <hip/hip_bf16.h>
#include <cmath>
namespace attn_body {
using bf16=__hip_bfloat16;
using bf16x8=__attribute__((ext_vector_type(8)))short;
using s16x4=__attribute__((ext_vector_type(4)))short;
using f32x16=__attribute__((ext_vector_type(16)))float;
using u32x4=__attribute__((ext_vector_type(4)))unsigned;
constexpr int BATCH=8,NHEAD=16,SEQ=4096,D=64,DM=NHEAD*D,OPITCH=2048,VW=128;
constexpr int NW=8,QBLK=32,QB=QBLK*NW,KVBLK=64,NQB=SEQ/QB;
__device__ __forceinline__ int crow(int r,int hi){return (r&3)+8*(r>>2)+4*hi;}
#define SBAR() __builtin_amdgcn_sched_barrier(0)
__device__ __forceinline__ void cmask(f32x16&p0,f32x16&p1,int jb,int qrel,int hi){
  const float NEG=-INFINITY; int kb=64*jb+4*hi;
  #pragma unroll
  for(int r=0;r<16;++r){int kv=kb+(r&3)+8*(r>>2); if(kv>qrel)p0[r]=NEG; if(kv+32>qrel)p1[r]=NEG;}
}
constexpr int NSLOT=3, SLOTK=8192, SLOTV=16384, OSTP=272;
constexpr int LDS_K=0, LDS_V=NSLOT*SLOTK, LDS_WS=LDS_V+NSLOT*SLOTV, LDS_OST=LDS_WS+NW*64*4, LDS_BYTES=LDS_OST+NW*32*OSTP;
constexpr float C2=0.125f*1.4426950408889634f;
__device__ __forceinline__ void glds16(const void*gsrc,unsigned lds_dst){unsigned keep;
  asm volatile("s_mov_b32 %0, m0\n\ts_mov_b32 m0, %2\n\ts_nop 0\n\tglobal_load_lds_dwordx4 %1, off\n\ts_mov_b32 m0, %0":"=&s"(keep):"v"(gsrc),"s"(lds_dst):"memory");}
__device__ __forceinline__ float max3f(float a,float b,float c){float r;asm("v_max3_f32 %0, %1, %2, %3":"=v"(r):"v"(a),"v"(b),"v"(c));return r;}
__device__ __forceinline__ float max2f(float a,float b){float r;asm("v_max_f32_e32 %0, %1, %2":"=v"(r):"v"(a),"v"(b));return r;}
__device__ __forceinline__ float fsub_s(float a,float b){float r;asm("v_sub_f32_e32 %0, %1, %2":"=v"(r):"v"(a),"v"(b));return r;}
typedef float f32x2_t __attribute__((ext_vector_type(2))); typedef __bf16 bf16x2_t __attribute__((ext_vector_type(2)));
__device__ __forceinline__ unsigned cvtpk_s(float lo,float hi){f32x2_t v={lo,hi};bf16x2_t b=__builtin_convertvector(v,bf16x2_t);return __builtin_bit_cast(unsigned,b);}
#define WAIT_BAR(N) asm volatile("s_waitcnt vmcnt(" #N ") lgkmcnt(0)\n\ts_barrier":::"memory")
#define MFMA(a,b,c) __builtin_amdgcn_mfma_f32_32x32x16_bf16(a,b,c,0,0,0)
__device__ __forceinline__ void qkt(f32x16&p0,f32x16&p1,const char*Kslot,const bf16x8*qr,int r32,int hi){
  const char*kb=Kslot+hi*1024+r32*16;
  #pragma unroll
  for(int d0=0;d0<4;++d0){
    const bf16x8 b0=*reinterpret_cast<const bf16x8*>(kb+d0*2048);
    const bf16x8 b1=*reinterpret_cast<const bf16x8*>(kb+d0*2048+512);
    if(d0==0){p0=MFMA(b0,qr[0],f32x16{});p1=MFMA(b1,qr[0],f32x16{});}
    else{p0=MFMA(b0,qr[d0],p0);p1=MFMA(b1,qr[d0],p1);}}
}
typedef __attribute__((address_space(3))) const char* lds_cptr;
typedef short v4i16_t __attribute__((ext_vector_type(4)));
#define KLD(p) (*(const __attribute__((address_space(3))) bf16x8*)(p))
__device__ __forceinline__ s16x4 vtr(lds_cptr p){ return __builtin_bit_cast(s16x4,__builtin_amdgcn_ds_read_tr16_b64_v4i16((__attribute__((address_space(3))) v4i16_t*)p)); }
__device__ __forceinline__ float rowmax(const f32x16&p0,const f32x16&p1){
  float a=max3f(p0[0],p0[1],p1[0]),b=max3f(p0[2],p0[3],p1[1]);a=max3f(a,p1[2],p1[3]);
  #pragma unroll
  for(int r=4;r<16;r+=4){a=max3f(a,p0[r],p0[r+1]);b=max3f(b,p0[r+2],p0[r+3]);a=max3f(a,p1[r],p1[r+1]);b=max3f(b,p1[r+2],p1[r+3]);}
  const float m=max2f(a,b);
  auto rr=__builtin_amdgcn_permlane32_swap(__float_as_uint(m),__float_as_uint(m),false,false);
  return max2f(__uint_as_float(rr[0]),__uint_as_float(rr[1]));
}
__device__ __forceinline__ void pv4(f32x16*o,int vb,bf16x8 pa0,bf16x8 pa1,bf16x8 pa2,bf16x8 pa3){
  #pragma unroll
  for(int d0=0;d0<4;++d0){s16x4 lo[4],hi[4];
    #pragma unroll
    for(int ks=0;ks<4;++ks){
      asm volatile("ds_read_b64_tr_b16 %0,%1 offset:%c2":"=&v"(lo[ks]):"v"(vb),"i"(d0*4096+ks*1024):"memory");
      asm volatile("ds_read_b64_tr_b16 %0,%1 offset:%c2":"=&v"(hi[ks]):"v"(vb),"i"(d0*4096+ks*1024+512):"memory");}
    asm volatile("s_waitcnt lgkmcnt(0)":::"memory");SBAR();
    #define PK(k) (bf16x8){lo[k][0],lo[k][1],lo[k][2],lo[k][3],hi[k][0],hi[k][1],hi[k][2],hi[k][3]}
    o[d0]=MFMA(pa0,PK(0),o[d0]);
    o[d0]=MFMA(pa1,PK(1),o[d0]);
    o[d0]=MFMA(pa2,PK(2),o[d0]);
    o[d0]=MFMA(pa3,PK(3),o[d0]);
    #undef PK
  }
}
#ifndef ATTN_STORE16
#define ATTN_STORE16(p,v) (*(u32x4*)(p)=(v))
#endif
template<int THRL> __device__ __forceinline__ void attn_unit(int b,int h,int qb,const bf16*Q,const bf16*__restrict__ K,const bf16*__restrict__ V,bf16*O,char*shm,const int wave_){
  const int lane=lane_id_(),r32=lane&31,hi=lane>>5; const int wid=wave_;
  const long rowbase=(long)b*SEQ; const int q0=qb*QB;
  const bf16*Qw=Q+(rowbase+q0+wid*QBLK)*DM+h*D;
  const bf16*Kh=K+rowbase*DM+h*D,*Vh=V+rowbase*DM+(h>>1)*VW;
  const unsigned lds0=(unsigned)(uintptr_t)shm;
  float*wsf=(float*)(shm+LDS_WS)+wid*64;
  const bf16*ksrc=Kh+(long)lane*DM+wid*8;
  const bf16*vsrc=Vh+(long)(16*(wid&3)+(lane>>2))*DM+(wid>>2)*32+(lane&3)*8;
  const unsigned kdst=lds0+LDS_K+wid*1024, vdst=lds0+LDS_V+wid*1024;
  #define DMA_K(t,slot) glds16(ksrc+(long)(t)*KVBLK*DM,(unsigned)__builtin_amdgcn_readfirstlane(kdst+(slot)))
  #define DMA_V(t,slot) do{ glds16(vsrc+(long)(t)*KVBLK*DM,(unsigned)__builtin_amdgcn_readfirstlane(vdst+(slot))); glds16(vsrc+(long)(t)*KVBLK*DM+64,(unsigned)__builtin_amdgcn_readfirstlane(vdst+(slot)+8192)); }while(0)
  const char*Kbase=shm+LDS_K; bf16x8 kf[8];
  const lds_cptr shm3=(lds_cptr)shm; const lds_cptr kp0=shm3+LDS_K+hi*1024+r32*16; const lds_cptr vp0=shm3+LDS_V+((lane>>4)&1)*32+(lane&3)*8+(4*hi+((lane&15)>>2))*64;
  const int NT=(q0+QB)/KVBLK;
  DMA_K(0,0);DMA_V(0,0);DMA_K(1,SLOTK);
  bf16x8 qr[4];
  #pragma unroll
  for(int d0=0;d0<4;++d0)qr[d0]=*reinterpret_cast<const bf16x8*>(&Qw[(long)r32*DM+d0*16+hi*8]);
  float mhat=0.f,l_reg=0.f;f32x16 o[4];o[0]=f32x16{};o[1]=f32x16{};o[2]=f32x16{};o[3]=f32x16{};
  const int qrel=wid*QBLK+r32;
  #define CMASK(P0,P1,t) do{int jb_=(t)-(NT-4); if(jb_>=0)cmask(P0,P1,jb_,qrel,hi);}while(0)
  bool resc=false;
  #define RESC() do{ if(resc){ asm volatile("s_waitcnt lgkmcnt(0)":::"memory"); \
      _Pragma("unroll") for(int r=0;r<16;++r){ const float f_=wsf[crow(r,hi)]; o[0][r]*=f_; o[1][r]*=f_; o[2][r]*=f_; o[3][r]*=f_; } } }while(0)
  f32x16 C0,C1; u32x4 pwa0,pwa1,pwa2,pwa3;
  int sk_prev=0,sk_cur=0,sk_next=SLOTK, sv_prev=0,sv_cur=0,sv_next=SLOTV;
  #define ROT() do{sk_prev=sk_cur;sk_cur=sk_next;sk_next=(sk_next==(NSLOT-1)*SLOTK)?0:sk_next+SLOTK; sv_prev=sv_cur;sv_cur=sv_next;sv_next=(sv_next==(NSLOT-1)*SLOTV)?0:sv_next+SLOTV;}while(0)
  #define PKW(P,B) cvtpk_s(P[B],P[B+1])
  DMA_K(2,2*SLOTK);
  WAIT_BAR(4);
  qkt(C0,C1,Kbase,qr,r32,hi);asm volatile("s_nop 15\n\ts_nop 7":"+v"(C0),"+v"(C1));CMASK(C0,C1,0);
  { const float rm=rowmax(C0,C1); mhat=rm;
    _Pragma("unroll") for(int r=0;r<16;++r){C0[r]=fsub_s(C0[r],rm);C1[r]=fsub_s(C1[r],rm);}
    _Pragma("unroll") for(int r=0;r<16;++r){C0[r]=__builtin_amdgcn_exp2f(C0[r]);C1[r]=__builtin_amdgcn_exp2f(C1[r]);}
    float s_=0.f; _Pragma("unroll") for(int r=0;r<16;++r)s_+=C0[r]+C1[r]; l_reg=s_;
    pwa0=(u32x4){PKW(C0,0),PKW(C0,2),PKW(C0,4),PKW(C0,6)};pwa1=(u32x4){PKW(C0,8),PKW(C0,10),PKW(C0,12),PKW(C0,14)};pwa2=(u32x4){PKW(C1,0),PKW(C1,2),PKW(C1,4),PKW(C1,6)};pwa3=(u32x4){PKW(C1,8),PKW(C1,10),PKW(C1,12),PKW(C1,14)}; }
  WAIT_BAR(0);
  DMA_K(3,0);DMA_V(1,SLOTV);
  ROT();
  { _Pragma("unroll") for(int j=0;j<8;++j)kf[j]=KLD(kp0+sk_cur+(j>>1)*2048+(j&1)*512); }
  WAIT_BAR(3);
  s16x4 vlo[16],vhi[16];
  #define PAF(S,k) __builtin_bit_cast(bf16x8,pw##S##k)
  #define VFR(i) (bf16x8){vlo[i][0],vlo[i][1],vlo[i][2],vlo[i][3],vhi[i][0],vhi[i][1],vhi[i][2],vhi[i][3]}
  #define PIN(x) asm volatile("":"+v"(x))
  #define MX3(a,b,c) __builtin_fmaxf(__builtin_fmaxf((a),(b)),(c))
  #define EX(v) __builtin_amdgcn_exp2f(v)
  #define VRDL(i) vlo[i]=vtr(vp_+(((i)>>2)*4096+((i)&3)*1024))
  #define VRDH(i) vhi[i]=vtr(vp_+(((i)>>2)*4096+((i)&3)*1024+512))
  #define STEP_AB(t,GK,GV,GL) do{ SBAR(); \
    const lds_cptr vp_=vp0+sv_prev; \
     C0=MFMA(kf[0],qr[0],f32x16{}); SBAR(); \
     C1=MFMA(kf[1],qr[0],f32x16{}); SBAR(); \
    VRDL(0); SBAR(); C0=MFMA(kf[2],qr[1],C0); SBAR(); \
    VRDH(0); SBAR(); C1=MFMA(kf[3],qr[1],C1); SBAR(); \
    VRDL(4); SBAR(); C0=MFMA(kf[4],qr[2],C0); SBAR(); \
    VRDH(4); SBAR(); C1=MFMA(kf[5],qr[2],C1); SBAR(); \
    VRDL(8); SBAR(); C0=MFMA(kf[6],qr[3],C0); SBAR(); \
    VRDH(8); SBAR(); C1=MFMA(kf[7],qr[3],C1); SBAR(); \
    if(GK){DMA_K((t)+3,sk_cur);} if(GV){DMA_V((t)+1,sv_next);} \
    CMASK(C0,C1,t); \
    { float a=MX3(C0[0],C0[1],C1[0]),b=MX3(C0[2],C0[3],C1[1]); a=MX3(a,C1[2],C1[3]); \
      _Pragma("unroll") for(int r=4;r<16;r+=4){a=MX3(a,C0[r],C0[r+1]);b=MX3(b,C0[r+2],C0[r+3]);a=MX3(a,C1[r],C1[r+1]);b=MX3(b,C1[r+2],C1[r+3]);} \
      float rm=__builtin_fmaxf(a,b); { auto rr=__builtin_amdgcn_permlane32_swap(__float_as_uint(rm),__float_as_uint(rm),false,false); rm=__builtin_fmaxf(__uint_as_float(rr[0]),__uint_as_float(rr[1])); } \
      resc=false; \
      rm-=mhat; \
      if(__builtin_expect(__any(rm>(float)THRL),0)){ const float dl=__builtin_fmaxf(rm,0.f); mhat+=dl; \
        const float f=__builtin_amdgcn_exp2f(-dl); l_reg*=f; if(hi==0)wsf[r32]=f; resc=true; } \
      _Pragma("unroll") for(int r=0;r<16;++r){C0[r]-=mhat;C1[r]-=mhat;} } \
    SBAR(); float sacc=0.f; \
    VRDL(12); VRDH(12); SBAR(); o[0]=MFMA(PAF(a,0),VFR(0),o[0]); C0[0]=EX(C0[0]); C0[1]=EX(C0[1]); PIN(C0); SBAR(); \
    VRDL(1); VRDH(1); SBAR(); o[1]=MFMA(PAF(a,0),VFR(4),o[1]); C0[2]=EX(C0[2]); C0[3]=EX(C0[3]); PIN(C0); sacc+=(C0[0]+C0[1]); PIN(sacc); SBAR(); \
    VRDL(5); VRDH(5); SBAR(); o[2]=MFMA(PAF(a,0),VFR(8),o[2]); C0[4]=EX(C0[4]); C0[5]=EX(C0[5]); PIN(C0); sacc+=(C0[2]+C0[3]); PIN(sacc); SBAR(); \
    VRDL(9); VRDH(9); SBAR(); o[3]=MFMA(PAF(a,0),VFR(12),o[3]); C0[6]=EX(C0[6]); C0[7]=EX(C0[7]); PIN(C0); sacc+=(C0[4]+C0[5]); PIN(sacc); SBAR(); \
    VRDL(13); VRDH(13); if(GL){ kf[0]=KLD(kp0+sk_next+0); } SBAR(); o[0]=MFMA(PAF(a,1),VFR(1),o[0]); C0[8]=EX(C0[8]); C0[9]=EX(C0[9]); PIN(C0); sacc+=(C0[6]+C0[7]); PIN(sacc); pwa0[0]=PKW(C0,0); PIN(pwa0); SBAR(); \
    VRDL(2); VRDH(2); if(GL){ kf[1]=KLD(kp0+sk_next+512); } SBAR(); o[1]=MFMA(PAF(a,1),VFR(5),o[1]); C0[10]=EX(C0[10]); C0[11]=EX(C0[11]); PIN(C0); sacc+=(C0[8]+C0[9]); PIN(sacc); pwa0[1]=PKW(C0,2); PIN(pwa0); SBAR(); \
    VRDL(6); VRDH(6); if(GL){ kf[2]=KLD(kp0+sk_next+2048); } SBAR(); o[2]=MFMA(PAF(a,1),VFR(9),o[2]); C0[12]=EX(C0[12]); C0[13]=EX(C0[13]); PIN(C0); sacc+=(C0[10]+C0[11]); PIN(sacc); pwa0[2]=PKW(C0,4); PIN(pwa0); SBAR(); \
    VRDL(10); VRDH(10); if(GL){ kf[3]=KLD(kp0+sk_next+2560); } SBAR(); o[3]=MFMA(PAF(a,1),VFR(13),o[3]); C0[14]=EX(C0[14]); C0[15]=EX(C0[15]); PIN(C0); sacc+=(C0[12]+C0[13]); PIN(sacc); pwa0[3]=PKW(C0,6); PIN(pwa0); SBAR(); \
    VRDL(14); VRDH(14); if(GL){ kf[4]=KLD(kp0+sk_next+4096); } SBAR(); o[0]=MFMA(PAF(a,2),VFR(2),o[0]); C1[0]=EX(C1[0]); C1[1]=EX(C1[1]); PIN(C1); sacc+=(C0[14]+C0[15]); PIN(sacc); pwa1[0]=PKW(C0,8); PIN(pwa1); SBAR(); \
    VRDL(3); VRDH(3); if(GL){ kf[5]=KLD(kp0+sk_next+4608); } SBAR(); o[1]=MFMA(PAF(a,2),VFR(6),o[1]); C1[2]=EX(C1[2]); C1[3]=EX(C1[3]); PIN(C1); sacc+=(C1[0]+C1[1]); PIN(sacc); pwa1[1]=PKW(C0,10); PIN(pwa1); SBAR(); \
    VRDL(7); VRDH(7); if(GL){ kf[6]=KLD(kp0+sk_next+6144); } SBAR(); o[2]=MFMA(PAF(a,2),VFR(10),o[2]); C1[4]=EX(C1[4]); C1[5]=EX(C1[5]); PIN(C1); sacc+=(C1[2]+C1[3]); PIN(sacc); pwa1[2]=PKW(C0,12); PIN(pwa1); SBAR(); \
    VRDL(11); VRDH(11); if(GL){ kf[7]=KLD(kp0+sk_next+6656); } SBAR(); o[3]=MFMA(PAF(a,2),VFR(14),o[3]); C1[6]=EX(C1[6]); C1[7]=EX(C1[7]); PIN(C1); sacc+=(C1[4]+C1[5]); PIN(sacc); pwa1[3]=PKW(C0,14); PIN(pwa1); SBAR(); \
    VRDL(15); VRDH(15); SBAR(); o[0]=MFMA(PAF(a,3),VFR(3),o[0]); C1[8]=EX(C1[8]); C1[9]=EX(C1[9]); PIN(C1); sacc+=(C1[6]+C1[7]); PIN(sacc); pwa2[0]=PKW(C1,0); PIN(pwa2); SBAR(); \
    o[1]=MFMA(PAF(a,3),VFR(7),o[1]); C1[10]=EX(C1[10]); C1[11]=EX(C1[11]); PIN(C1); sacc+=(C1[8]+C1[9]); PIN(sacc); pwa2[1]=PKW(C1,2); PIN(pwa2); SBAR(); \
    o[2]=MFMA(PAF(a,3),VFR(11),o[2]); C1[12]=EX(C1[12]); C1[13]=EX(C1[13]); PIN(C1); sacc+=(C1[10]+C1[11]); PIN(sacc); pwa2[2]=PKW(C1,4); PIN(pwa2); SBAR(); \
    o[3]=MFMA(PAF(a,3),VFR(15),o[3]); C1[14]=EX(C1[14]); C1[15]=EX(C1[15]); PIN(C1); sacc+=(C1[12]+C1[13]); PIN(sacc); pwa2[3]=PKW(C1,6); PIN(pwa2); SBAR(); \
    sacc+=(C1[14]+C1[15]); pwa3[0]=PKW(C1,8); pwa3[1]=PKW(C1,10); pwa3[2]=PKW(C1,12); pwa3[3]=PKW(C1,14); PIN(pwa3); l_reg+=sacc; \
    }while(0)
  #define STEP_BA(t,GK,GV,GL) do{ SBAR(); \
    const lds_cptr vp_=vp0+sv_prev; \
     C0=MFMA(kf[0],qr[0],f32x16{}); SBAR(); \
     C1=MFMA(kf[1],qr[0],f32x16{}); SBAR(); \
    VRDL(0); SBAR(); C0=MFMA(kf[2],qr[1],C0); SBAR(); \
    VRDH(0); SBAR(); C1=MFMA(kf[3],qr[1],C1); SBAR(); \
    VRDL(4); SBAR(); C0=MFMA(kf[4],qr[2],C0); SBAR(); \
    VRDH(4); SBAR(); C1=MFMA(kf[5],qr[2],C1); SBAR(); \
    VRDL(8); SBAR(); C0=MFMA(kf[6],qr[3],C0); SBAR(); \
    VRDH(8); SBAR(); C1=MFMA(kf[7],qr[3],C1); SBAR(); \
    if(GK){DMA_K((t)+3,sk_cur);} if(GV){DMA_V((t)+1,sv_next);} \
    CMASK(C0,C1,t); \
    { float a=MX3(C0[0],C0[1],C1[0]),b=MX3(C0[2],C0[3],C1[1]); a=MX3(a,C1[2],C1[3]); \
      _Pragma("unroll") for(int r=4;r<16;r+=4){a=MX3(a,C0[r],C0[r+1]);b=MX3(b,C0[r+2],C0[r+3]);a=MX3(a,C1[r],C1[r+1]);b=MX3(b,C1[r+2],C1[r+3]);} \
      float rm=__builtin_fmaxf(a,b); { auto rr=__builtin_amdgcn_permlane32_swap(__float_as_uint(rm),__float_as_uint(rm),false,false); rm=__builtin_fmaxf(__uint_as_float(rr[0]),__uint_as_float(rr[1])); } \
      resc=false; \
      rm-=mhat; \
      if(__builtin_expect(__any(rm>(float)THRL),0)){ const float dl=__builtin_fmaxf(rm,0.f); mhat+=dl; \
        const float f=__builtin_amdgcn_exp2f(-dl); l_reg*=f; if(hi==0)wsf[r32]=f; resc=true; } \
      _Pragma("unroll") for(int r=0;r<16;++r){C0[r]-=mhat;C1[r]-=mhat;} } \
    SBAR(); float sacc=0.f; \
    VRDL(12); VRDH(12); SBAR(); o[0]=MFMA(PAF(a,0),VFR(0),o[0]); C0[0]=EX(C0[0]); C0[1]=EX(C0[1]); PIN(C0); SBAR(); \
    VRDL(1); VRDH(1); SBAR(); o[1]=MFMA(PAF(a,0),VFR(4),o[1]); C0[2]=EX(C0[2]); C0[3]=EX(C0[3]); PIN(C0); sacc+=(C0[0]+C0[1]); PIN(sacc); SBAR(); \
    VRDL(5); VRDH(5); SBAR(); o[2]=MFMA(PAF(a,0),VFR(8),o[2]); C0[4]=EX(C0[4]); C0[5]=EX(C0[5]); PIN(C0); sacc+=(C0[2]+C0[3]); PIN(sacc); SBAR(); \
    VRDL(9); VRDH(9); SBAR(); o[3]=MFMA(PAF(a,0),VFR(12),o[3]); C0[6]=EX(C0[6]); C0[7]=EX(C0[7]); PIN(C0); sacc+=(C0[4]+C0[5]); PIN(sacc); SBAR(); \
    VRDL(13); VRDH(13); if(GL){ kf[0]=KLD(kp0+sk_next+0); } SBAR(); o[0]=MFMA(PAF(a,1),VFR(1),o[0]); C0[8]=EX(C0[8]); C0[9]=EX(C0[9]); PIN(C0); sacc+=(C0[6]+C0[7]); PIN(sacc); pwa0[0]=PKW(C0,0); PIN(pwa0); SBAR(); \
    VRDL(2); VRDH(2); if(GL){ kf[1]=KLD(kp0+sk_next+512); } SBAR(); o[1]=MFMA(PAF(a,1),VFR(5),o[1]); C0[10]=EX(C0[10]); C0[11]=EX(C0[11]); PIN(C0); sacc+=(C0[8]+C0[9]); PIN(sacc); pwa0[1]=PKW(C0,2); PIN(pwa0); SBAR(); \
    VRDL(6); VRDH(6); if(GL){ kf[2]=KLD(kp0+sk_next+2048); } SBAR(); o[2]=MFMA(PAF(a,1),VFR(9),o[2]); C0[12]=EX(C0[12]); C0[13]=EX(C0[13]); PIN(C0); sacc+=(C0[10]+C0[11]); PIN(sacc); pwa0[2]=PKW(C0,4); PIN(pwa0); SBAR(); \
    VRDL(10); VRDH(10); if(GL){ kf[3]=KLD(kp0+sk_next+2560); } SBAR(); o[3]=MFMA(PAF(a,1),VFR(13),o[3]); C0[14]=EX(C0[14]); C0[15]=EX(C0[15]); PIN(C0); sacc+=(C0[12]+C0[13]); PIN(sacc); pwa0[3]=PKW(C0,6); PIN(pwa0); SBAR(); \
    VRDL(14); VRDH(14); if(GL){ kf[4]=KLD(kp0+sk_next+4096); } SBAR(); o[0]=MFMA(PAF(a,2),VFR(2),o[0]); C1[0]=EX(C1[0]); C1[1]=EX(C1[1]); PIN(C1); sacc+=(C0[14]+C0[15]); PIN(sacc); pwa1[0]=PKW(C0,8); PIN(pwa1); SBAR(); \
    VRDL(3); VRDH(3); if(GL){ kf[5]=KLD(kp0+sk_next+4608); } SBAR(); o[1]=MFMA(PAF(a,2),VFR(6),o[1]); C1[2]=EX(C1[2]); C1[3]=EX(C1[3]); PIN(C1); sacc+=(C1[0]+C1[1]); PIN(sacc); pwa1[1]=PKW(C0,10); PIN(pwa1); SBAR(); \
    VRDL(7); VRDH(7); if(GL){ kf[6]=KLD(kp0+sk_next+6144); } SBAR(); o[2]=MFMA(PAF(a,2),VFR(10),o[2]); C1[4]=EX(C1[4]); C1[5]=EX(C1[5]); PIN(C1); sacc+=(C1[2]+C1[3]); PIN(sacc); pwa1[2]=PKW(C0,12); PIN(pwa1); SBAR(); \
    VRDL(11); VRDH(11); if(GL){ kf[7]=KLD(kp0+sk_next+6656); } SBAR(); o[3]=MFMA(PAF(a,2),VFR(14),o[3]); C1[6]=EX(C1[6]); C1[7]=EX(C1[7]); PIN(C1); sacc+=(C1[4]+C1[5]); PIN(sacc); pwa1[3]=PKW(C0,14); PIN(pwa1); SBAR(); \
    VRDL(15); VRDH(15); SBAR(); o[0]=MFMA(PAF(a,3),VFR(3),o[0]); C1[8]=EX(C1[8]); C1[9]=EX(C1[9]); PIN(C1); sacc+=(C1[6]+C1[7]); PIN(sacc); pwa2[0]=PKW(C1,0); PIN(pwa2); SBAR(); \
    o[1]=MFMA(PAF(a,3),VFR(7),o[1]); C1[10]=EX(C1[10]); C1[11]=EX(C1[11]); PIN(C1); sacc+=(C1[8]+C1[9]); PIN(sacc); pwa2[1]=PKW(C1,2); PIN(pwa2); SBAR(); \
    o[2]=MFMA(PAF(a,3),VFR(11),o[2]); C1[12]=EX(C1[12]); C1[13]=EX(C1[13]); PIN(C1); sacc+=(C1[10]+C1[11]); PIN(sacc); pwa2[2]=PKW(C1,4); PIN(pwa2); SBAR(); \
    o[3]=MFMA(PAF(a,3),VFR(15),o[3]); C1[14]=EX(C1[14]); C1[15]=EX(C1[15]); PIN(C1); sacc+=(C1[12]+C1[13]); PIN(sacc); pwa2[3]=PKW(C1,6); PIN(pwa2); SBAR(); \
    sacc+=(C1[14]+C1[15]); pwa3[0]=PKW(C1,8); pwa3[1]=PKW(C1,10); pwa3[2]=PKW(C1,12); pwa3[3]=PKW(C1,14); PIN(pwa3); l_reg+=sacc; \
    }while(0)

  int t=1;
  #undef CMASK
  #define CMASK(P0,P1,t) do{}while(0)
  for(;t+5<NT;t+=2){
    STEP_AB(t,true,true,true);     WAIT_BAR(3); RESC(); ROT();
    STEP_BA(t+1,true,true,true);   WAIT_BAR(3); RESC(); ROT();
  }
  #undef CMASK
  #define CMASK(P0,P1,t) do{int jb_=(t)-(NT-4); if(jb_>=0)cmask(P0,P1,jb_,qrel,hi);}while(0)
  #define ENDW(tt) do{ if((tt)+3<NT){WAIT_BAR(3);} else if((tt)+2<NT){WAIT_BAR(2);} else {WAIT_BAR(0);} }while(0)
  for(;t+1<NT;t+=2){
    STEP_AB(t,(t+3<NT),(t+1<NT),(t+1<NT));       ENDW(t);   RESC(); ROT();
    STEP_BA(t+1,(t+4<NT),(t+2<NT),(t+2<NT));     ENDW(t+1); RESC(); ROT();
  }
  STEP_AB(NT-1,false,false,false); RESC();
  SBAR(); pv4(o,(int)(unsigned long)(vp0+sv_cur),PAF(a,0),PAF(a,1),PAF(a,2),PAF(a,3));
  #undef PKW
  #undef PAF
  #undef VFR
  #undef PIN
  #undef MX3
  #undef EX
  #undef VRDL
  #undef VRDH
  #undef STEP_AB
  #undef STEP_BA
  #undef ENDW
  {auto rr=__builtin_amdgcn_permlane32_swap(__float_as_uint(l_reg),__float_as_uint(l_reg),false,false);l_reg=__uint_as_float(rr[0])+__uint_as_float(rr[1]);}
  if(hi==0)wsf[32+r32]=l_reg;asm volatile("s_waitcnt lgkmcnt(0)":::"memory");
  float rli[16];
  #pragma unroll
  for(int r=0;r<16;++r)rli[r]=__builtin_amdgcn_rcpf(wsf[32+crow(r,hi)]);
  int l2_=lane_id_(); asm volatile("":"+v"(l2_));
  bf16*Ow=O+(rowbase+q0+wid*QBLK)*OPITCH+h*VW;
  { char*stg=shm+LDS_OST+wid*(32*OSTP);
    #pragma unroll
    for(int r=0;r<16;++r){const int orow=crow(r,hi);
      #pragma unroll
      for(int d0=0;d0<4;++d0)*(bf16*)(stg+orow*OSTP+(d0*32+r32)*2)=__float2bfloat16(o[d0][r]*rli[r]);}
    asm volatile("s_waitcnt lgkmcnt(0)":::"memory");
    #pragma unroll
    for(int i=0;i<8;++i){const int row=i*4+(l2_>>4),ch=l2_&15; const u32x4 v=*(const u32x4*)(stg+row*OSTP+ch*16); ATTN_STORE16(Ow+(long)row*OPITCH+ch*8,v);} }
  asm volatile("s_waitcnt lgkmcnt(0)\n\ts_barrier":::"memory");
  #undef DMA_K
  #undef DMA_V
  #undef CMASK
  #undef RESC
  #undef ROT
}
constexpr int ATTN_LDS_BYTES=LDS_BYTES;
struct AttnTensors { const bf16* Q; const bf16* K; const bf16* V; bf16* O; };
struct AttnUnit { int bh; int qb; };
struct StaticOrder {
  int vcu, G;
  __device__ __forceinline__ explicit StaticOrder(int vcu_,int G_):vcu(vcu_),G(G_){}
  __device__ __forceinline__ bool next(int i,AttnUnit&u)const{ const int w=vcu+(i>>3)*G; if(w>=BATCH*NHEAD*2)return false; u.bh=w>>1; const int j=w&1,k=i&7,base=4*(k>>1); u.qb=(k&1)?(base+3-j):(base+j); return true; }
};
template<class Sched,int THRL=8> __device__ __forceinline__ void attn_phase(char*lds,const AttnTensors&T,const Sched&S,const int wave_){
  AttnUnit u;
  for(int i=0;S.next(i,u);++i){ attn_unit<THRL>(u.bh/NHEAD,u.bh%NHEAD,u.qb,T.Q,T.K,T.V,T.O,lds,wave_); }
}
#undef SBAR
#undef WAIT_BAR
#undef MFMA
#undef KLD
}
#define GAS __attribute__((address_space(1)))
#define LAS __attribute__((address_space(3)))
#define XB_TMO      128
#define XB_XCNT(j)  (256  + 64 * (j))
#define XB_XSUB(j)  (1280 + 64 * (j))
#define XB_XGEN(j)  (2304 + 64 * (j))
#define XB_TOP      3328
#define XB_TOPGEN   3392
#define XCD_BAR_WORDS 3456
#define XB_SPIN_CAP (1u << 18)

__device__ __forceinline__ unsigned xb_ld(unsigned* p)              { return __hip_atomic_load(p, __ATOMIC_RELAXED, __HIP_MEMORY_SCOPE_AGENT); }
__device__ __forceinline__ unsigned xb_add(unsigned* p, unsigned v) { return __hip_atomic_fetch_add(p, v, __ATOMIC_RELAXED, __HIP_MEMORY_SCOPE_AGENT); }
__device__ __forceinline__ unsigned xb_xcc_id() { return (unsigned)__builtin_amdgcn_s_getreg((3 << 11) | 20) & 0xFu; }
#define XB_SPIN(cond, bar) do { unsigned _sp = 0; while (cond) { __builtin_amdgcn_s_sleep(1); \
    if ((++_sp & 255u) == 0u) { if (xb_ld(&(bar)[XB_TMO])) break; if (_sp > XB_SPIN_CAP) { atomicAdd(&(bar)[XB_TMO], 1u); break; } } } } while (0)

struct XcdBarrier {
    unsigned* bar; unsigned x;
    volatile LAS unsigned* st;
};

__device__ __forceinline__ XcdBarrier xcd_barrier_post(unsigned* bar, volatile LAS unsigned* st, const bool lane0w0) {
    XcdBarrier b; b.bar = bar; b.x = xb_xcc_id(); b.st = st;
    if (lane0w0) (void)xb_add(&bar[XB_XCNT(b.x)], 1u);
    return b;
}
__device__ __forceinline__ void xcd_barrier_complete(unsigned* bar, unsigned x, unsigned& nloc, unsigned& nx) {
    const unsigned G = gridDim.x * gridDim.y * gridDim.z;
    unsigned sum, cnt, mine, sp = 0u;
    for (;;) {
        sum = 0u; cnt = 0u; mine = 0u;
#pragma unroll
        for (unsigned j = 0; j < 16; ++j) { const unsigned c = xb_ld(&bar[XB_XCNT(j)]); sum += c; cnt += (c > 0u) ? 1u : 0u; mine = (j == x) ? c : mine; }
        if (sum == G) break;
        __builtin_amdgcn_s_sleep(1);
        if ((++sp & 255u) == 0u) { if (xb_ld(&bar[XB_TMO])) break; if (sp > XB_SPIN_CAP) { atomicAdd(&bar[XB_TMO], 1u); break; } }
    }
    nloc = mine > 0u ? mine : 1u; nx = cnt > 0u ? cnt : 1u;
}

__device__ __forceinline__ void xcd_barrier(const XcdBarrier& b, const bool lane0w0) {
    asm volatile("s_waitcnt vmcnt(0)" ::: "memory");
    __syncthreads();
    if (lane0w0) {
        unsigned* bar = b.bar;
        __builtin_amdgcn_s_waitcnt(0);
        unsigned nloc = b.st[0], nx = b.st[1];
        if (nloc == 0u) { xcd_barrier_complete(bar, b.x, nloc, nx); b.st[0] = nloc; b.st[1] = nx; }
        const unsigned old = xb_add(&bar[XB_XSUB(b.x)], 1u);
        const unsigned gen = old / nloc;
        if (old + 1u == (gen + 1u) * nloc) {
            __builtin_amdgcn_fence(__ATOMIC_RELEASE, "agent");
            asm volatile("s_waitcnt vmcnt(0)" ::: "memory");
            const unsigned og = xb_add(&bar[XB_TOP], 1u);
            const unsigned tg = og / nx;
            if (og + 1u == (tg + 1u) * nx) xb_add(&bar[XB_TOPGEN], 1u);
            else XB_SPIN(xb_ld(&bar[XB_TOPGEN]) == tg, bar);
            __builtin_amdgcn_fence(__ATOMIC_ACQUIRE, "agent");
            xb_add(&bar[XB_XGEN(b.x)], 1u);
            asm volatile("s_waitcnt vmcnt(0)" ::: "memory");
        } else {
            XB_SPIN(xb_ld(&bar[XB_XGEN(b.x)]) == gen, bar);
            __builtin_amdgcn_fence(__ATOMIC_ACQUIRE, "agent");
            asm volatile("s_waitcnt vmcnt(0)" ::: "memory");
        }
    }
    __syncthreads();
}
namespace cg = cooperative_groups;
constexpr int NWAVES = 8;
constexpr int BATCH = 8, SEQ = 4096, D = 1024, M = BATCH * SEQ, NIN = 8192;
constexpr float NORM_EPS = 1e-6f;
constexpr float LAM_INIT = 0.2f;
constexpr size_t MiB = 1u << 20, SLOT = 64 * MiB;
constexpr size_t WS_XR = 0 * SLOT, WS_ZR = 1 * SLOT  , WS_Q = 2 * SLOT  , WS_K = 3 * SLOT  , WS_V = 4 * SLOT  , WS_ZA = 5 * SLOT  , WS_U = 6 * SLOT;
constexpr size_t WS_MISC = 7 * SLOT;
constexpr size_t WS_CTL = WS_MISC, CTL_ZERO_BYTES = 64 * 1024;
constexpr size_t WS_CARRY = WS_MISC + 1 * MiB;
constexpr size_t WS_STATS = WS_MISC + 2 * MiB;
constexpr size_t WS_WIN = WS_MISC + 4 * MiB;
constexpr size_t WS_WR = WS_MISC + 20 * MiB, WS_WA = WS_MISC + 22 * MiB, WS_WO = WS_MISC + 24 * MiB, WS_END = WS_MISC + 26 * MiB;
constexpr int LDS_BYTES = 147456;
constexpr int MISC_OFF = 147456 - 256;

typedef unsigned short bf16;
typedef unsigned v4u __attribute__((ext_vector_type(4)));
typedef float f32x4 __attribute__((ext_vector_type(4)));
typedef float f32x16 __attribute__((ext_vector_type(16)));
typedef short bf16x8 __attribute__((ext_vector_type(8)));
#define LDS_WAIT() asm volatile("s_waitcnt lgkmcnt(0)" ::: "memory")
__device__ __forceinline__ unsigned f2bf(float f) { unsigned u = __builtin_bit_cast(unsigned, f); return (u + 0x7fffu + ((u >> 16) & 1u)) >> 16; }
typedef float f32x2_ __attribute__((ext_vector_type(2))); typedef __bf16 bf16x2_ __attribute__((ext_vector_type(2)));
__device__ __forceinline__ unsigned pk2(float lo, float hi) { f32x2_ v = {lo, hi}; return __builtin_bit_cast(unsigned, __builtin_convertvector(v, bf16x2_)); }
__device__ __forceinline__ float bflo(unsigned w) { return __builtin_bit_cast(float, w << 16); }
__device__ __forceinline__ float bfhi(unsigned w) { return __builtin_bit_cast(float, w & 0xffff0000u); }
__device__ __forceinline__ float sigm(float v) { return __builtin_amdgcn_rcpf(1.0f + __builtin_amdgcn_exp2f(-1.4426950408889634f * v)); }
__device__ __forceinline__ float wave_sum(float v) {
#pragma unroll
    for (int o = 1; o < 64; o <<= 1) v += __shfl_xor(v, o);
    return v;
}

struct Frame {
    LAS unsigned char* lds;
    int wave, vcu, G;
    const float* in[19]; float* out; unsigned char* ws;
};
enum { I_X = 0, I_PREG, I_POSTG, I_WIN, I_CONVW, I_CONVB, I_WA, I_BA, I_WX, I_BX, I_LRUA, I_LQ1, I_LK1, I_LQ2, I_LK2, I_SUBG, I_WBR, I_WBA, I_WOUT };

__device__ __forceinline__ void p0_transpose_item(const float* W, int K, int N, bf16* WT, LAS float* scr, int item, int lane) {
    const int nblk = N / 32, kb = item / nblk, nb = item % nblk, k0 = 64 * kb, n0 = 32 * nb;
#pragma unroll 8
    for (int i = 0; i < 32; ++i) { const int kk = 2 * i + (lane >> 5); scr[kk * 33 + (lane & 31)] = W[(size_t)(k0 + kk) * N + n0 + (lane & 31)]; }
    LDS_WAIT(); asm volatile("" ::: "memory");
    const int c = lane & 7;
#pragma unroll
    for (int j = 0; j < 4; ++j) { const int n = (lane >> 3) + 8 * j; const LAS float* s = scr + (8 * c) * 33 + n;
        v4u o; o.x = pk2(s[0 * 33], s[1 * 33]); o.y = pk2(s[2 * 33], s[3 * 33]); o.z = pk2(s[4 * 33], s[5 * 33]); o.w = pk2(s[6 * 33], s[7 * 33]);
        *(GAS v4u*)(WT + (size_t)(n0 + n) * K + k0 + 8 * c) = o; }
    LDS_WAIT(); asm volatile("" ::: "memory");
}
__device__ __forceinline__ void p0_prologue(Frame& F) {
    LAS float* scr = (LAS float*)(F.lds + F.wave * 16384);
    const int gw = F.vcu * NWAVES + F.wave, NGW = F.G * NWAVES;
    constexpr int I_BIG = (D / 64) * (NIN / 32), I_SM = (D / 64) * (D / 32);
    constexpr int NITEMS = I_BIG + 3 * I_SM;
    for (int it = gw; it < NITEMS; it += NGW) {
        int r = it;
        if (r < I_BIG) { p0_transpose_item(F.in[I_WIN], D, NIN, (bf16*)(F.ws + WS_WIN), scr, r, lane_id_()); continue; } r -= I_BIG;
        if (r < I_SM) { p0_transpose_item(F.in[I_WBR], D, D, (bf16*)(F.ws + WS_WR), scr, r, lane_id_()); continue; } r -= I_SM;
        if (r < I_SM) { p0_transpose_item(F.in[I_WBA], D, D, (bf16*)(F.ws + WS_WA), scr, r, lane_id_()); continue; } r -= I_SM;
        p0_transpose_item(F.in[I_WOUT], D, D, (bf16*)(F.ws + WS_WO), scr, r, lane_id_());
    }
    const GAS f32x4* gp = (const GAS f32x4*)F.in[I_PREG] + lane_id_();
    f32x4 gg[4];
#pragma unroll
    for (int j = 0; j < 4; ++j) gg[j] = gp[64 * j];
    for (int m = gw; m < M; m += NGW) {
        const GAS f32x4* xr = (const GAS f32x4*)(F.in[I_X] + (size_t)m * D) + lane_id_();
        f32x4 v[4]; float s = 0.f;
#pragma unroll
        for (int j = 0; j < 4; ++j) { v[j] = xr[64 * j]; s += (v[j].x * v[j].x + v[j].y * v[j].y) + (v[j].z * v[j].z + v[j].w * v[j].w); }
        const float rstd = 1.0f / sqrtf(wave_sum(s) * (1.f / D) + NORM_EPS);
        GAS unsigned long long* o8 = (GAS unsigned long long*)((bf16*)(F.ws + WS_U) + (size_t)m * D) + lane_id_();
#pragma unroll
        for (int j = 0; j < 4; ++j) { const f32x4 y = v[j] * rstd * gg[j]; o8[64 * j] = (unsigned long long)pk2(y.x, y.y) | ((unsigned long long)pk2(y.z, y.w) << 32); }
    }
}

constexpr int SC_WFRAG = 0;
constexpr int SC_CONV = 16384;
constexpr int SC_WAVE = 16384 + 2048, SC_WAVE_BYTES = 5120 + 4608;
__device__ __forceinline__ int crow16(int r, int hi) { return (r & 3) + 8 * (r >> 2) + 4 * hi; }
template <bool PASS2> __device__ __forceinline__ void scan_phase(Frame& F) {
    const int lane = lane_id_(), tid_ = F.wave * 64 + lane, r32 = lane & 31, hi = lane >> 5;
    LAS unsigned char* const lw = F.lds + SC_WAVE + F.wave * SC_WAVE_BYTES;
    LAS unsigned char* const lz = lw + 5120;
    const LAS float* const lc = (const LAS float*)(F.lds + SC_CONV);
    const bf16* XR = (const bf16*)(F.ws + WS_XR); bf16* ZR = (bf16*)(F.ws + WS_ZR);
    float* carry = (float*)(F.ws + WS_CARRY);
    for (int wi = F.vcu; wi < BATCH * 16 * 2; wi += F.G) {
        const int b = wi >> 5, g = (wi >> 1) & 15, half = wi & 1, sc = half * 8 + F.wave, c0 = g * 64;
        __syncthreads();
        for (int idx = tid_; idx < 1024; idx += NWAVES * 64) {
            const int mat = idx >> 9, f = (idx >> 6) & 7, kk = f >> 1, nt = f & 1, ln = idx & 63, n = 32 * nt + (ln & 31), kb = 16 * kk + 8 * (ln >> 5);
            const float* W = F.in[mat ? I_WX : I_WA] + (size_t)(g * 64 + kb) * 64 + n;
            v4u o; o.x = pk2(W[0], W[64]); o.y = pk2(W[128], W[192]); o.z = pk2(W[256], W[320]); o.w = pk2(W[384], W[448]);
            *(LAS v4u*)(F.lds + SC_WFRAG + idx * 16) = o;
        }
        if (tid_ < 320) { const int tap = tid_ >> 6, ch = tid_ & 63; ((LAS float*)(F.lds + SC_CONV))[tid_] = (tap < 4) ? F.in[I_CONVW][tap * D + c0 + ch] : F.in[I_CONVB][c0 + ch]; }
        __syncthreads();
        float cba[2], cbx[2], ckc[2], H[2], P[2];
#pragma unroll
        for (int nt = 0; nt < 2; ++nt) { const int c = c0 + 32 * nt + r32; cba[nt] = F.in[I_BA][c]; cbx[nt] = F.in[I_BX][c];
            ckc[nt] = -8.0f * 1.4426950408889634f * log1pf(expf(-F.in[I_LRUA][c])); H[nt] = 0.f; P[nt] = 1.f; }
        if (PASS2) {
            for (int j0 = 0; j0 < sc; j0 += 8) {
                float2 ab[8][2];
#pragma unroll
                for (int jj = 0; jj < 8; ++jj)
#pragma unroll
                    for (int nt = 0; nt < 2; ++nt) ab[jj][nt] = *(const float2*)(carry + ((size_t)(b * 16 + ((j0 + jj) & 15)) * D + c0 + 32 * nt + r32) * 2);
#pragma unroll
                for (int jj = 0; jj < 8; ++jj) if (j0 + jj < sc) {
#pragma unroll
                    for (int nt = 0; nt < 2; ++nt) H[nt] = ab[jj][nt].x * H[nt] + ab[jj][nt].y; }
            }
        }
        bf16x8 idf[4];
#pragma unroll
        for (int kk = 0; kk < 4; ++kk) { const int d = (32 * (kk >> 1) + r32) - (16 * kk + 8 * hi); v4u w;
            w.x = (d == 0 ? 0x3F80u : 0u) | (d == 1 ? 0x3F800000u : 0u); w.y = (d == 2 ? 0x3F80u : 0u) | (d == 3 ? 0x3F800000u : 0u);
            w.z = (d == 4 ? 0x3F80u : 0u) | (d == 5 ? 0x3F800000u : 0u); w.w = (d == 6 ? 0x3F80u : 0u) | (d == 7 ? 0x3F800000u : 0u);
            idf[kk] = __builtin_bit_cast(bf16x8, w); }
        v4u nx[5], nz[4];
#define SC_LOAD(T0) do { _Pragma("unroll") for (int i = 0; i < 5; ++i) { const int row = i * 8 + (lane >> 3), ch = lane & 7, t = (T0) - 3 + row; \
                nx[i] = (v4u){0u, 0u, 0u, 0u}; if (row < 35 && t >= 0) nx[i] = *(const GAS v4u*)(XR + (size_t)(b * SEQ + t) * D + c0 + ch * 8); } \
            if (PASS2) { _Pragma("unroll") for (int i = 0; i < 4; ++i) { const int row = i * 8 + (lane >> 3), ch = lane & 7; \
                nz[i] = *(const GAS v4u*)(ZR + (size_t)(b * SEQ + (T0) + row) * D + c0 + ch * 8); } } } while (0)
        SC_LOAD(sc * 256);
        for (int sub = 0; sub < 8; ++sub) {
            const int t0 = sc * 256 + sub * 32;
#pragma unroll
            for (int i = 0; i < 5; ++i) { const int row = i * 8 + (lane >> 3), ch = lane & 7; if (row < 35) *(LAS v4u*)(lw + row * 144 + ch * 16) = nx[i]; }
            if (PASS2) {
#pragma unroll
                for (int i = 0; i < 4; ++i) { const int row = i * 8 + (lane >> 3), ch = lane & 7; *(LAS v4u*)(lz + row * 144 + ch * 16) = nz[i]; }
            }
            if (sub < 7) SC_LOAD(t0 + 32);
            bf16x8 af[4];
#pragma unroll
            for (int kk = 0; kk < 4; ++kk) { const int cb = 16 * kk + 8 * hi;
                f32x4 a0 = *(const LAS f32x4*)(lc + 256 + cb), a1 = *(const LAS f32x4*)(lc + 256 + cb + 4);
#pragma unroll
                for (int tap = 0; tap < 4; ++tap) { const v4u x = *(const LAS v4u*)(lw + (r32 + tap) * 144 + cb * 2);
                    const f32x4 w0 = *(const LAS f32x4*)(lc + tap * 64 + cb), w1 = *(const LAS f32x4*)(lc + tap * 64 + cb + 4);
                    a0[0] += w0[0] * bflo(x.x); a0[1] += w0[1] * bfhi(x.x); a0[2] += w0[2] * bflo(x.y); a0[3] += w0[3] * bfhi(x.y);
                    a1[0] += w1[0] * bflo(x.z); a1[1] += w1[1] * bfhi(x.z); a1[2] += w1[2] * bflo(x.w); a1[3] += w1[3] * bfhi(x.w); }
                v4u w; w.x = pk2(a0[0], a0[1]); w.y = pk2(a0[2], a0[3]); w.z = pk2(a1[0], a1[1]); w.w = pk2(a1[2], a1[3]);
                af[kk] = __builtin_bit_cast(bf16x8, w); }
#pragma unroll
            for (int nt = 0; nt < 2; ++nt) {
                f32x16 accR = {}, accI = {}, accX = {};
#pragma unroll
                for (int kk = 0; kk < 4; ++kk) {
                    const bf16x8 fa = *(const LAS bf16x8*)(F.lds + SC_WFRAG + ((0 * 8 + kk * 2 + nt) * 64 + lane) * 16);
                    const bf16x8 fx = *(const LAS bf16x8*)(F.lds + SC_WFRAG + ((1 * 8 + kk * 2 + nt) * 64 + lane) * 16);
                    accR = __builtin_amdgcn_mfma_f32_32x32x16_bf16(af[kk], fa, accR, 0, 0, 0);
                    accI = __builtin_amdgcn_mfma_f32_32x32x16_bf16(af[kk], fx, accI, 0, 0, 0);
                    if ((kk >> 1) == nt) accX = __builtin_amdgcn_mfma_f32_32x32x16_bf16(af[kk], idf[kk], accX, 0, 0, 0);
                }
                float Ap[16], hl[16], Aq[4], Bq[4];
#pragma unroll
                for (int q = 0; q < 4; ++q) { float pa = 1.f, hh = 0.f;
#pragma unroll
                    for (int j = 0; j < 4; ++j) { const int r = 4 * q + j;
                        const float rg = sigm(accR[r] + cba[nt]), ig = sigm(accI[r] + cbx[nt]);
                        const float a = __builtin_amdgcn_exp2f(ckc[nt] * rg);
                        const float bb = __builtin_amdgcn_sqrtf(fmaxf(1.0f - a * a, 0.f)) * ig * accX[r];
                        hh = a * hh + bb; pa *= a; Ap[r] = pa; hl[r] = hh; }
                    Aq[q] = pa; Bq[q] = hh; }
                float Ao[4], Bo[4];
#pragma unroll
                for (int q = 0; q < 4; ++q) { Ao[q] = __shfl_xor(Aq[q], 32); Bo[q] = __shfl_xor(Bq[q], 32); }
                float ci[4]; float Hc = H[nt], Pc = P[nt]; const bool up = (hi != 0);
#pragma unroll
                for (int q = 0; q < 4; ++q) { const float a0 = up ? Ao[q] : Aq[q], b0 = up ? Bo[q] : Bq[q], a1 = up ? Aq[q] : Ao[q], b1 = up ? Bq[q] : Bo[q];
                    const float mid = a0 * Hc + b0; ci[q] = up ? mid : Hc; Hc = a1 * mid + b1; Pc *= a0 * a1; }
                H[nt] = Hc; P[nt] = Pc;
                if (PASS2) {
#pragma unroll
                    for (int q = 0; q < 4; ++q) {
#pragma unroll
                        for (int j = 0; j < 4; ++j) { const int r = 4 * q + j; const float hv = Ap[r] * ci[q] + hl[r];
                            LAS unsigned short* zp = (LAS unsigned short*)(lz + crow16(r, hi) * 144 + (32 * nt + r32) * 2);
                            const float zs = __builtin_bit_cast(float, (unsigned)(*zp) << 16);
                            *zp = (unsigned short)pk2(hv * zs, 0.f); } }
                }
            }
            if (PASS2) {
#pragma unroll
                for (int i = 0; i < 4; ++i) { const int row = i * 8 + (lane >> 3), ch = lane & 7;
                    *(GAS v4u*)(ZR + (size_t)(b * SEQ + t0 + row) * D + c0 + ch * 8) = *(const LAS v4u*)(lz + row * 144 + ch * 16); }
            }
        }
#undef SC_LOAD
        if (!PASS2) { if (hi == 0) {
#pragma unroll
            for (int nt = 0; nt < 2; ++nt) *(float2*)(carry + ((size_t)(b * 16 + sc) * D + c0 + 32 * nt + r32) * 2) = make_float2(P[nt], H[nt]); } }
    }
    __syncthreads();
}

__device__ __forceinline__ void combine_phase(Frame& F) {
    const int gw = F.vcu * NWAVES + F.wave, NGW = F.G * NWAVES, lane = lane_id_(), hd = lane >> 3, p = lane & 7;
    const float l1 = wave_sum(F.in[I_LQ1][lane] * F.in[I_LK1][lane]), l2 = wave_sum(F.in[I_LQ2][lane] * F.in[I_LK2][lane]);
    const float lam = expf(l1) - expf(l2) + LAM_INIT;
    float gsc[16];
#pragma unroll
    for (int i = 0; i < 16; ++i) gsc[i] = F.in[I_SUBG][p * 16 + i] * (1.0f - LAM_INIT);
    const bf16* OB = (const bf16*)F.out; bf16* ZA = (bf16*)(F.ws + WS_ZA);
    for (int m = gw; m < M; m += NGW) {
        const bf16* ob = OB + (size_t)m * 2048 + hd * 256 + p * 16;
        const v4u a0 = *(const GAS v4u*)ob, a1 = *(const GAS v4u*)(ob + 8), b0 = *(const GAS v4u*)(ob + 128), b1 = *(const GAS v4u*)(ob + 136);
        bf16* zp = ZA + (size_t)m * D + hd * 128 + p * 16;
        const v4u z0 = *(const GAS v4u*)zp, z1 = *(const GAS v4u*)(zp + 8);
        float o[16]; const unsigned aw[8] = {a0.x, a0.y, a0.z, a0.w, a1.x, a1.y, a1.z, a1.w}, bw[8] = {b0.x, b0.y, b0.z, b0.w, b1.x, b1.y, b1.z, b1.w}, zw[8] = {z0.x, z0.y, z0.z, z0.w, z1.x, z1.y, z1.z, z1.w};
        float ss = 0.f;
#pragma unroll
        for (int i = 0; i < 8; ++i) { o[2 * i] = bflo(aw[i]) - lam * bflo(bw[i]); o[2 * i + 1] = bfhi(aw[i]) - lam * bfhi(bw[i]); ss += o[2 * i] * o[2 * i] + o[2 * i + 1] * o[2 * i + 1]; }
        ss += __shfl_xor(ss, 1); ss += __shfl_xor(ss, 2); ss += __shfl_xor(ss, 4);
        const float rstd = 1.0f / sqrtf(ss * (1.f / 128.f) + NORM_EPS);
        unsigned yw[8];
#pragma unroll
        for (int i = 0; i < 8; ++i) yw[i] = pk2(o[2 * i] * rstd * gsc[2 * i] * bflo(zw[i]), o[2 * i + 1] * rstd * gsc[2 * i + 1] * bfhi(zw[i]));
        *(GAS v4u*)zp = (v4u){yw[0], yw[1], yw[2], yw[3]}; *(GAS v4u*)(zp + 8) = (v4u){yw[4], yw[5], yw[6], yw[7]};
    }
}

__device__ __forceinline__ void final_phase(Frame& F) {
    const int gw = F.vcu * NWAVES + F.wave, NGW = F.G * NWAVES, lane = lane_id_();
    const float* stats = (const float*)(F.ws + WS_STATS);
    f32x4 gg[4];
#pragma unroll
    for (int j = 0; j < 4; ++j) gg[j] = ((const GAS f32x4*)F.in[I_POSTG])[lane + 64 * j];
    for (int m = gw; m < M; m += NGW) {
        float s = stats[(size_t)m * 16 + (lane & 15)];
        s += __shfl_xor(s, 1); s += __shfl_xor(s, 2); s += __shfl_xor(s, 4); s += __shfl_xor(s, 8);
        const float rstd = 1.0f / sqrtf(s * (1.f / D) + NORM_EPS);
        GAS f32x4* yp = (GAS f32x4*)(F.out + (size_t)m * D) + lane; const GAS f32x4* xp = (const GAS f32x4*)(F.in[I_X] + (size_t)m * D) + lane;
#pragma unroll
        for (int j = 0; j < 4; ++j) { const f32x4 y = yp[64 * j], x = xp[64 * j]; yp[64 * j] = x + y * rstd * gg[j]; }
    }
}

struct Args { const float* in[19]; float* out; unsigned char* ws; int ph_lo, ph_hi; };
__global__ void __launch_bounds__(NWAVES * 64, 2) fwd_kernel(Args args) {
    extern __shared__ __attribute__((aligned(16))) unsigned char lds[];
    cg::grid_group grid = cg::this_grid();
    Frame F;
    F.lds = (LAS unsigned char*)lds;
    F.wave = __builtin_amdgcn_readfirstlane((int)threadIdx.x >> 6);
    F.G = gridDim.x; { const int bx = blockIdx.x; F.vcu = (F.G % 8 == 0) ? (bx % 8) * (F.G / 8) + bx / 8 : bx; }
#pragma unroll
    for (int i = 0; i < 19; ++i) F.in[i] = args.in[i];
    F.out = args.out; F.ws = args.ws;
    unsigned char* ws = args.ws;
    const int lo = args.ph_lo, hi = args.ph_hi;
#define IN(k) (lo <= (k) && (k) < hi)
    const bool lane0w0 = (F.wave == 0) && (lane_id_() == 0);
    if (lane0w0) { ((volatile LAS unsigned*)(F.lds + MISC_OFF))[0] = 0u; ((volatile LAS unsigned*)(F.lds + MISC_OFF))[1] = 0u; }
    __syncthreads();
    XcdBarrier bar = xcd_barrier_post((unsigned*)(ws + WS_CTL) + 1024, (volatile LAS unsigned*)(F.lds + MISC_OFF), lane0w0);
#define SEAM(k) do { if (IN(k) && IN((k) + 1)) { if ((k) == 0) { __syncthreads(); grid.sync(); } else { xcd_barrier(bar, (F.wave == 0) && (lane_id_() == 0)); } } } while (0)

    if (IN(0)) { p0_prologue(F); }
    SEAM(0);
    if (IN(1)) {
        pg8::Gemm g{(const pg8::bf16_t*)(ws + WS_U), (const pg8::bf16_t*)(ws + WS_WIN), M, 6144, D}; pg8::StaticOrder S; S.init(M, 6144, F.G, (int)blockIdx.x);
        pg8::EpiSplit E{(pg8::bf16_t*)(ws + WS_XR), SLOT / 2, 0x100310u, attn_body::C2};
        pg8::gemm_phase<pg8::EpiSplit, pg8::StaticOrder, PG8_ALIGN, PG8_SP2>(F.lds, g, S, E, F.wave);
    }
    SEAM(1);
    if (IN(2)) {
        scan_phase<false>(F);
        const attn_body::AttnTensors AT{(const attn_body::bf16*)(ws + WS_Q), (const attn_body::bf16*)(ws + WS_K), (const attn_body::bf16*)(ws + WS_V), (attn_body::bf16*)F.out};
        const attn_body::StaticOrder AS(F.vcu, F.G); attn_body::attn_phase<attn_body::StaticOrder>((char*)lds, AT, AS, F.wave);
    }
    SEAM(2);
    if (IN(3)) {
        { pg8::Gemm g{(const pg8::bf16_t*)(ws + WS_U), (const pg8::bf16_t*)(ws + WS_WIN) + (size_t)6144 * D, M, 2048, D}; pg8::StaticOrder S; S.init(M, 2048, F.G, (int)blockIdx.x);
          pg8::EpiSplit E{(pg8::bf16_t*)(ws + WS_Q), SLOT / 2, 0x22u, 1.0f};
          pg8::gemm_phase<pg8::EpiSplit, pg8::StaticOrder, PG8_ALIGN, PG8_SP2>(F.lds, g, S, E, F.wave); }
        scan_phase<true>(F);
        combine_phase(F);
    }
    SEAM(3);
    if (IN(4)) {
        { pg8::Gemm g{(const pg8::bf16_t*)(ws + WS_ZR), (const pg8::bf16_t*)(ws + WS_WR), M, D, D}; pg8::StaticOrder S; S.init(M, D, F.G, (int)blockIdx.x);
          pg8::EpiGate<false> E{(const pg8::bf16_t*)(ws + WS_Q), (pg8::bf16_t*)(ws + WS_V)};
          pg8::gemm_phase<pg8::EpiGate<false>, pg8::StaticOrder, PG8_ALIGN, PG8_SP2>(F.lds, g, S, E, F.wave); }
        { pg8::Gemm g{(const pg8::bf16_t*)(ws + WS_ZA), (const pg8::bf16_t*)(ws + WS_WA), M, D, D}; pg8::StaticOrder S; S.init(M, D, F.G, (int)blockIdx.x);
          pg8::EpiGate<true> E{(const pg8::bf16_t*)(ws + WS_K), (pg8::bf16_t*)(ws + WS_V)};
          pg8::gemm_phase<pg8::EpiGate<true>, pg8::StaticOrder, PG8_ALIGN, PG8_SP2>(F.lds, g, S, E, F.wave); }
    }
    SEAM(4);
    if (IN(5)) {
        pg8::Gemm g{(const pg8::bf16_t*)(ws + WS_V), (const pg8::bf16_t*)(ws + WS_WO), M, D, D}; pg8::StaticOrder S; S.init(M, D, F.G, (int)blockIdx.x);
        pg8::EpiF32Stats E{F.out, (float*)(ws + WS_STATS)};
        pg8::gemm_phase<pg8::EpiF32Stats, pg8::StaticOrder, PG8_ALIGN, PG8_SP2>(F.lds, g, S, E, F.wave);
    }
    SEAM(5);
    if (IN(6)) { final_phase(F); }
#undef IN
#undef SEAM
}

extern "C" void kernel_launch(void* const* d_in, const int* in_sizes, int n_in, void* d_out, int out_size, void* d_ws, size_t ws_size, hipStream_t stream) {
    static int grid = 0;
    if (grid == 0) {
        if (n_in != 19 || in_sizes[0] != M * D || out_size != M * D || ws_size < WS_END) { fprintf(stderr, "kernel_launch: unexpected shapes (n_in %d, in0 %d, out %d, ws %zu)\n", n_in, n_in > 0 ? in_sizes[0] : -1, out_size, ws_size); grid = -1; return; }
        int dev = 0, cus = 0, per_cu = 0;
        if (hipGetDevice(&dev) != hipSuccess || hipDeviceGetAttribute(&cus, hipDeviceAttributeMultiprocessorCount, dev) != hipSuccess) { grid = -1; return; }
        if (hipFuncSetAttribute((const void*)fwd_kernel, hipFuncAttributeMaxDynamicSharedMemorySize, LDS_BYTES) != hipSuccess) { fprintf(stderr, "kernel_launch: hipFuncSetAttribute failed\n"); grid = -1; return; }
        if (hipOccupancyMaxActiveBlocksPerMultiprocessor(&per_cu, (const void*)fwd_kernel, NWAVES * 64, LDS_BYTES) != hipSuccess || per_cu < 1) { fprintf(stderr, "kernel_launch: occupancy query says %d\n", per_cu); (void)hipGetLastError(); grid = -1; return; }
        grid = cus;
    }
    if (grid < 0) return;
    if (hipMemsetAsync((char*)d_ws + WS_CTL, 0, CTL_ZERO_BYTES, stream) != hipSuccess) { fprintf(stderr, "kernel_launch: hipMemsetAsync failed\n"); return; }
    Args a{};
    for (int i = 0; i < 19; ++i) a.in[i] = (const float*)d_in[i];
    a.out = (float*)d_out; a.ws = (unsigned char*)d_ws; a.ph_lo = 0; a.ph_hi = 7;
    void* kargs[] = {&a};
    const hipError_t e = hipLaunchCooperativeKernel((const void*)fwd_kernel, dim3(grid), dim3(NWAVES * 64), kargs, LDS_BYTES, stream);
    if (e != hipSuccess) fprintf(stderr, "kernel_launch: cooperative launch failed: %s (grid %d)\n", hipGetErrorString(e), grid);
}
```

```cpp
#include <hip/hip_runtime.h>

#include <cstdio>
#include <cstdint>
__device__ __forceinline__ int lane_id_() { return (int)__builtin_amdgcn_mbcnt_hi(~0u, __builtin_amdgcn_mbcnt_lo(~0u, 0u)); }
namespace pg8 {
#define PG8_LAS __attribute__((address_space(3)))
typedef unsigned short bf16_t;
typedef short bf16x8 __attribute__((ext_vector_type(8)));
typedef float f32x4 __attribute__((ext_vector_type(4)));
typedef unsigned u32x4 __attribute__((ext_vector_type(4)));
constexpr int BM = 256, BK = 64, HALF = 128, HTB = HALF * BK * 2  , STAGE_BYTES = 8 * HTB, NXCD = 8, WGM = 8;

__host__ __device__ __forceinline__ int lds_byte(int r, int c) { const int st = (r >> 4) * 2 + (c >> 5), rr = r & 15, cc = c & 31, ob = rr * 64 + cc * 2; return st * 1024 + (ob ^ (((ob >> 9) & 1) << 5)); }
__host__ __device__ __forceinline__ void stage_rc(int b, int& R, int& C) { const int st = b / 1024, sb = b % 1024, swz = sb ^ (((sb >> 9) & 1) << 5); R = (st >> 1) * 16 + swz / 64; C = (st & 1) * 32 + (swz % 64) / 2; }
__host__ __device__ __forceinline__ int perm32(int rho) { const int n = rho >> 4, i = rho & 15; return 8 * (i >> 2) + 4 * n + (i & 3); }

struct Unit { int pm, pn; };
struct Gemm { const bf16_t* A; const bf16_t* Bt; int M, N, K; };

struct StaticOrder {
    int nM, nN, nwg, G, c;
    __host__ __device__ void init(int M, int N, int G_, int c_) { nM = M / BM; nN = N / BM; nwg = nM * nN; G = G_; c = c_; }
    __host__ __device__ bool next(int i, Unit& u) const {
        const long L = (long)i * G + c; if (L >= nwg) return false;
        int wgid = (int)L; { const int q = nwg / NXCD, r = nwg % NXCD, xcd = wgid % NXCD, off = wgid / NXCD; wgid = (xcd < r ? xcd * (q + 1) : r * (q + 1) + (xcd - r) * q) + off; }
        const int nig = WGM * nN, gid = wgid / nig, fm = gid * WGM, gsz = (nM - fm) < WGM ? (nM - fm) : WGM;
        u.pm = fm + ((wgid % nig) % gsz); u.pn = (wgid % nig) / gsz; return true;
    }
    __device__ __forceinline__ void a_ready(const Unit&) const {}
    __device__ __forceinline__ void done(const Unit&) const {}
};

__device__ __forceinline__ unsigned cvt_pk_bf16(float lo, float hi) { unsigned r; asm volatile("v_cvt_pk_bf16_f32 %0, %1, %2" : "=v"(r) : "v"(lo), "v"(hi)); return r; }
typedef float f32x2 __attribute__((ext_vector_type(2)));
__device__ __forceinline__ float bf_lo(unsigned w) { return __builtin_bit_cast(float, w << 16); }
__device__ __forceinline__ float bf_hi(unsigned w) { return __builtin_bit_cast(float, w & 0xffff0000u); }
__device__ __forceinline__ float sigmoid_f(float v) { return __builtin_amdgcn_rcpf(1.0f + __builtin_amdgcn_exp2f(-1.4426950408889634f * v)); }
struct EpiSplit {
    static constexpr bool PERM = true, AFTER_DRAIN = false;
    bf16_t* O; size_t split_stride; unsigned acts; float scl;
    __device__ __forceinline__ void operator()(const f32x4 (&acc)[2][2][4][2], const Unit& u, int wr, int wc, int fr, int fq) const {
        const int row0 = u.pm * BM + wr * 64 + fr; int colt = u.pn * BM; const int t = colt >> 10; bf16_t* base = O + (size_t)t * split_stride; colt -= t << 10;
        const int act = (int)((acts >> (4 * t)) & 15u);
        const int col0 = colt + wc * 32 + 8 * fq;
#pragma unroll
        for (int ai = 0; ai < 2; ++ai)
#pragma unroll
            for (int m = 0; m < 4; ++m) { bf16_t* rowp = base + (size_t)(row0 + ai * HALF + m * 16) * 1024 + col0;
#pragma unroll
                for (int bj = 0; bj < 2; ++bj) { f32x4 v0 = acc[ai][bj][m][0], v1 = acc[ai][bj][m][1];
                    if (act == 1) {
#pragma unroll
                        for (int e = 0; e < 4; ++e) { v0[e] = v0[e] * sigmoid_f(v0[e]); v1[e] = v1[e] * sigmoid_f(v1[e]); }
                    } else if (act == 2) {
#pragma unroll
                        for (int e = 0; e < 4; ++e) { v0[e] = sigmoid_f(v0[e]); v1[e] = sigmoid_f(v1[e]); }
                    } else if (act == 3) { v0 = v0 * scl; v1 = v1 * scl; }
                    u32x4 w; w.x = cvt_pk_bf16(v0[0], v0[1]); w.y = cvt_pk_bf16(v0[2], v0[3]); w.z = cvt_pk_bf16(v1[0], v1[1]); w.w = cvt_pk_bf16(v1[2], v1[3]);
                    *(u32x4*)(rowp + bj * HALF) = w; } }
    }
};
template <bool ACCUM> struct EpiGate {
    static constexpr bool PERM = true, AFTER_DRAIN = false;
    const bf16_t* G; bf16_t* Mb;
    __device__ __forceinline__ void operator()(const f32x4 (&acc)[2][2][4][2], const Unit& u, int wr, int wc, int fr, int fq) const {
        const int row0 = u.pm * BM + wr * 64 + fr, col0 = u.pn * BM + wc * 32 + 8 * fq;
#pragma unroll
        for (int ai = 0; ai < 2; ++ai)
#pragma unroll
            for (int m = 0; m < 4; ++m) { const size_t off = (size_t)(row0 + ai * HALF + m * 16) * 1024 + col0;
#pragma unroll
                for (int bj = 0; bj < 2; ++bj) { const f32x4 a0 = acc[ai][bj][m][0], a1 = acc[ai][bj][m][1];
                    const u32x4 g = *(const u32x4*)(G + off + bj * HALF);
                    f32x4 v0, v1;
                    v0[0] = bf_lo(g.x) * a0[0]; v0[1] = bf_hi(g.x) * a0[1]; v0[2] = bf_lo(g.y) * a0[2]; v0[3] = bf_hi(g.y) * a0[3];
                    v1[0] = bf_lo(g.z) * a1[0]; v1[1] = bf_hi(g.z) * a1[1]; v1[2] = bf_lo(g.w) * a1[2]; v1[3] = bf_hi(g.w) * a1[3];
                    if (ACCUM) { const u32x4 o = *(const u32x4*)(Mb + off + bj * HALF);
                        v0[0] += bf_lo(o.x); v0[1] += bf_hi(o.x); v0[2] += bf_lo(o.y); v0[3] += bf_hi(o.y);
                        v1[0] += bf_lo(o.z); v1[1] += bf_hi(o.z); v1[2] += bf_lo(o.w); v1[3] += bf_hi(o.w); }
                    u32x4 w; w.x = cvt_pk_bf16(v0[0], v0[1]); w.y = cvt_pk_bf16(v0[2], v0[3]); w.z = cvt_pk_bf16(v1[0], v1[1]); w.w = cvt_pk_bf16(v1[2], v1[3]);
                    *(u32x4*)(Mb + off + bj * HALF) = w; } }
    }
};
struct EpiF32Stats {
    static constexpr bool PERM = false, AFTER_DRAIN = false;
    float* Y; float* stats;
    __device__ __forceinline__ void operator()(const f32x4 (&acc)[2][2][4][2], const Unit& u, int wr, int wc, int fr, int fq) const {
        const int col0 = u.pn * BM + wc * 32 + 4 * fq;
#pragma unroll
        for (int ai = 0; ai < 2; ++ai)
#pragma unroll
            for (int m = 0; m < 4; ++m) { const int r = u.pm * BM + ai * HALF + wr * 64 + m * 16 + fr; const size_t off = (size_t)r * 1024 + col0; float s = 0.f;
#pragma unroll
                for (int bj = 0; bj < 2; ++bj)
#pragma unroll
                    for (int n = 0; n < 2; ++n) { const f32x4 x = acc[ai][bj][m][n]; *(f32x4*)(Y + off + bj * HALF + n * 16) = x; s += (x[0] * x[0] + x[1] * x[1]) + (x[2] * x[2] + x[3] * x[3]); }
                s += __shfl_xor(s, 16); s += __shfl_xor(s, 32);
                if (fq == 0) stats[(size_t)r * 16 + u.pn * 4 + wc] = s; }
    }
};
template <class Epi, class Sched, bool ALIGN_EPI = false, bool SP2 = false>
__device__ __forceinline__ void gemm_phase(PG8_LAS unsigned char* lds, const Gemm g, const Sched& S, const Epi& E, const int wave_) {
    const int lane = lane_id_(), wid = wave_, tid = wid * 64 + lane, wr = wid >> 2, wc = wid & 3, fr = lane & 15, fq = lane >> 4;
    const int K = g.K, nt = K / BK;
    unsigned voffA[2], voffB[2];
#pragma unroll
    for (int i = 0; i < 2; ++i) { int R, C; stage_rc(tid * 16 + i * 8192, R, C); const int Rb = Epi::PERM ? ((R & ~31) + perm32(R & 31)) : R;
        voffA[i] = (unsigned)(R * K + C) * 2u; voffB[i] = (unsigned)(Rb * K + C) * 2u; }
    const size_t kstep = (size_t)(BK * 2);
    const size_t hstep = (size_t)HALF * K * 2;
    const size_t tstep = 2 * hstep;
    const unsigned ldsw = (unsigned)wid * 1024u;
    const int aoff = lds_byte(wr * 64 + fr, fq * 8), boff = lds_byte(wc * 32 + fr, fq * 8);
#define PG8_SA(b, h) (((b) * 2 + (h)) * HTB)
#define PG8_SB(b, h) ((4 + (b) * 2 + (h)) * HTB)
#define PG8_STAGE(bufoff, gbase, voff) do { _Pragma("unroll") for (int _i = 0; _i < 2; ++_i) \
        __builtin_amdgcn_global_load_lds((const unsigned*)((const char*)(gbase) + (voff)[_i]), (PG8_LAS unsigned*)(lds + (bufoff) + ldsw + _i * 8192), 16, 0, 0); } while (0)
#define PG8_LDA(dst, b, h) do { _Pragma("unroll") for (int m = 0; m < 4; ++m) _Pragma("unroll") for (int k = 0; k < 2; ++k) dst[m][k] = *(const PG8_LAS bf16x8*)(lds + PG8_SA(b, h) + aoff + m * 2048 + k * 1024); } while (0)
#define PG8_LDB(dst, b, h) do { _Pragma("unroll") for (int n = 0; n < 2; ++n) _Pragma("unroll") for (int k = 0; k < 2; ++k) dst[n][k] = *(const PG8_LAS bf16x8*)(lds + PG8_SB(b, h) + boff + n * 2048 + k * 1024); } while (0)
#define PG8_MMA(ai, bj, At, Bt) do { __builtin_amdgcn_s_setprio(1); _Pragma("unroll") for (int m = 0; m < 4; ++m) _Pragma("unroll") for (int n = 0; n < 2; ++n) _Pragma("unroll") for (int k = 0; k < 2; ++k) \
        acc[ai][bj][m][n] = __builtin_amdgcn_mfma_f32_16x16x32_bf16(Bt[n][k], At[m][k], acc[ai][bj][m][n], 0, 0, 0); __builtin_amdgcn_s_setprio(0); } while (0)
#define PG8_WAIT_V(n) asm volatile("s_waitcnt vmcnt(" #n ")" ::: "memory")
#define PG8_WAIT_L(n) asm volatile("s_waitcnt lgkmcnt(" #n ")" ::: "memory")
#define PG8_BAR __builtin_amdgcn_s_barrier()
#define PG8_SCHED __builtin_amdgcn_sched_barrier(0)
    Unit cur, nxt; int ui = 0;
    if (!S.next(0, cur)) return;
    f32x4 acc[2][2][4][2];
#pragma unroll
    for (int a = 0; a < 2; ++a)
#pragma unroll
        for (int b = 0; b < 2; ++b)
#pragma unroll
            for (int m = 0; m < 4; ++m)
#pragma unroll
                for (int n = 0; n < 2; ++n) acc[a][b][m][n] = (f32x4){0.f, 0.f, 0.f, 0.f};
    bf16x8 At[4][2], B0[2][2], B1[2][2];
    const char* cA = (const char*)g.A + (size_t)cur.pm * tstep; const char* cB = (const char*)g.Bt + (size_t)cur.pn * tstep;
    S.a_ready(cur);
    if constexpr (SP2) {
        PG8_STAGE(PG8_SB(0, 0), cB, voffB); PG8_STAGE(PG8_SB(0, 1), cB + hstep, voffB); PG8_STAGE(PG8_SA(0, 0), cA, voffA); PG8_STAGE(PG8_SA(0, 1), cA + hstep, voffA);
        if (wr == 1) PG8_BAR;
        PG8_WAIT_V(2); PG8_BAR;
        PG8_STAGE(PG8_SB(1, 0), cB + kstep, voffB); PG8_STAGE(PG8_SA(1, 0), cA + kstep, voffA); PG8_STAGE(PG8_SB(1, 1), cB + hstep + kstep, voffB);
        PG8_WAIT_V(6); PG8_BAR;
    } else {
        PG8_STAGE(PG8_SB(0, 0), cB, voffB); PG8_STAGE(PG8_SA(0, 0), cA, voffA); PG8_STAGE(PG8_SB(0, 1), cB + hstep, voffB); PG8_STAGE(PG8_SA(0, 1), cA + hstep, voffA);
        if (wr == 1) PG8_BAR;
        PG8_WAIT_V(4); PG8_BAR;
        PG8_STAGE(PG8_SB(1, 0), cB + kstep, voffB); PG8_STAGE(PG8_SA(1, 0), cA + kstep, voffA); PG8_STAGE(PG8_SB(1, 1), cB + hstep + kstep, voffB);
        PG8_WAIT_V(6); PG8_BAR;
    }
    for (;;) {
        const bool has_next = S.next(ui + 1, nxt);
        const char* nA = has_next ? (const char*)g.A + (size_t)nxt.pm * tstep : cA; const char* nB = has_next ? (const char*)g.Bt + (size_t)nxt.pn * tstep : cB;
        for (int t = 0; t < nt; t += 2) {
            const bool last = (t == nt - 2);
            const char* a1 = cA + (size_t)(t + 1) * kstep;
            const char* a2 = last ? nA : cA + (size_t)(t + 2) * kstep; const char* b2 = last ? nB : cB + (size_t)(t + 2) * kstep;
            const char* a3 = a2 + kstep; const char* b3 = b2 + kstep;
            if (last && has_next) S.a_ready(nxt);
            if constexpr (SP2) {
            PG8_LDB(B0, 0, 0); PG8_LDB(B1, 0, 1); PG8_SCHED; PG8_LDA(At, 0, 0); PG8_STAGE(PG8_SA(1, 1), a1 + hstep, voffA);
            PG8_WAIT_V(8); PG8_WAIT_L(0); PG8_BAR; PG8_MMA(0, 0, At, B0); PG8_MMA(0, 1, At, B1); PG8_BAR; PG8_SCHED;
            PG8_LDA(At, 0, 1); PG8_STAGE(PG8_SB(0, 0), b2, voffB); PG8_STAGE(PG8_SB(0, 1), b2 + hstep, voffB); PG8_STAGE(PG8_SA(0, 0), a2, voffA);
            PG8_WAIT_V(8); PG8_WAIT_L(0); PG8_BAR; PG8_MMA(1, 0, At, B0); PG8_MMA(1, 1, At, B1); PG8_BAR; PG8_SCHED;
            PG8_LDB(B0, 1, 0); PG8_LDB(B1, 1, 1); PG8_SCHED; PG8_LDA(At, 1, 0); PG8_STAGE(PG8_SA(0, 1), a2 + hstep, voffA);
            PG8_WAIT_V(8); PG8_WAIT_L(0); PG8_BAR; PG8_MMA(0, 0, At, B0); PG8_MMA(0, 1, At, B1); PG8_BAR; PG8_SCHED;
            PG8_LDA(At, 1, 1); PG8_STAGE(PG8_SB(1, 0), b3, voffB); PG8_STAGE(PG8_SB(1, 1), b3 + hstep, voffB); PG8_STAGE(PG8_SA(1, 0), a3, voffA);
            PG8_WAIT_V(8); PG8_WAIT_L(0); PG8_BAR; PG8_MMA(1, 0, At, B0); PG8_MMA(1, 1, At, B1); PG8_BAR; PG8_SCHED;
            } else {
            PG8_LDB(B0, 0, 0); PG8_SCHED; PG8_LDA(At, 0, 0); PG8_STAGE(PG8_SA(1, 1), a1 + hstep, voffA);
            PG8_WAIT_L(8); PG8_BAR; PG8_WAIT_L(0); PG8_MMA(0, 0, At, B0); PG8_BAR; PG8_SCHED;
            PG8_LDB(B1, 0, 1); PG8_STAGE(PG8_SB(0, 0), b2, voffB);
            PG8_BAR; PG8_WAIT_L(0); PG8_MMA(0, 1, At, B1); PG8_BAR;
            PG8_LDA(At, 0, 1); PG8_STAGE(PG8_SA(0, 0), a2, voffA);
            PG8_BAR; PG8_WAIT_L(0); PG8_MMA(1, 0, At, B0); PG8_BAR; PG8_SCHED;
            PG8_STAGE(PG8_SB(0, 1), b2 + hstep, voffB);
            PG8_WAIT_V(6); PG8_BAR; PG8_MMA(1, 1, At, B1); PG8_BAR;
            PG8_LDB(B0, 1, 0); PG8_SCHED; PG8_LDA(At, 1, 0); PG8_STAGE(PG8_SA(0, 1), a2 + hstep, voffA);
            PG8_WAIT_L(8); PG8_BAR; PG8_WAIT_L(0); PG8_MMA(0, 0, At, B0); PG8_BAR; PG8_SCHED;
            PG8_LDB(B1, 1, 1); PG8_STAGE(PG8_SB(1, 0), b3, voffB);
            PG8_BAR; PG8_WAIT_L(0); PG8_MMA(0, 1, At, B1); PG8_BAR;
            PG8_LDA(At, 1, 1); PG8_STAGE(PG8_SA(1, 0), a3, voffA);
            PG8_BAR; PG8_WAIT_L(0); PG8_MMA(1, 0, At, B0); PG8_BAR; PG8_SCHED;
            PG8_STAGE(PG8_SB(1, 1), b3 + hstep, voffB);
            PG8_WAIT_V(6); PG8_BAR; PG8_MMA(1, 1, At, B1); PG8_BAR;
            }
        }
        if constexpr (ALIGN_EPI) { if (wr == 0) PG8_BAR; }
        if constexpr (!Epi::AFTER_DRAIN) { E(acc, cur, wr, wc, fr, fq); S.done(cur); }
        if (!has_next) break;
#pragma unroll
        for (int a = 0; a < 2; ++a)
#pragma unroll
            for (int b = 0; b < 2; ++b)
#pragma unroll
                for (int m = 0; m < 4; ++m)
#pragma unroll
                    for (int n = 0; n < 2; ++n) acc[a][b][m][n] = (f32x4){0.f, 0.f, 0.f, 0.f};
        cur = nxt; cA = nA; cB = nB; ++ui;
        if constexpr (ALIGN_EPI) { if (wr == 1) PG8_BAR; }
    }
    PG8_WAIT_V(0);
    if constexpr (!ALIGN_EPI) { if (wr == 0) PG8_BAR; }
    PG8_BAR;
    if constexpr (Epi::AFTER_DRAIN) { E.fused(acc, cur, wr, wc, fr, fq, lds, wid, lane); S.done(cur); }
#undef PG8_SA
#undef PG8_SB
#undef PG8_STAGE
#undef PG8_LDA
#undef PG8_LDB
#undef PG8_MMA
#undef PG8_WAIT_V
#undef PG8_WAIT_L
#undef PG8_BAR
#undef PG8_SCHED
}
}

#ifndef PG8_SP2
#define PG8_SP2 true
#endif
#ifndef PG8_ALIGN
#define PG8_ALIGN true
#endif
#include <hip/hip_bf16.h>
#include <cmath>
#include <hip/hip_bf16.h>
#include <cmath>
namespace attn_body {
using bf16=__hip_bfloat16;
using bf16x8=__attribute__((ext_vector_type(8)))short;
using s16x4=__attribute__((ext_vector_type(4)))short;
using f32x16=__attribute__((ext_vector_type(16)))float;
using u32x4=__attribute__((ext_vector_type(4)))unsigned;
constexpr int BATCH=8,NHEAD=16,SEQ=4096,D=64,DM=NHEAD*D,OPITCH=2048,VW=128;
constexpr int NW=8,QBLK=32,QB=QBLK*NW,KVBLK=64,NQB=SEQ/QB;
__device__ __forceinline__ int crow(int r,int hi){return (r&3)+8*(r>>2)+4*hi;}
#define SBAR() __builtin_amdgcn_sched_barrier(0)
__device__ __forceinline__ void cmask(f32x16&p0,f32x16&p1,int jb,int qrel,int hi){
  const float NEG=-INFINITY; int kb=64*jb+4*hi;
  #pragma unroll
  for(int r=0;r<16;++r){int kv=kb+(r&3)+8*(r>>2); if(kv>qrel)p0[r]=NEG; if(kv+32>qrel)p1[r]=NEG;}
}
constexpr int NSLOT=3, SLOTK=8192, SLOTV=16384, OSTP=272;
constexpr int LDS_K=0, LDS_V=NSLOT*SLOTK, LDS_WS=LDS_V+NSLOT*SLOTV, LDS_OST=LDS_WS+NW*64*4, LDS_BYTES=LDS_OST+NW*32*OSTP;
constexpr float C2=0.125f*1.4426950408889634f;
__device__ __forceinline__ void glds16(const void*gsrc,unsigned lds_dst){unsigned keep;
  asm volatile("s_mov_b32 %0, m0\n\ts_mov_b32 m0, %2\n\ts_nop 0\n\tglobal_load_lds_dwordx4 %1, off\n\ts_mov_b32 m0, %0":"=&s"(keep):"v"(gsrc),"s"(lds_dst):"memory");}
__device__ __forceinline__ float max3f(float a,float b,float c){float r;asm("v_max3_f32 %0, %1, %2, %3":"=v"(r):"v"(a),"v"(b),"v"(c));return r;}
__device__ __forceinline__ float max2f(float a,float b){float r;asm("v_max_f32_e32 %0, %1, %2":"=v"(r):"v"(a),"v"(b));return r;}
__device__ __forceinline__ float fsub_s(float a,float b){float r;asm("v_sub_f32_e32 %0, %1, %2":"=v"(r):"v"(a),"v"(b));return r;}
typedef float f32x2_t __attribute__((ext_vector_type(2))); typedef __bf16 bf16x2_t __attribute__((ext_vector_type(2)));
__device__ __forceinline__ unsigned cvtpk_s(float lo,float hi){f32x2_t v={lo,hi};bf16x2_t b=__builtin_convertvector(v,bf16x2_t);return __builtin_bit_cast(unsigned,b);}
#define WAIT_BAR(N) asm volatile("s_waitcnt vmcnt(" #N ") lgkmcnt(0)\n\ts_barrier":::"memory")
#define MFMA(a,b,c) __builtin_amdgcn_mfma_f32_32x32x16_bf16(a,b,c,0,0,0)
__device__ __forceinline__ void qkt(f32x16&p0,f32x16&p1,const char*Kslot,const bf16x8*qr,int r32,int hi){
  const char*kb=Kslot+hi*1024+r32*16;
  #pragma unroll
  for(int d0=0;d0<4;++d0){
    const bf16x8 b0=*reinterpret_cast<const bf16x8*>(kb+d0*2048);
    const bf16x8 b1=*reinterpret_cast<const bf16x8*>(kb+d0*2048+512);
    if(d0==0){p0=MFMA(b0,qr[0],f32x16{});p1=MFMA(b1,qr[0],f32x16{});}
    else{p0=MFMA(b0,qr[d0],p0);p1=MFMA(b1,qr[d0],p1);}}
}
typedef __attribute__((address_space(3))) const char* lds_cptr;
typedef short v4i16_t __attribute__((ext_vector_type(4)));
#define KLD(p) (*(const __attribute__((address_space(3))) bf16x8*)(p))
__device__ __forceinline__ s16x4 vtr(lds_cptr p){ return __builtin_bit_cast(s16x4,__builtin_amdgcn_ds_read_tr16_b64_v4i16((__attribute__((address_space(3))) v4i16_t*)p)); }
__device__ __forceinline__ float rowmax(const f32x16&p0,const f32x16&p1){
  float a=max3f(p0[0],p0[1],p1[0]),b=max3f(p0[2],p0[3],p1[1]);a=max3f(a,p1[2],p1[3]);
  #pragma unroll
  for(int r=4;r<16;r+=4){a=max3f(a,p0[r],p0[r+1]);b=max3f(b,p0[r+2],p0[r+3]);a=max3f(a,p1[r],p1[r+1]);b=max3f(b,p1[r+2],p1[r+3]);}
  const float m=max2f(a,b);
  auto rr=__builtin_amdgcn_permlane32_swap(__float_as_uint(m),__float_as_uint(m),false,false);
  return max2f(__uint_as_float(rr[0]),__uint_as_float(rr[1]));
}
__device__ __forceinline__ void pv4(f32x16*o,int vb,bf16x8 pa0,bf16x8 pa1,bf16x8 pa2,bf16x8 pa3){
  #pragma unroll
  for(int d0=0;d0<4;++d0){s16x4 lo[4],hi[4];
    #pragma unroll
    for(int ks=0;ks<4;++ks){
      asm volatile("ds_read_b64_tr_b16 %0,%1 offset:%c2":"=&v"(lo[ks]):"v"(vb),"i"(d0*4096+ks*1024):"memory");
      asm volatile("ds_read_b64_tr_b16 %0,%1 offset:%c2":"=&v"(hi[ks]):"v"(vb),"i"(d0*4096+ks*1024+512):"memory");}
    asm volatile("s_waitcnt lgkmcnt(0)":::"memory");SBAR();
    #define PK(k) (bf16x8){lo[k][0],lo[k][1],lo[k][2],lo[k][3],hi[k][0],hi[k][1],hi[k][2],hi[k][3]}
    o[d0]=MFMA(pa0,PK(0),o[d0]);
    o[d0]=MFMA(pa1,PK(1),o[d0]);
    o[d0]=MFMA(pa2,PK(2),o[d0]);
    o[d0]=MFMA(pa3,PK(3),o[d0]);
    #undef PK
  }
}
#ifndef ATTN_STORE16
#define ATTN_STORE16(p,v) (*(u32x4*)(p)=(v))
#endif
template<int THRL> __device__ __forceinline__ void attn_unit(int b,int h,int qb,const bf16*Q,const bf16*__restrict__ K,const bf16*__restrict__ V,bf16*O,char*shm,const int wave_){
  const int lane=lane_id_(),r32=lane&31,hi=lane>>5; const int wid=wave_;
  const long rowbase=(long)b*SEQ; const int q0=qb*QB;
  const bf16*Qw=Q+(rowbase+q0+wid*QBLK)*DM+h*D;
  const bf16*Kh=K+rowbase*DM+h*D,*Vh=V+rowbase*DM+(h>>1)*VW;
  const unsigned lds0=(unsigned)(uintptr_t)shm;
  float*wsf=(float*)(shm+LDS_WS)+wid*64;
  const bf16*ksrc=Kh+(long)lane*DM+wid*8;
  const bf16*vsrc=Vh+(long)(16*(wid&3)+(lane>>2))*DM+(wid>>2)*32+(lane&3)*8;
  const unsigned kdst=lds0+LDS_K+wid*1024, vdst=lds0+LDS_V+wid*1024;
  #define DMA_K(t,slot) glds16(ksrc+(long)(t)*KVBLK*DM,(unsigned)__builtin_amdgcn_readfirstlane(kdst+(slot)))
  #define DMA_V(t,slot) do{ glds16(vsrc+(long)(t)*KVBLK*DM,(unsigned)__builtin_amdgcn_readfirstlane(vdst+(slot))); glds16(vsrc+(long)(t)*KVBLK*DM+64,(unsigned)__builtin_amdgcn_readfirstlane(vdst+(slot)+8192)); }while(0)
  const char*Kbase=shm+LDS_K; bf16x8 kf[8];
  const lds_cptr shm3=(lds_cptr)shm; const lds_cptr kp0=shm3+LDS_K+hi*1024+r32*16; const lds_cptr vp0=shm3+LDS_V+((lane>>4)&1)*32+(lane&3)*8+(4*hi+((lane&15)>>2))*64;
  const int NT=(q0+QB)/KVBLK;
  DMA_K(0,0);DMA_V(0,0);DMA_K(1,SLOTK);
  bf16x8 qr[4];
  #pragma unroll
  for(int d0=0;d0<4;++d0)qr[d0]=*reinterpret_cast<const bf16x8*>(&Qw[(long)r32*DM+d0*16+hi*8]);
  float mhat=0.f,l_reg=0.f;f32x16 o[4];o[0]=f32x16{};o[1]=f32x16{};o[2]=f32x16{};o[3]=f32x16{};
  const int qrel=wid*QBLK+r32;
  #define CMASK(P0,P1,t) do{int jb_=(t)-(NT-4); if(jb_>=0)cmask(P0,P1,jb_,qrel,hi);}while(0)
  bool resc=false;
  #define RESC() do{ if(resc){ asm volatile("s_waitcnt lgkmcnt(0)":::"memory"); \
      _Pragma("unroll") for(int r=0;r<16;++r){ const float f_=wsf[crow(r,hi)]; o[0][r]*=f_; o[1][r]*=f_; o[2][r]*=f_; o[3][r]*=f_; } } }while(0)
  f32x16 C0,C1; u32x4 pwa0,pwa1,pwa2,pwa3;
  int sk_prev=0,sk_cur=0,sk_next=SLOTK, sv_prev=0,sv_cur=0,sv_next=SLOTV;
  #define ROT() do{sk_prev=sk_cur;sk_cur=sk_next;sk_next=(sk_next==(NSLOT-1)*SLOTK)?0:sk_next+SLOTK; sv_prev=sv_cur;sv_cur=sv_next;sv_next=(sv_next==(NSLOT-1)*SLOTV)?0:sv_next+SLOTV;}while(0)
  #define PKW(P,B) cvtpk_s(P[B],P[B+1])
  DMA_K(2,2*SLOTK);
  WAIT_BAR(4);
  qkt(C0,C1,Kbase,qr,r32,hi);asm volatile("s_nop 15\n\ts_nop 7":"+v"(C0),"+v"(C1));CMASK(C0,C1,0);
  { const float rm=rowmax(C0,C1); mhat=rm;
    _Pragma("unroll") for(int r=0;r<16;++r){C0[r]=fsub_s(C0[r],rm);C1[r]=fsub_s(C1[r],rm);}
    _Pragma("unroll") for(int r=0;r<16;++r){C0[r]=__builtin_amdgcn_exp2f(C0[r]);C1[r]=__builtin_amdgcn_exp2f(C1[r]);}
    float s_=0.f; _Pragma("unroll") for(int r=0;r<16;++r)s_+=C0[r]+C1[r]; l_reg=s_;
    pwa0=(u32x4){PKW(C0,0),PKW(C0,2),PKW(C0,4),PKW(C0,6)};pwa1=(u32x4){PKW(C0,8),PKW(C0,10),PKW(C0,12),PKW(C0,14)};pwa2=(u32x4){PKW(C1,0),PKW(C1,2),PKW(C1,4),PKW(C1,6)};pwa3=(u32x4){PKW(C1,8),PKW(C1,10),PKW(C1,12),PKW(C1,14)}; }
  WAIT_BAR(0);
  DMA_K(3,0);DMA_V(1,SLOTV);
  ROT();
  { _Pragma("unroll") for(int j=0;j<8;++j)kf[j]=KLD(kp0+sk_cur+(j>>1)*2048+(j&1)*512); }
  WAIT_BAR(3);
  s16x4 vlo[16],vhi[16];
  #define PAF(S,k) __builtin_bit_cast(bf16x8,pw##S##k)
  #define VFR(i) (bf16x8){vlo[i][0],vlo[i][1],vlo[i][2],vlo[i][3],vhi[i][0],vhi[i][1],vhi[i][2],vhi[i][3]}
  #define PIN(x) asm volatile("":"+v"(x))
  #define MX3(a,b,c) __builtin_fmaxf(__builtin_fmaxf((a),(b)),(c))
  #define EX(v) __builtin_amdgcn_exp2f(v)
  #define VRDL(i) vlo[i]=vtr(vp_+(((i)>>2)*4096+((i)&3)*1024))
  #define VRDH(i) vhi[i]=vtr(vp_+(((i)>>2)*4096+((i)&3)*1024+512))
  #define STEP_AB(t,GK,GV,GL) do{ SBAR(); \
    const lds_cptr vp_=vp0+sv_prev; \
     C0=MFMA(kf[0],qr[0],f32x16{}); SBAR(); \
     C1=MFMA(kf[1],qr[0],f32x16{}); SBAR(); \
    VRDL(0); SBAR(); C0=MFMA(kf[2],qr[1],C0); SBAR(); \
    VRDH(0); SBAR(); C1=MFMA(kf[3],qr[1],C1); SBAR(); \
    VRDL(4); SBAR(); C0=MFMA(kf[4],qr[2],C0); SBAR(); \
    VRDH(4); SBAR(); C1=MFMA(kf[5],qr[2],C1); SBAR(); \
    VRDL(8); SBAR(); C0=MFMA(kf[6],qr[3],C0); SBAR(); \
    VRDH(8); SBAR(); C1=MFMA(kf[7],qr[3],C1); SBAR(); \
    if(GK){DMA_K((t)+3,sk_cur);} if(GV){DMA_V((t)+1,sv_next);} \
    CMASK(C0,C1,t); \
    { float a=MX3(C0[0],C0[1],C1[0]),b=MX3(C0[2],C0[3],C1[1]); a=MX3(a,C1[2],C1[3]); \
      _Pragma("unroll") for(int r=4;r<16;r+=4){a=MX3(a,C0[r],C0[r+1]);b=MX3(b,C0[r+2],C0[r+3]);a=MX3(a,C1[r],C1[r+1]);b=MX3(b,C1[r+2],C1[r+3]);} \
      float rm=__builtin_fmaxf(a,b); { auto rr=__builtin_amdgcn_permlane32_swap(__float_as_uint(rm),__float_as_uint(rm),false,false); rm=__builtin_fmaxf(__uint_as_float(rr[0]),__uint_as_float(rr[1])); } \
      resc=false; \
      rm-=mhat; \
      if(__builtin_expect(__any(rm>(float)THRL),0)){ const float dl=__builtin_fmaxf(rm,0.f); mhat+=dl; \
        const float f=__builtin_amdgcn_exp2f(-dl); l_reg*=f; if(hi==0)wsf[r32]=f; resc=true; } \
      _Pragma("unroll") for(int r=0;r<16;++r){C0[r]-=mhat;C1[r]-=mhat;} } \
    SBAR(); float sacc=0.f; \
    VRDL(12); VRDH(12); SBAR(); o[0]=MFMA(PAF(a,0),VFR(0),o[0]); C0[0]=EX(C0[0]); C0[1]=EX(C0[1]); PIN(C0); SBAR(); \
    VRDL(1); VRDH(1); SBAR(); o[1]=MFMA(PAF(a,0),VFR(4),o[1]); C0[2]=EX(C0[2]); C0[3]=EX(C0[3]); PIN(C0); sacc+=(C0[0]+C0[1]); PIN(sacc); SBAR(); \
    VRDL(5); VRDH(5); SBAR(); o[2]=MFMA(PAF(a,0),VFR(8),o[2]); C0[4]=EX(C0[4]); C0[5]=EX(C0[5]); PIN(C0); sacc+=(C0[2]+C0[3]); PIN(sacc); SBAR(); \
    VRDL(9); VRDH(9); SBAR(); o[3]=MFMA(PAF(a,0),VFR(12),o[3]); C0[6]=EX(C0[6]); C0[7]=EX(C0[7]); PIN(C0); sacc+=(C0[4]+C0[5]); PIN(sacc); SBAR(); \
    VRDL(13); VRDH(13); if(GL){ kf[0]=KLD(kp0+sk_next+0); } SBAR(); o[0]=MFMA(PAF(a,1),VFR(1),o[0]); C0[8]=EX(C0[8]); C0[9]=EX(C0[9]); PIN(C0); sacc+=(C0[6]+C0[7]); PIN(sacc); pwa0[0]=PKW(C0,0); PIN(pwa0); SBAR(); \
    VRDL(2); VRDH(2); if(GL){ kf[1]=KLD(kp0+sk_next+512); } SBAR(); o[1]=MFMA(PAF(a,1),VFR(5),o[1]); C0[10]=EX(C0[10]); C0[11]=EX(C0[11]); PIN(C0); sacc+=(C0[8]+C0[9]); PIN(sacc); pwa0[1]=PKW(C0,2); PIN(pwa0); SBAR(); \
    VRDL(6); VRDH(6); if(GL){ kf[2]=KLD(kp0+sk_next+2048); } SBAR(); o[2]=MFMA(PAF(a,1),VFR(9),o[2]); C0[12]=EX(C0[12]); C0[13]=EX(C0[13]); PIN(C0); sacc+=(C0[10]+C0[11]); PIN(sacc); pwa0[2]=PKW(C0,4); PIN(pwa0); SBAR(); \
    VRDL(10); VRDH(10); if(GL){ kf[3]=KLD(kp0+sk_next+2560); } SBAR(); o[3]=MFMA(PAF(a,1),VFR(13),o[3]); C0[14]=EX(C0[14]); C0[15]=EX(C0[15]); PIN(C0); sacc+=(C0[12]+C0[13]); PIN(sacc); pwa0[3]=PKW(C0,6); PIN(pwa0); SBAR(); \
    VRDL(14); VRDH(14); if(GL){ kf[4]=KLD(kp0+sk_next+4096); } SBAR(); o[0]=MFMA(PAF(a,2),VFR(2),o[0]); C1[0]=EX(C1[0]); C1[1]=EX(C1[1]); PIN(C1); sacc+=(C0[14]+C0[15]); PIN(sacc); pwa1[0]=PKW(C0,8); PIN(pwa1); SBAR(); \
    VRDL(3); VRDH(3); if(GL){ kf[5]=KLD(kp0+sk_next+4608); } SBAR(); o[1]=MFMA(PAF(a,2),VFR(6),o[1]); C1[2]=EX(C1[2]); C1[3]=EX(C1[3]); PIN(C1); sacc+=(C1[0]+C1[1]); PIN(sacc); pwa1[1]=PKW(C0,10); PIN(pwa1); SBAR(); \
    VRDL(7); VRDH(7); if(GL){ kf[6]=KLD(kp0+sk_next+6144); } SBAR(); o[2]=MFMA(PAF(a,2),VFR(10),o[2]); C1[4]=EX(C1[4]); C1[5]=EX(C1[5]); PIN(C1); sacc+=(C1[2]+C1[3]); PIN(sacc); pwa1[2]=PKW(C0,12); PIN(pwa1); SBAR(); \
    VRDL(11); VRDH(11); if(GL){ kf[7]=KLD(kp0+sk_next+6656); } SBAR(); o[3]=MFMA(PAF(a,2),VFR(14),o[3]); C1[6]=EX(C1[6]); C1[7]=EX(C1[7]); PIN(C1); sacc+=(C1[4]+C1[5]); PIN(sacc); pwa1[3]=PKW(C0,14); PIN(pwa1); SBAR(); \
    VRDL(15); VRDH(15); SBAR(); o[0]=MFMA(PAF(a,3),VFR(3),o[0]); C1[8]=EX(C1[8]); C1[9]=EX(C1[9]); PIN(C1); sacc+=(C1[6]+C1[7]); PIN(sacc); pwa2[0]=PKW(C1,0); PIN(pwa2); SBAR(); \
    o[1]=MFMA(PAF(a,3),VFR(7),o[1]); C1[10]=EX(C1[10]); C1[11]=EX(C1[11]); PIN(C1); sacc+=(C1[8]+C1[9]); PIN(sacc); pwa2[1]=PKW(C1,2); PIN(pwa2); SBAR(); \
    o[2]=MFMA(PAF(a,3),VFR(11),o[2]); C1[12]=EX(C1[12]); C1[13]=EX(C1[13]); PIN(C1); sacc+=(C1[10]+C1[11]); PIN(sacc); pwa2[2]=PKW(C1,4); PIN(pwa2); SBAR(); \
    o[3]=MFMA(PAF(a,3),VFR(15),o[3]); C1[14]=EX(C1[14]); C1[15]=EX(C1[15]); PIN(C1); sacc+=(C1[12]+C1[13]); PIN(sacc); pwa2[3]=PKW(C1,6); PIN(pwa2); SBAR(); \
    sacc+=(C1[14]+C1[15]); pwa3[0]=PKW(C1,8); pwa3[1]=PKW(C1,10); pwa3[2]=PKW(C1,12); pwa3[3]=PKW(C1,14); PIN(pwa3); l_reg+=sacc; \
    }while(0)
  #define STEP_BA(t,GK,GV,GL) do{ SBAR(); \
    const lds_cptr vp_=vp0+sv_prev; \
     C0=MFMA(kf[0],qr[0],f32x16{}); SBAR(); \
     C1=MFMA(kf[1],qr[0],f32x16{}); SBAR(); \
    VRDL(0); SBAR(); C0=MFMA(kf[2],qr[1],C0); SBAR(); \
    VRDH(0); SBAR(); C1=MFMA(kf[3],qr[1],C1); SBAR(); \
    VRDL(4); SBAR(); C0=MFMA(kf[4],qr[2],C0); SBAR(); \
    VRDH(4); SBAR(); C1=MFMA(kf[5],qr[2],C1); SBAR(); \
    VRDL(8); SBAR(); C0=MFMA(kf[6],qr[3],C0); SBAR(); \
    VRDH(8); SBAR(); C1=MFMA(kf[7],qr[3],C1); SBAR(); \
    if(GK){DMA_K((t)+3,sk_cur);} if(GV){DMA_V((t)+1,sv_next);} \
    CMASK(C0,C1,t); \
    { float a=MX3(C0[0],C0[1],C1[0]),b=MX3(C0[2],C0[3],C1[1]); a=MX3(a,C1[2],C1[3]); \
      _Pragma("unroll") for(int r=4;r<16;r+=4){a=MX3(a,C0[r],C0[r+1]);b=MX3(b,C0[r+2],C0[r+3]);a=MX3(a,C1[r],C1[r+1]);b=MX3(b,C1[r+2],C1[r+3]);} \
      float rm=__builtin_fmaxf(a,b); { auto rr=__builtin_amdgcn_permlane32_swap(__float_as_uint(rm),__float_as_uint(rm),false,false); rm=__builtin_fmaxf(__uint_as_float(rr[0]),__uint_as_float(rr[1])); } \
      resc=false; \
      rm-=mhat; \
      if(__builtin_expect(__any(rm>(float)THRL),0)){ const float dl=__builtin_fmaxf(rm,0.f); mhat+=dl; \
        const float f=__builtin_amdgcn_exp2f(-dl); l_reg*=f; if(hi==0)wsf[r32]=f; resc=true; } \
      _Pragma("unroll") for(int r=0;r<16;++r){C0[r]-=mhat;C1[r]-=mhat;} } \
    SBAR(); float sacc=0.f; \
    VRDL(12); VRDH(12); SBAR(); o[0]=MFMA(PAF(a,0),VFR(0),o[0]); C0[0]=EX(C0[0]); C0[1]=EX(C0[1]); PIN(C0); SBAR(); \
    VRDL(1); VRDH(1); SBAR(); o[1]=MFMA(PAF(a,0),VFR(4),o[1]); C0[2]=EX(C0[2]); C0[3]=EX(C0[3]); PIN(C0); sacc+=(C0[0]+C0[1]); PIN(sacc); SBAR(); \
    VRDL(5); VRDH(5); SBAR(); o[2]=MFMA(PAF(a,0),VFR(8),o[2]); C0[4]=EX(C0[4]); C0[5]=EX(C0[5]); PIN(C0); sacc+=(C0[2]+C0[3]); PIN(sacc); SBAR(); \
    VRDL(9); VRDH(9); SBAR(); o[3]=MFMA(PAF(a,0),VFR(12),o[3]); C0[6]=EX(C0[6]); C0[7]=EX(C0[7]); PIN(C0); sacc+=(C0[4]+C0[5]); PIN(sacc); SBAR(); \
    VRDL(13); VRDH(13); if(GL){ kf[0]=KLD(kp0+sk_next+0); } SBAR(); o[0]=MFMA(PAF(a,1),VFR(1),o[0]); C0[8]=EX(C0[8]); C0[9]=EX(C0[9]); PIN(C0); sacc+=(C0[6]+C0[7]); PIN(sacc); pwa0[0]=PKW(C0,0); PIN(pwa0); SBAR(); \
    VRDL(2); VRDH(2); if(GL){ kf[1]=KLD(kp0+sk_next+512); } SBAR(); o[1]=MFMA(PAF(a,1),VFR(5),o[1]); C0[10]=EX(C0[10]); C0[11]=EX(C0[11]); PIN(C0); sacc+=(C0[8]+C0[9]); PIN(sacc); pwa0[1]=PKW(C0,2); PIN(pwa0); SBAR(); \
    VRDL(6); VRDH(6); if(GL){ kf[2]=KLD(kp0+sk_next+2048); } SBAR(); o[2]=MFMA(PAF(a,1),VFR(9),o[2]); C0[12]=EX(C0[12]); C0[13]=EX(C0[13]); PIN(C0); sacc+=(C0[10]+C0[11]); PIN(sacc); pwa0[2]=PKW(C0,4); PIN(pwa0); SBAR(); \
    VRDL(10); VRDH(10); if(GL){ kf[3]=KLD(kp0+sk_next+2560); } SBAR(); o[3]=MFMA(PAF(a,1),VFR(13),o[3]); C0[14]=EX(C0[14]); C0[15]=EX(C0[15]); PIN(C0); sacc+=(C0[12]+C0[13]); PIN(sacc); pwa0[3]=PKW(C0,6); PIN(pwa0); SBAR(); \
    VRDL(14); VRDH(14); if(GL){ kf[4]=KLD(kp0+sk_next+4096); } SBAR(); o[0]=MFMA(PAF(a,2),VFR(2),o[0]); C1[0]=EX(C1[0]); C1[1]=EX(C1[1]); PIN(C1); sacc+=(C0[14]+C0[15]); PIN(sacc); pwa1[0]=PKW(C0,8); PIN(pwa1); SBAR(); \
    VRDL(3); VRDH(3); if(GL){ kf[5]=KLD(kp0+sk_next+4608); } SBAR(); o[1]=MFMA(PAF(a,2),VFR(6),o[1]); C1[2]=EX(C1[2]); C1[3]=EX(C1[3]); PIN(C1); sacc+=(C1[0]+C1[1]); PIN(sacc); pwa1[1]=PKW(C0,10); PIN(pwa1); SBAR(); \
    VRDL(7); VRDH(7); if(GL){ kf[6]=KLD(kp0+sk_next+6144); } SBAR(); o[2]=MFMA(PAF(a,2),VFR(10),o[2]); C1[4]=EX(C1[4]); C1[5]=EX(C1[5]); PIN(C1); sacc+=(C1[2]+C1[3]); PIN(sacc); pwa1[2]=PKW(C0,12); PIN(pwa1); SBAR(); \
    VRDL(11); VRDH(11); if(GL){ kf[7]=KLD(kp0+sk_next+6656); } SBAR(); o[3]=MFMA(PAF(a,2),VFR(14),o[3]); C1[6]=EX(C1[6]); C1[7]=EX(C1[7]); PIN(C1); sacc+=(C1[4]+C1[5]); PIN(sacc); pwa1[3]=PKW(C0,14); PIN(pwa1); SBAR(); \
    VRDL(15); VRDH(15); SBAR(); o[0]=MFMA(PAF(a,3),VFR(3),o[0]); C1[8]=EX(C1[8]); C1[9]=EX(C1[9]); PIN(C1); sacc+=(C1[6]+C1[7]); PIN(sacc); pwa2[0]=PKW(C1,0); PIN(pwa2); SBAR(); \
    o[1]=MFMA(PAF(a,3),VFR(7),o[1]); C1[10]=EX(C1[10]); C1[11]=EX(C1[11]); PIN(C1); sacc+=(C1[8]+C1[9]); PIN(sacc); pwa2[1]=PKW(C1,2); PIN(pwa2); SBAR(); \
    o[2]=MFMA(PAF(a,3),VFR(11),o[2]); C1[12]=EX(C1[12]); C1[13]=EX(C1[13]); PIN(C1); sacc+=(C1[10]+C1[11]); PIN(sacc); pwa2[2]=PKW(C1,4); PIN(pwa2); SBAR(); \
    o[3]=MFMA(PAF(a,3),VFR(15),o[3]); C1[14]=EX(C1[14]); C1[15]=EX(C1[15]); PIN(C1); sacc+=(C1[12]+C1[13]); PIN(sacc); pwa2[3]=PKW(C1,6); PIN(pwa2); SBAR(); \
    sacc+=(C1[14]+C1[15]); pwa3[0]=PKW(C1,8); pwa3[1]=PKW(C1,10); pwa3[2]=PKW(C1,12); pwa3[3]=PKW(C1,14); PIN(pwa3); l_reg+=sacc; \
    }while(0)

  int t=1;
  #undef CMASK
  #define CMASK(P0,P1,t) do{}while(0)
  for(;t+5<NT;t+=2){
    STEP_AB(t,true,true,true);     WAIT_BAR(3); RESC(); ROT();
    STEP_BA(t+1,true,true,true);   WAIT_BAR(3); RESC(); ROT();
  }
  #undef CMASK
  #define CMASK(P0,P1,t) do{int jb_=(t)-(NT-4); if(jb_>=0)cmask(P0,P1,jb_,qrel,hi);}while(0)
  #define ENDW(tt) do{ if((tt)+3<NT){WAIT_BAR(3);} else if((tt)+2<NT){WAIT_BAR(2);} else {WAIT_BAR(0);} }while(0)
  for(;t+1<NT;t+=2){
    STEP_AB(t,(t+3<NT),(t+1<NT),(t+1<NT));       ENDW(t);   RESC(); ROT();
    STEP_BA(t+1,(t+4<NT),(t+2<NT),(t+2<NT));     ENDW(t+1); RESC(); ROT();
  }
  STEP_AB(NT-1,false,false,false); RESC();
  SBAR(); pv4(o,(int)(unsigned long)(vp0+sv_cur),PAF(a,0),PAF(a,1),PAF(a,2),PAF(a,3));
  #undef PKW
  #undef PAF
  #undef VFR
  #undef PIN
  #undef MX3
  #undef EX
  #undef VRDL
  #undef VRDH
  #undef STEP_AB
  #undef STEP_BA
  #undef ENDW
  {auto rr=__builtin_amdgcn_permlane32_swap(__float_as_uint(l_reg),__float_as_uint(l_reg),false,false);l_reg=__uint_as_float(rr[0])+__uint_as_float(rr[1]);}
  if(hi==0)wsf[32+r32]=l_reg;asm volatile("s_waitcnt lgkmcnt(0)":::"memory");
  float rli[16];
  #pragma unroll
  for(int r=0;r<16;++r)rli[r]=__builtin_amdgcn_rcpf(wsf[32+crow(r,hi)]);
  int l2_=lane_id_(); asm volatile("":"+v"(l2_));
  bf16*Ow=O+(rowbase+q0+wid*QBLK)*OPITCH+h*VW;
  { char*stg=shm+LDS_OST+wid*(32*OSTP);
    #pragma unroll
    for(int r=0;r<16;++r){const int orow=crow(r,hi);
      #pragma unroll
      for(int d0=0;d0<4;++d0)*(bf16*)(stg+orow*OSTP+(d0*32+r32)*2)=__float2bfloat16(o[d0][r]*rli[r]);}
    asm volatile("s_waitcnt lgkmcnt(0)":::"memory");
    #pragma unroll
    for(int i=0;i<8;++i){const int row=i*4+(l2_>>4),ch=l2_&15; const u32x4 v=*(const u32x4*)(stg+row*OSTP+ch*16); ATTN_STORE16(Ow+(long)row*OPITCH+ch*8,v);} }
  asm volatile("s_waitcnt lgkmcnt(0)\n\ts_barrier":::"memory");
  #undef DMA_K
  #undef DMA_V
  #undef CMASK
  #undef RESC
  #undef ROT
}
constexpr int ATTN_LDS_BYTES=LDS_BYTES;
struct AttnTensors { const bf16* Q; const bf16* K; const bf16* V; bf16* O; };
struct AttnUnit { int bh; int qb; };
struct StaticOrder {
  int vcu, G;
  __device__ __forceinline__ explicit StaticOrder(int vcu_,int G_):vcu(vcu_),G(G_){}
  __device__ __forceinline__ bool next(int i,AttnUnit&u)const{ const int w=vcu+(i>>3)*G; if(w>=BATCH*NHEAD*2)return false; u.bh=w>>1; const int j=w&1,k=i&7,base=4*(k>>1); u.qb=(k&1)?(base+3-j):(base+j); return true; }
};
template<class Sched,int THRL=8> __device__ __forceinline__ void attn_phase(char*lds,const AttnTensors&T,const Sched&S,const int wave_){
  AttnUnit u;
  for(int i=0;S.next(i,u);++i){ attn_unit<THRL>(u.bh/NHEAD,u.bh%NHEAD,u.qb,T.Q,T.K,T.V,T.O,lds,wave_); }
}
#undef SBAR
#undef WAIT_BAR
#undef MFMA
#undef KLD
}
#define GAS __attribute__((address_space(1)))
#define LAS __attribute__((address_space(3)))
#define XB_TMO      128
#define XB_XCNT(j)  (256  + 64 * (j))
#define XB_XSUB(j)  (1280 + 64 * (j))
#define XB_XGEN(j)  (2304 + 64 * (j))
#define XB_TOP      3328
#define XB_TOPGEN   3392
#define XCD_BAR_WORDS 3456
#define XB_SPIN_CAP (1u << 18)

__device__ __forceinline__ unsigned xb_ld(unsigned* p)              { return __hip_atomic_load(p, __ATOMIC_RELAXED, __HIP_MEMORY_SCOPE_AGENT); }
__device__ __forceinline__ unsigned xb_add(unsigned* p, unsigned v) { return __hip_atomic_fetch_add(p, v, __ATOMIC_RELAXED, __HIP_MEMORY_SCOPE_AGENT); }
__device__ __forceinline__ unsigned xb_xcc_id() { return (unsigned)__builtin_amdgcn_s_getreg((3 << 11) | 20) & 0xFu; }
#define XB_SPIN(cond, bar) do { unsigned _sp = 0; while (cond) { __builtin_amdgcn_s_sleep(1); \
    if ((++_sp & 255u) == 0u) { if (xb_ld(&(bar)[XB_TMO])) break; if (_sp > XB_SPIN_CAP) { atomicAdd(&(bar)[XB_TMO], 1u); break; } } } } while (0)

struct XcdBarrier {
    unsigned* bar; unsigned x;
    volatile LAS unsigned* st;
};

__device__ __forceinline__ XcdBarrier xcd_barrier_post(unsigned* bar, volatile LAS unsigned* st, const bool lane0w0) {
    XcdBarrier b; b.bar = bar; b.x = xb_xcc_id(); b.st = st;
    if (lane0w0) (void)xb_add(&bar[XB_XCNT(b.x)], 1u);
    return b;
}
__device__ __forceinline__ void xcd_barrier_complete(unsigned* bar, unsigned x, unsigned& nloc, unsigned& nx) {
    const unsigned G = gridDim.x * gridDim.y * gridDim.z;
    unsigned sum, cnt, mine, sp = 0u;
    for (;;) {
        sum = 0u; cnt = 0u; mine = 0u;
#pragma unroll
        for (unsigned j = 0; j < 16; ++j) { const unsigned c = xb_ld(&bar[XB_XCNT(j)]); sum += c; cnt += (c > 0u) ? 1u : 0u; mine = (j == x) ? c : mine; }
        if (sum == G) break;
        __builtin_amdgcn_s_sleep(1);
        if ((++sp & 255u) == 0u) { if (xb_ld(&bar[XB_TMO])) break; if (sp > XB_SPIN_CAP) { atomicAdd(&bar[XB_TMO], 1u); break; } }
    }
    nloc = mine > 0u ? mine : 1u; nx = cnt > 0u ? cnt : 1u;
}

__device__ __forceinline__ void xcd_barrier(const XcdBarrier& b, const bool lane0w0) {
    asm volatile("s_waitcnt vmcnt(0)" ::: "memory");
    __syncthreads();
    if (lane0w0) {
        unsigned* bar = b.bar;
        __builtin_amdgcn_s_waitcnt(0);
        unsigned nloc = b.st[0], nx = b.st[1];
        if (nloc == 0u) { xcd_barrier_complete(bar, b.x, nloc, nx); b.st[0] = nloc; b.st[1] = nx; }
        const unsigned old = xb_add(&bar[XB_XSUB(b.x)], 1u);
        const unsigned gen = old / nloc;
        if (old + 1u == (gen + 1u) * nloc) {
            __builtin_amdgcn_fence(__ATOMIC_RELEASE, "agent");
            asm volatile("s_waitcnt vmcnt(0)" ::: "memory");
            const unsigned og = xb_add(&bar[XB_TOP], 1u);
            const unsigned tg = og / nx;
            if (og + 1u == (tg + 1u) * nx) xb_add(&bar[XB_TOPGEN], 1u);
            else XB_SPIN(xb_ld(&bar[XB_TOPGEN]) == tg, bar);
            __builtin_amdgcn_fence(__ATOMIC_ACQUIRE, "agent");
            xb_add(&bar[XB_XGEN(b.x)], 1u);
            asm volatile("s_waitcnt vmcnt(0)" ::: "memory");
        } else {
            XB_SPIN(xb_ld(&bar[XB_XGEN(b.x)]) == gen, bar);
            __builtin_amdgcn_fence(__ATOMIC_ACQUIRE, "agent");
            asm volatile("s_waitcnt vmcnt(0)" ::: "memory");
        }
    }
    __syncthreads();
}
constexpr int NWAVES = 8;
constexpr int BATCH = 8, SEQ = 4096, D = 1024, M = BATCH * SEQ, NIN = 8192;
constexpr float NORM_EPS = 1e-6f;
constexpr float LAM_INIT = 0.2f;
constexpr size_t MiB = 1u << 20, SLOT = 64 * MiB;
constexpr size_t WS_XR = 0 * SLOT, WS_ZR = 1 * SLOT  , WS_Q = 2 * SLOT  , WS_K = 3 * SLOT  , WS_V = 4 * SLOT  , WS_ZA = 5 * SLOT  , WS_U = 6 * SLOT;
constexpr size_t WS_MISC = 7 * SLOT;
constexpr size_t WS_CTL = WS_MISC, CTL_ZERO_BYTES = 64 * 1024;
constexpr size_t WS_CARRY = WS_MISC + 1 * MiB;
constexpr size_t WS_STATS = WS_MISC + 2 * MiB;
constexpr size_t WS_WIN = WS_MISC + 4 * MiB;
constexpr size_t WS_WR = WS_MISC + 20 * MiB, WS_WA = WS_MISC + 22 * MiB, WS_WO = WS_MISC + 24 * MiB, WS_END = WS_MISC + 26 * MiB;
constexpr int LDS_BYTES = 147456;
constexpr int MISC_OFF = 147456 - 256;

typedef unsigned short bf16;
typedef unsigned v4u __attribute__((ext_vector_type(4)));
typedef float f32x4 __attribute__((ext_vector_type(4)));
typedef float f32x16 __attribute__((ext_vector_type(16)));
typedef short bf16x8 __attribute__((ext_vector_type(8)));
#define LDS_WAIT() asm volatile("s_waitcnt lgkmcnt(0)" ::: "memory")
__device__ __forceinline__ unsigned f2bf(float f) { unsigned u = __builtin_bit_cast(unsigned, f); return (u + 0x7fffu + ((u >> 16) & 1u)) >> 16; }
typedef float f32x2_ __attribute__((ext_vector_type(2))); typedef __bf16 bf16x2_ __attribute__((ext_vector_type(2)));
__device__ __forceinline__ unsigned pk2(float lo, float hi) { f32x2_ v = {lo, hi}; return __builtin_bit_cast(unsigned, __builtin_convertvector(v, bf16x2_)); }
__device__ __forceinline__ float bflo(unsigned w) { return __builtin_bit_cast(float, w << 16); }
__device__ __forceinline__ float bfhi(unsigned w) { return __builtin_bit_cast(float, w & 0xffff0000u); }
__device__ __forceinline__ float sigm(float v) { return __builtin_amdgcn_rcpf(1.0f + __builtin_amdgcn_exp2f(-1.4426950408889634f * v)); }
__device__ __forceinline__ float wave_sum(float v) {
#pragma unroll
    for (int o = 1; o < 64; o <<= 1) v += __shfl_xor(v, o);
    return v;
}

struct Frame {
    LAS unsigned char* lds;
    int wave, vcu, G;
    const float* in[19]; float* out; unsigned char* ws;
};
enum { I_X = 0, I_PREG, I_POSTG, I_WIN, I_CONVW, I_CONVB, I_WA, I_BA, I_WX, I_BX, I_LRUA, I_LQ1, I_LK1, I_LQ2, I_LK2, I_SUBG, I_WBR, I_WBA, I_WOUT };

__device__ __forceinline__ void p0_transpose_item(const float* W, int K, int N, bf16* WT, LAS float* scr, int item, int lane) {
    const int nblk = N / 32, kb = item / nblk, nb = item % nblk, k0 = 64 * kb, n0 = 32 * nb;
#pragma unroll 8
    for (int i = 0; i < 32; ++i) { const int kk = 2 * i + (lane >> 5); scr[kk * 33 + (lane & 31)] = W[(size_t)(k0 + kk) * N + n0 + (lane & 31)]; }
    LDS_WAIT(); asm volatile("" ::: "memory");
    const int c = lane & 7;
#pragma unroll
    for (int j = 0; j < 4; ++j) { const int n = (lane >> 3) + 8 * j; const LAS float* s = scr + (8 * c) * 33 + n;
        v4u o; o.x = pk2(s[0 * 33], s[1 * 33]); o.y = pk2(s[2 * 33], s[3 * 33]); o.z = pk2(s[4 * 33], s[5 * 33]); o.w = pk2(s[6 * 33], s[7 * 33]);
        *(GAS v4u*)(WT + (size_t)(n0 + n) * K + k0 + 8 * c) = o; }
    LDS_WAIT(); asm volatile("" ::: "memory");
}
__device__ __forceinline__ void p0_prologue(Frame& F) {
    LAS float* scr = (LAS float*)(F.lds + F.wave * 16384);
    const int gw = F.vcu * NWAVES + F.wave, NGW = F.G * NWAVES;
    constexpr int I_BIG = (D / 64) * (NIN / 32), I_SM = (D / 64) * (D / 32);
    constexpr int NITEMS = I_BIG + 3 * I_SM;
    for (int it = gw; it < NITEMS; it += NGW) {
        int r = it;
        if (r < I_BIG) { p0_transpose_item(F.in[I_WIN], D, NIN, (bf16*)(F.ws + WS_WIN), scr, r, lane_id_()); continue; } r -= I_BIG;
        if (r < I_SM) { p0_transpose_item(F.in[I_WBR], D, D, (bf16*)(F.ws + WS_WR), scr, r, lane_id_()); continue; } r -= I_SM;
        if (r < I_SM) { p0_transpose_item(F.in[I_WBA], D, D, (bf16*)(F.ws + WS_WA), scr, r, lane_id_()); continue; } r -= I_SM;
        p0_transpose_item(F.in[I_WOUT], D, D, (bf16*)(F.ws + WS_WO), scr, r, lane_id_());
    }
    const GAS f32x4* gp = (const GAS f32x4*)F.in[I_PREG] + lane_id_();
    f32x4 gg[4];
#pragma unroll
    for (int j = 0; j < 4; ++j) gg[j] = gp[64 * j];
    for (int m = gw; m < M; m += NGW) {
        const GAS f32x4* xr = (const GAS f32x4*)(F.in[I_X] + (size_t)m * D) + lane_id_();
        f32x4 v[4]; float s = 0.f;
#pragma unroll
        for (int j = 0; j < 4; ++j) { v[j] = xr[64 * j]; s += (v[j].x * v[j].x + v[j].y * v[j].y) + (v[j].z * v[j].z + v[j].w * v[j].w); }
        const float rstd = 1.0f / sqrtf(wave_sum(s) * (1.f / D) + NORM_EPS);
        GAS unsigned long long* o8 = (GAS unsigned long long*)((bf16*)(F.ws + WS_U) + (size_t)m * D) + lane_id_();
#pragma unroll
        for (int j = 0; j < 4; ++j) { const f32x4 y = v[j] * rstd * gg[j]; o8[64 * j] = (unsigned long long)pk2(y.x, y.y) | ((unsigned long long)pk2(y.z, y.w) << 32); }
    }
}

constexpr int SC_WFRAG = 0;
constexpr int SC_CONV = 16384;
constexpr int SC_WAVE = 16384 + 2048, SC_WAVE_BYTES = 5120 + 4608;
__device__ __forceinline__ int crow16(int r, int hi) { return (r & 3) + 8 * (r >> 2) + 4 * hi; }
template <bool PASS2> __device__ __forceinline__ void scan_phase(Frame& F) {
    const int lane = lane_id_(), tid_ = F.wave * 64 + lane, r32 = lane & 31, hi = lane >> 5;
    LAS unsigned char* const lw = F.lds + SC_WAVE + F.wave * SC_WAVE_BYTES;
    LAS unsigned char* const lz = lw + 5120;
    const LAS float* const lc = (const LAS float*)(F.lds + SC_CONV);
    const bf16* XR = (const bf16*)(F.ws + WS_XR); bf16* ZR = (bf16*)(F.ws + WS_ZR);
    float* carry = (float*)(F.ws + WS_CARRY);
    for (int wi = F.vcu; wi < BATCH * 16 * 2; wi += F.G) {
        const int b = wi >> 5, g = (wi >> 1) & 15, half = wi & 1, sc = half * 8 + F.wave, c0 = g * 64;
        __syncthreads();
        for (int idx = tid_; idx < 1024; idx += NWAVES * 64) {
            const int mat = idx >> 9, f = (idx >> 6) & 7, kk = f >> 1, nt = f & 1, ln = idx & 63, n = 32 * nt + (ln & 31), kb = 16 * kk + 8 * (ln >> 5);
            const float* W = F.in[mat ? I_WX : I_WA] + (size_t)(g * 64 + kb) * 64 + n;
            v4u o; o.x = pk2(W[0], W[64]); o.y = pk2(W[128], W[192]); o.z = pk2(W[256], W[320]); o.w = pk2(W[384], W[448]);
            *(LAS v4u*)(F.lds + SC_WFRAG + idx * 16) = o;
        }
        if (tid_ < 320) { const int tap = tid_ >> 6, ch = tid_ & 63; ((LAS float*)(F.lds + SC_CONV))[tid_] = (tap < 4) ? F.in[I_CONVW][tap * D + c0 + ch] : F.in[I_CONVB][c0 + ch]; }
        __syncthreads();
        float cba[2], cbx[2], ckc[2], H[2], P[2];
#pragma unroll
        for (int nt = 0; nt < 2; ++nt) { const int c = c0 + 32 * nt + r32; cba[nt] = F.in[I_BA][c]; cbx[nt] = F.in[I_BX][c];
            ckc[nt] = -8.0f * 1.4426950408889634f * log1pf(expf(-F.in[I_LRUA][c])); H[nt] = 0.f; P[nt] = 1.f; }
        if (PASS2) {
            for (int j0 = 0; j0 < sc; j0 += 8) {
                float2 ab[8][2];
#pragma unroll
                for (int jj = 0; jj < 8; ++jj)
#pragma unroll
                    for (int nt = 0; nt < 2; ++nt) ab[jj][nt] = *(const float2*)(carry + ((size_t)(b * 16 + ((j0 + jj) & 15)) * D + c0 + 32 * nt + r32) * 2);
#pragma unroll
                for (int jj = 0; jj < 8; ++jj) if (j0 + jj < sc) {
#pragma unroll
                    for (int nt = 0; nt < 2; ++nt) H[nt] = ab[jj][nt].x * H[nt] + ab[jj][nt].y; }
            }
        }
        bf16x8 idf[4];
#pragma unroll
        for (int kk = 0; kk < 4; ++kk) { const int d = (32 * (kk >> 1) + r32) - (16 * kk + 8 * hi); v4u w;
            w.x = (d == 0 ? 0x3F80u : 0u) | (d == 1 ? 0x3F800000u : 0u); w.y = (d == 2 ? 0x3F80u : 0u) | (d == 3 ? 0x3F800000u : 0u);
            w.z = (d == 4 ? 0x3F80u : 0u) | (d == 5 ? 0x3F800000u : 0u); w.w = (d == 6 ? 0x3F80u : 0u) | (d == 7 ? 0x3F800000u : 0u);
            idf[kk] = __builtin_bit_cast(bf16x8, w); }
        v4u nx[5], nz[4];
#define SC_LOAD(T0) do { _Pragma("unroll") for (int i = 0; i < 5; ++i) { const int row = i * 8 + (lane >> 3), ch = lane & 7, t = (T0) - 3 + row; \
                nx[i] = (v4u){0u, 0u, 0u, 0u}; if (row < 35 && t >= 0) nx[i] = *(const GAS v4u*)(XR + (size_t)(b * SEQ + t) * D + c0 + ch * 8); } \
            if (PASS2) { _Pragma("unroll") for (int i = 0; i < 4; ++i) { const int row = i * 8 + (lane >> 3), ch = lane & 7; \
                nz[i] = *(const GAS v4u*)(ZR + (size_t)(b * SEQ + (T0) + row) * D + c0 + ch * 8); } } } while (0)
        SC_LOAD(sc * 256);
        for (int sub = 0; sub < 8; ++sub) {
            const int t0 = sc * 256 + sub * 32;
#pragma unroll
            for (int i = 0; i < 5; ++i) { const int row = i * 8 + (lane >> 3), ch = lane & 7; if (row < 35) *(LAS v4u*)(lw + row * 144 + ch * 16) = nx[i]; }
            if (PASS2) {
#pragma unroll
                for (int i = 0; i < 4; ++i) { const int row = i * 8 + (lane >> 3), ch = lane & 7; *(LAS v4u*)(lz + row * 144 + ch * 16) = nz[i]; }
            }
            if (sub < 7) SC_LOAD(t0 + 32);
            bf16x8 af[4];
#pragma unroll
            for (int kk = 0; kk < 4; ++kk) { const int cb = 16 * kk + 8 * hi;
                f32x4 a0 = *(const LAS f32x4*)(lc + 256 + cb), a1 = *(const LAS f32x4*)(lc + 256 + cb + 4);
#pragma unroll
                for (int tap = 0; tap < 4; ++tap) { const v4u x = *(const LAS v4u*)(lw + (r32 + tap) * 144 + cb * 2);
                    const f32x4 w0 = *(const LAS f32x4*)(lc + tap * 64 + cb), w1 = *(const LAS f32x4*)(lc + tap * 64 + cb + 4);
                    a0[0] += w0[0] * bflo(x.x); a0[1] += w0[1] * bfhi(x.x); a0[2] += w0[2] * bflo(x.y); a0[3] += w0[3] * bfhi(x.y);
                    a1[0] += w1[0] * bflo(x.z); a1[1] += w1[1] * bfhi(x.z); a1[2] += w1[2] * bflo(x.w); a1[3] += w1[3] * bfhi(x.w); }
                v4u w; w.x = pk2(a0[0], a0[1]); w.y = pk2(a0[2], a0[3]); w.z = pk2(a1[0], a1[1]); w.w = pk2(a1[2], a1[3]);
                af[kk] = __builtin_bit_cast(bf16x8, w); }
#pragma unroll
            for (int nt = 0; nt < 2; ++nt) {
                f32x16 accR = {}, accI = {}, accX = {};
#pragma unroll
                for (int kk = 0; kk < 4; ++kk) {
                    const bf16x8 fa = *(const LAS bf16x8*)(F.lds + SC_WFRAG + ((0 * 8 + kk * 2 + nt) * 64 + lane) * 16);
                    const bf16x8 fx = *(const LAS bf16x8*)(F.lds + SC_WFRAG + ((1 * 8 + kk * 2 + nt) * 64 + lane) * 16);
                    accR = __builtin_amdgcn_mfma_f32_32x32x16_bf16(af[kk], fa, accR, 0, 0, 0);
                    accI = __builtin_amdgcn_mfma_f32_32x32x16_bf16(af[kk], fx, accI, 0, 0, 0);
                    if ((kk >> 1) == nt) accX = __builtin_amdgcn_mfma_f32_32x32x16_bf16(af[kk], idf[kk], accX, 0, 0, 0);
                }
                float Ap[16], hl[16], Aq[4], Bq[4];
#pragma unroll
                for (int q = 0; q < 4; ++q) { float pa = 1.f, hh = 0.f;
#pragma unroll
                    for (int j = 0; j < 4; ++j) { const int r = 4 * q + j;
                        const float rg = sigm(accR[r] + cba[nt]), ig = sigm(accI[r] + cbx[nt]);
                        const float a = __builtin_amdgcn_exp2f(ckc[nt] * rg);
                        const float bb = __builtin_amdgcn_sqrtf(fmaxf(1.0f - a * a, 0.f)) * ig * accX[r];
                        hh = a * hh + bb; pa *= a; Ap[r] = pa; hl[r] = hh; }
                    Aq[q] = pa; Bq[q] = hh; }
                float Ao[4], Bo[4];
#pragma unroll
                for (int q = 0; q < 4; ++q) { Ao[q] = __shfl_xor(Aq[q], 32); Bo[q] = __shfl_xor(Bq[q], 32); }
                float ci[4]; float Hc = H[nt], Pc = P[nt]; const bool up = (hi != 0);
#pragma unroll
                for (int q = 0; q < 4; ++q) { const float a0 = up ? Ao[q] : Aq[q], b0 = up ? Bo[q] : Bq[q], a1 = up ? Aq[q] : Ao[q], b1 = up ? Bq[q] : Bo[q];
                    const float mid = a0 * Hc + b0; ci[q] = up ? mid : Hc; Hc = a1 * mid + b1; Pc *= a0 * a1; }
                H[nt] = Hc; P[nt] = Pc;
                if (PASS2) {
#pragma unroll
                    for (int q = 0; q < 4; ++q) {
#pragma unroll
                        for (int j = 0; j < 4; ++j) { const int r = 4 * q + j; const float hv = Ap[r] * ci[q] + hl[r];
                            LAS unsigned short* zp = (LAS unsigned short*)(lz + crow16(r, hi) * 144 + (32 * nt + r32) * 2);
                            const float zs = __builtin_bit_cast(float, (unsigned)(*zp) << 16);
                            *zp = (unsigned short)pk2(hv * zs, 0.f); } }
                }
            }
            if (PASS2) {
#pragma unroll
                for (int i = 0; i < 4; ++i) { const int row = i * 8 + (lane >> 3), ch = lane & 7;
                    *(GAS v4u*)(ZR + (size_t)(b * SEQ + t0 + row) * D + c0 + ch * 8) = *(const LAS v4u*)(lz + row * 144 + ch * 16); }
            }
        }
#undef SC_LOAD
        if (!PASS2) { if (hi == 0) {
#pragma unroll
            for (int nt = 0; nt < 2; ++nt) *(float2*)(carry + ((size_t)(b * 16 + sc) * D + c0 + 32 * nt + r32) * 2) = make_float2(P[nt], H[nt]); } }
    }
    __syncthreads();
}

__device__ __forceinline__ void combine_phase(Frame& F) {
    const int gw = F.vcu * NWAVES + F.wave, NGW = F.G * NWAVES, lane = lane_id_(), hd = lane >> 3, p = lane & 7;
    const float l1 = wave_sum(F.in[I_LQ1][lane] * F.in[I_LK1][lane]), l2 = wave_sum(F.in[I_LQ2][lane] * F.in[I_LK2][lane]);
    const float lam = expf(l1) - expf(l2) + LAM_INIT;
    float gsc[16];
#pragma unroll
    for (int i = 0; i < 16; ++i) gsc[i] = F.in[I_SUBG][p * 16 + i] * (1.0f - LAM_INIT);
    const bf16* OB = (const bf16*)F.out; bf16* ZA = (bf16*)(F.ws + WS_ZA);
    for (int m = gw; m < M; m += NGW) {
        const bf16* ob = OB + (size_t)m * 2048 + hd * 256 + p * 16;
        const v4u a0 = *(const GAS v4u*)ob, a1 = *(const GAS v4u*)(ob + 8), b0 = *(const GAS v4u*)(ob + 128), b1 = *(const GAS v4u*)(ob + 136);
        bf16* zp = ZA + (size_t)m * D + hd * 128 + p * 16;
        const v4u z0 = *(const GAS v4u*)zp, z1 = *(const GAS v4u*)(zp + 8);
        float o[16]; const unsigned aw[8] = {a0.x, a0.y, a0.z, a0.w, a1.x, a1.y, a1.z, a1.w}, bw[8] = {b0.x, b0.y, b0.z, b0.w, b1.x, b1.y, b1.z, b1.w}, zw[8] = {z0.x, z0.y, z0.z, z0.w, z1.x, z1.y, z1.z, z1.w};
        float ss = 0.f;
#pragma unroll
        for (int i = 0; i < 8; ++i) { o[2 * i] = bflo(aw[i]) - lam * bflo(bw[i]); o[2 * i + 1] = bfhi(aw[i]) - lam * bfhi(bw[i]); ss += o[2 * i] * o[2 * i] + o[2 * i + 1] * o[2 * i + 1]; }
        ss += __shfl_xor(ss, 1); ss += __shfl_xor(ss, 2); ss += __shfl_xor(ss, 4);
        const float rstd = 1.0f / sqrtf(ss * (1.f / 128.f) + NORM_EPS);
        unsigned yw[8];
#pragma unroll
        for (int i = 0; i < 8; ++i) yw[i] = pk2(o[2 * i] * rstd * gsc[2 * i] * bflo(zw[i]), o[2 * i + 1] * rstd * gsc[2 * i + 1] * bfhi(zw[i]));
        *(GAS v4u*)zp = (v4u){yw[0], yw[1], yw[2], yw[3]}; *(GAS v4u*)(zp + 8) = (v4u){yw[4], yw[5], yw[6], yw[7]};
    }
}

__device__ __forceinline__ void final_phase(Frame& F) {
    const int gw = F.vcu * NWAVES + F.wave, NGW = F.G * NWAVES, lane = lane_id_();
    const float* stats = (const float*)(F.ws + WS_STATS);
    f32x4 gg[4];
#pragma unroll
    for (int j = 0; j < 4; ++j) gg[j] = ((const GAS f32x4*)F.in[I_POSTG])[lane + 64 * j];
    for (int m = gw; m < M; m += NGW) {
        float s = stats[(size_t)m * 16 + (lane & 15)];
        s += __shfl_xor(s, 1); s += __shfl_xor(s, 2); s += __shfl_xor(s, 4); s += __shfl_xor(s, 8);
        const float rstd = 1.0f / sqrtf(s * (1.f / D) + NORM_EPS);
        GAS f32x4* yp = (GAS f32x4*)(F.out + (size_t)m * D) + lane; const GAS f32x4* xp = (const GAS f32x4*)(F.in[I_X] + (size_t)m * D) + lane;
#pragma unroll
        for (int j = 0; j < 4; ++j) { const f32x4 y = yp[64 * j], x = xp[64 * j]; yp[64 * j] = x + y * rstd * gg[j]; }
    }
}

struct Args { const float* in[19]; float* out; unsigned char* ws; int ph_lo, ph_hi; };
__global__ void __launch_bounds__(NWAVES * 64, 2) fwd_kernel(Args args) {
    extern __shared__ __attribute__((aligned(16))) unsigned char lds[];
    Frame F;
    F.lds = (LAS unsigned char*)lds;
    F.wave = __builtin_amdgcn_readfirstlane((int)threadIdx.x >> 6);
    F.G = gridDim.x; { const int bx = blockIdx.x; F.vcu = (F.G % 8 == 0) ? (bx % 8) * (F.G / 8) + bx / 8 : bx; }
#pragma unroll
    for (int i = 0; i < 19; ++i) F.in[i] = args.in[i];
    F.out = args.out; F.ws = args.ws;
    unsigned char* ws = args.ws;
    const int lo = args.ph_lo, hi = args.ph_hi;
#define IN(k) (lo <= (k) && (k) < hi)
    const bool lane0w0 = (F.wave == 0) && (lane_id_() == 0);
    if (lane0w0) { ((volatile LAS unsigned*)(F.lds + MISC_OFF))[0] = 0u; ((volatile LAS unsigned*)(F.lds + MISC_OFF))[1] = 0u; }
    __syncthreads();
    XcdBarrier bar = xcd_barrier_post((unsigned*)(ws + WS_CTL) + 1024, (volatile LAS unsigned*)(F.lds + MISC_OFF), lane0w0);
#define SEAM(k) do { if (IN(k) && IN((k) + 1)) { xcd_barrier(bar, (F.wave == 0) && (lane_id_() == 0)); } } while (0)

    if (IN(0)) { p0_prologue(F); }
    SEAM(0);
    if (IN(1)) {
        pg8::Gemm g{(const pg8::bf16_t*)(ws + WS_U), (const pg8::bf16_t*)(ws + WS_WIN), M, 6144, D}; pg8::StaticOrder S; S.init(M, 6144, F.G, (int)blockIdx.x);
        pg8::EpiSplit E{(pg8::bf16_t*)(ws + WS_XR), SLOT / 2, 0x100310u, attn_body::C2};
        pg8::gemm_phase<pg8::EpiSplit, pg8::StaticOrder, PG8_ALIGN, PG8_SP2>(F.lds, g, S, E, F.wave);
    }
    SEAM(1);
    if (IN(2)) {
        scan_phase<false>(F);
        const attn_body::AttnTensors AT{(const attn_body::bf16*)(ws + WS_Q), (const attn_body::bf16*)(ws + WS_K), (const attn_body::bf16*)(ws + WS_V), (attn_body::bf16*)F.out};
        const attn_body::StaticOrder AS(F.vcu, F.G); attn_body::attn_phase<attn_body::StaticOrder>((char*)lds, AT, AS, F.wave);
    }
    SEAM(2);
    if (IN(3)) {
        { pg8::Gemm g{(const pg8::bf16_t*)(ws + WS_U), (const pg8::bf16_t*)(ws + WS_WIN) + (size_t)6144 * D, M, 2048, D}; pg8::StaticOrder S; S.init(M, 2048, F.G, (int)blockIdx.x);
          pg8::EpiSplit E{(pg8::bf16_t*)(ws + WS_Q), SLOT / 2, 0x22u, 1.0f};
          pg8::gemm_phase<pg8::EpiSplit, pg8::StaticOrder, PG8_ALIGN, PG8_SP2>(F.lds, g, S, E, F.wave); }
        scan_phase<true>(F);
        combine_phase(F);
    }
    SEAM(3);
    if (IN(4)) {
        { pg8::Gemm g{(const pg8::bf16_t*)(ws + WS_ZR), (const pg8::bf16_t*)(ws + WS_WR), M, D, D}; pg8::StaticOrder S; S.init(M, D, F.G, (int)blockIdx.x);
          pg8::EpiGate<false> E{(const pg8::bf16_t*)(ws + WS_Q), (pg8::bf16_t*)(ws + WS_V)};
          pg8::gemm_phase<pg8::EpiGate<false>, pg8::StaticOrder, PG8_ALIGN, PG8_SP2>(F.lds, g, S, E, F.wave); }
        { pg8::Gemm g{(const pg8::bf16_t*)(ws + WS_ZA), (const pg8::bf16_t*)(ws + WS_WA), M, D, D}; pg8::StaticOrder S; S.init(M, D, F.G, (int)blockIdx.x);
          pg8::EpiGate<true> E{(const pg8::bf16_t*)(ws + WS_K), (pg8::bf16_t*)(ws + WS_V)};
          pg8::gemm_phase<pg8::EpiGate<true>, pg8::StaticOrder, PG8_ALIGN, PG8_SP2>(F.lds, g, S, E, F.wave); }
    }
    SEAM(4);
    if (IN(5)) {
        pg8::Gemm g{(const pg8::bf16_t*)(ws + WS_V), (const pg8::bf16_t*)(ws + WS_WO), M, D, D}; pg8::StaticOrder S; S.init(M, D, F.G, (int)blockIdx.x);
        pg8::EpiF32Stats E{F.out, (float*)(ws + WS_STATS)};
        pg8::gemm_phase<pg8::EpiF32Stats, pg8::StaticOrder, PG8_ALIGN, PG8_SP2>(F.lds, g, S, E, F.wave);
    }
    SEAM(5);
    if (IN(6)) { final_phase(F); }
#undef IN
#undef SEAM
}

extern "C" void kernel_launch(void* const* d_in, const int* in_sizes, int n_in, void* d_out, int out_size, void* d_ws, size_t ws_size, hipStream_t stream) {
    static int grid = 0;
    if (grid == 0) {
        if (n_in != 19 || in_sizes[0] != M * D || out_size != M * D || ws_size < WS_END) { fprintf(stderr, "kernel_launch: unexpected shapes (n_in %d, in0 %d, out %d, ws %zu)\n", n_in, n_in > 0 ? in_sizes[0] : -1, out_size, ws_size); grid = -1; return; }
        int dev = 0, cus = 0, per_cu = 0;
        if (hipGetDevice(&dev) != hipSuccess || hipDeviceGetAttribute(&cus, hipDeviceAttributeMultiprocessorCount, dev) != hipSuccess) { grid = -1; return; }
        if (hipFuncSetAttribute((const void*)fwd_kernel, hipFuncAttributeMaxDynamicSharedMemorySize, LDS_BYTES) != hipSuccess) { fprintf(stderr, "kernel_launch: hipFuncSetAttribute failed\n"); grid = -1; return; }
        if (hipOccupancyMaxActiveBlocksPerMultiprocessor(&per_cu, (const void*)fwd_kernel, NWAVES * 64, LDS_BYTES) != hipSuccess || per_cu < 1) { fprintf(stderr, "kernel_launch: occupancy query says %d\n", per_cu); (void)hipGetLastError(); grid = -1; return; }
        grid = cus;
    }
    if (grid < 0) return;
    if (hipMemsetAsync((char*)d_ws + WS_CTL, 0, CTL_ZERO_BYTES, stream) != hipSuccess) { fprintf(stderr, "kernel_launch: hipMemsetAsync failed\n"); return; }
    Args a{};
    for (int i = 0; i < 19; ++i) a.in[i] = (const float*)d_in[i];
    a.out = (float*)d_out; a.ws = (unsigned char*)d_ws; a.ph_lo = 0; a.ph_hi = 7;
    void* kargs[] = {&a};
    const hipError_t e = hipLaunchCooperativeKernel((const void*)fwd_kernel, dim3(grid), dim3(NWAVES * 64), kargs, LDS_BYTES, stream);
    if (e != hipSuccess) fprintf(stderr, "kernel_launch: launch failed: %s (grid %d)\n", hipGetErrorString(e), grid);
}
```

```cpp
#include <hip/hip_runtime.h>

#include <cstdio>
#include <cstdint>
__device__ __forceinline__ int lane_id_() { return (int)__builtin_amdgcn_mbcnt_hi(~0u, __builtin_amdgcn_mbcnt_lo(~0u, 0u)); }
namespace pg8 {
#define PG8_LAS __attribute__((address_space(3)))
typedef unsigned short bf16_t;
typedef short bf16x8 __attribute__((ext_vector_type(8)));
typedef float f32x4 __attribute__((ext_vector_type(4)));
typedef unsigned u32x4 __attribute__((ext_vector_type(4)));
constexpr int BM = 256, BK = 64, HALF = 128, HTB = HALF * BK * 2  , STAGE_BYTES = 8 * HTB, NXCD = 8, WGM = 8;

__host__ __device__ __forceinline__ int lds_byte(int r, int c) { const int st = (r >> 4) * 2 + (c >> 5), rr = r & 15, cc = c & 31, ob = rr * 64 + cc * 2; return st * 1024 + (ob ^ (((ob >> 9) & 1) << 5)); }
__host__ __device__ __forceinline__ void stage_rc(int b, int& R, int& C) { const int st = b / 1024, sb = b % 1024, swz = sb ^ (((sb >> 9) & 1) << 5); R = (st >> 1) * 16 + swz / 64; C = (st & 1) * 32 + (swz % 64) / 2; }
__host__ __device__ __forceinline__ int perm32(int rho) { const int n = rho >> 4, i = rho & 15; return 8 * (i >> 2) + 4 * n + (i & 3); }

struct Unit { int pm, pn; };
struct Gemm { const bf16_t* A; const bf16_t* Bt; int M, N, K; const bf16_t* A2; int lda, ksp; };

struct StaticOrder {
    int nM, nN, nwg, G, c;
    __host__ __device__ void init(int M, int N, int G_, int c_) { nM = M / BM; nN = N / BM; nwg = nM * nN; G = G_; c = c_; }
    __host__ __device__ bool next(int i, Unit& u) const {
        const long L = (long)i * G + c; if (L >= nwg) return false;
        int wgid = (int)L; { const int q = nwg / NXCD, r = nwg % NXCD, xcd = wgid % NXCD, off = wgid / NXCD; wgid = (xcd < r ? xcd * (q + 1) : r * (q + 1) + (xcd - r) * q) + off; }
        const int nig = WGM * nN, gid = wgid / nig, fm = gid * WGM, gsz = (nM - fm) < WGM ? (nM - fm) : WGM;
        u.pm = fm + ((wgid % nig) % gsz); u.pn = (wgid % nig) / gsz; return true;
    }
    __device__ __forceinline__ void a_ready(const Unit&) const {}
    __device__ __forceinline__ void done(const Unit&) const {}
};

__device__ __forceinline__ unsigned cvt_pk_bf16(float lo, float hi) { unsigned r; asm volatile("v_cvt_pk_bf16_f32 %0, %1, %2" : "=v"(r) : "v"(lo), "v"(hi)); return r; }
typedef float f32x2 __attribute__((ext_vector_type(2)));
__device__ __forceinline__ float bf_lo(unsigned w) { return __builtin_bit_cast(float, w << 16); }
__device__ __forceinline__ float bf_hi(unsigned w) { return __builtin_bit_cast(float, w & 0xffff0000u); }
__device__ __forceinline__ float sigmoid_f(float v) { return __builtin_amdgcn_rcpf(1.0f + __builtin_amdgcn_exp2f(-1.4426950408889634f * v)); }
struct EpiSplit {
    static constexpr bool PERM = true, AFTER_DRAIN = false, MID = false;
    bf16_t* O; size_t split_stride; unsigned acts; float scl;
    __device__ __forceinline__ void operator()(const f32x4 (&acc)[2][2][4][2], const Unit& u, int wr, int wc, int fr, int fq) const {
        const int row0 = u.pm * BM + wr * 64 + fr; int colt = u.pn * BM; const int t = colt >> 10; bf16_t* base = O + (size_t)t * split_stride; colt -= t << 10;
        const int act = (int)((acts >> (4 * t)) & 15u);
        const int col0 = colt + wc * 32 + 8 * fq;
#pragma unroll
        for (int ai = 0; ai < 2; ++ai)
#pragma unroll
            for (int m = 0; m < 4; ++m) { bf16_t* rowp = base + (size_t)(row0 + ai * HALF + m * 16) * 1024 + col0;
#pragma unroll
                for (int bj = 0; bj < 2; ++bj) { f32x4 v0 = acc[ai][bj][m][0], v1 = acc[ai][bj][m][1];
                    if (act == 1) {
#pragma unroll
                        for (int e = 0; e < 4; ++e) { v0[e] = v0[e] * sigmoid_f(v0[e]); v1[e] = v1[e] * sigmoid_f(v1[e]); }
                    } else if (act == 2) {
#pragma unroll
                        for (int e = 0; e < 4; ++e) { v0[e] = sigmoid_f(v0[e]); v1[e] = sigmoid_f(v1[e]); }
                    } else if (act == 3) { v0 = v0 * scl; v1 = v1 * scl; }
                    u32x4 w; w.x = cvt_pk_bf16(v0[0], v0[1]); w.y = cvt_pk_bf16(v0[2], v0[3]); w.z = cvt_pk_bf16(v1[0], v1[1]); w.w = cvt_pk_bf16(v1[2], v1[3]);
                    *(u32x4*)(rowp + bj * HALF) = w; } }
    }
};
template <bool ACCUM> struct EpiGate {
    static constexpr bool PERM = true, AFTER_DRAIN = false, MID = false;
    const bf16_t* G; bf16_t* Mb;
    __device__ __forceinline__ void operator()(const f32x4 (&acc)[2][2][4][2], const Unit& u, int wr, int wc, int fr, int fq) const {
        const int row0 = u.pm * BM + wr * 64 + fr, col0 = u.pn * BM + wc * 32 + 8 * fq;
#pragma unroll
        for (int ai = 0; ai < 2; ++ai)
#pragma unroll
            for (int m = 0; m < 4; ++m) { const size_t off = (size_t)(row0 + ai * HALF + m * 16) * 1024 + col0;
#pragma unroll
                for (int bj = 0; bj < 2; ++bj) { const f32x4 a0 = acc[ai][bj][m][0], a1 = acc[ai][bj][m][1];
                    const u32x4 g = *(const u32x4*)(G + off + bj * HALF);
                    f32x4 v0, v1;
                    v0[0] = bf_lo(g.x) * a0[0]; v0[1] = bf_hi(g.x) * a0[1]; v0[2] = bf_lo(g.y) * a0[2]; v0[3] = bf_hi(g.y) * a0[3];
                    v1[0] = bf_lo(g.z) * a1[0]; v1[1] = bf_hi(g.z) * a1[1]; v1[2] = bf_lo(g.w) * a1[2]; v1[3] = bf_hi(g.w) * a1[3];
                    if (ACCUM) { const u32x4 o = *(const u32x4*)(Mb + off + bj * HALF);
                        v0[0] += bf_lo(o.x); v0[1] += bf_hi(o.x); v0[2] += bf_lo(o.y); v0[3] += bf_hi(o.y);
                        v1[0] += bf_lo(o.z); v1[1] += bf_hi(o.z); v1[2] += bf_lo(o.w); v1[3] += bf_hi(o.w); }
                    u32x4 w; w.x = cvt_pk_bf16(v0[0], v0[1]); w.y = cvt_pk_bf16(v0[2], v0[3]); w.z = cvt_pk_bf16(v1[0], v1[1]); w.w = cvt_pk_bf16(v1[2], v1[3]);
                    *(u32x4*)(Mb + off + bj * HALF) = w; } }
    }
};
struct EpiF32Stats {
    static constexpr bool PERM = false, AFTER_DRAIN = false, MID = false;
    float* Y; float* stats;
    __device__ __forceinline__ void operator()(const f32x4 (&acc)[2][2][4][2], const Unit& u, int wr, int wc, int fr, int fq) const {
        const int col0 = u.pn * BM + wc * 32 + 4 * fq;
#pragma unroll
        for (int ai = 0; ai < 2; ++ai)
#pragma unroll
            for (int m = 0; m < 4; ++m) { const int r = u.pm * BM + ai * HALF + wr * 64 + m * 16 + fr; const size_t off = (size_t)r * 1024 + col0; float s = 0.f;
#pragma unroll
                for (int bj = 0; bj < 2; ++bj)
#pragma unroll
                    for (int n = 0; n < 2; ++n) { const f32x4 x = acc[ai][bj][m][n]; *(f32x4*)(Y + off + bj * HALF + n * 16) = x; s += (x[0] * x[0] + x[1] * x[1]) + (x[2] * x[2] + x[3] * x[3]); }
                s += __shfl_xor(s, 16); s += __shfl_xor(s, 32);
                if (fq == 0) stats[(size_t)r * 16 + u.pn * 4 + wc] = s; }
    }
};
struct EpiGateMerge {
    static constexpr bool PERM = true, AFTER_DRAIN = false, MID = true;
    const bf16_t* GR; const bf16_t* GA; bf16_t* Mb;
    __device__ __forceinline__ void mid(f32x4 (&acc)[2][2][4][2], const Unit& u, int wr, int wc, int fr, int fq) const {
        unsigned o0 = (unsigned)((u.pm * BM + wr * 64 + fr) * 1024 + u.pn * BM + wc * 32 + 8 * fq); asm volatile("" : "+v"(o0));
#pragma unroll
        for (int ai = 0; ai < 2; ++ai)
#pragma unroll
            for (int m = 0; m < 4; ++m) { const size_t off = (size_t)(o0 + (unsigned)((ai * HALF + m * 16) * 1024));
#pragma unroll
                for (int bj = 0; bj < 2; ++bj) { const u32x4 r = *(const u32x4*)(GR + off + bj * HALF), a = *(const u32x4*)(GA + off + bj * HALF);
                    f32x4& a0 = acc[ai][bj][m][0]; f32x4& a1 = acc[ai][bj][m][1];
                    a0[0] *= bf_lo(r.x) * __builtin_amdgcn_rcpf(bf_lo(a.x)); a0[1] *= bf_hi(r.x) * __builtin_amdgcn_rcpf(bf_hi(a.x)); a0[2] *= bf_lo(r.y) * __builtin_amdgcn_rcpf(bf_lo(a.y)); a0[3] *= bf_hi(r.y) * __builtin_amdgcn_rcpf(bf_hi(a.y));
                    a1[0] *= bf_lo(r.z) * __builtin_amdgcn_rcpf(bf_lo(a.z)); a1[1] *= bf_hi(r.z) * __builtin_amdgcn_rcpf(bf_hi(a.z)); a1[2] *= bf_lo(r.w) * __builtin_amdgcn_rcpf(bf_lo(a.w)); a1[3] *= bf_hi(r.w) * __builtin_amdgcn_rcpf(bf_hi(a.w)); } }
    }
    __device__ __forceinline__ void operator()(const f32x4 (&acc)[2][2][4][2], const Unit& u, int wr, int wc, int fr, int fq) const {
        unsigned o0 = (unsigned)((u.pm * BM + wr * 64 + fr) * 1024 + u.pn * BM + wc * 32 + 8 * fq); asm volatile("" : "+v"(o0));
#pragma unroll
        for (int ai = 0; ai < 2; ++ai)
#pragma unroll
            for (int m = 0; m < 4; ++m) { const size_t off = (size_t)(o0 + (unsigned)((ai * HALF + m * 16) * 1024));
#pragma unroll
                for (int bj = 0; bj < 2; ++bj) { const f32x4 a0 = acc[ai][bj][m][0], a1 = acc[ai][bj][m][1];
                    const u32x4 g = *(const u32x4*)(GA + off + bj * HALF);
                    u32x4 w; w.x = cvt_pk_bf16(bf_lo(g.x) * a0[0], bf_hi(g.x) * a0[1]); w.y = cvt_pk_bf16(bf_lo(g.y) * a0[2], bf_hi(g.y) * a0[3]);
                    w.z = cvt_pk_bf16(bf_lo(g.z) * a1[0], bf_hi(g.z) * a1[1]); w.w = cvt_pk_bf16(bf_lo(g.w) * a1[2], bf_hi(g.w) * a1[3]);
                    *(u32x4*)(Mb + off + bj * HALF) = w; } }
    }
};
template <class Epi, class Sched, bool ALIGN_EPI = false, bool SP2 = false>
__device__ __forceinline__ void gemm_phase(PG8_LAS unsigned char* lds, const Gemm g, const Sched& S, const Epi& E, const int wave_) {
    const int lane = lane_id_(), wid = wave_, tid = wid * 64 + lane, wr = wid >> 2, wc = wid & 3, fr = lane & 15, fq = lane >> 4;
    const int K = g.K, nt = K / BK, lda = g.lda ? g.lda : K, ksp = g.ksp ? g.ksp : nt;
    const bf16_t* const A2b = g.A2 ? g.A2 : g.A;
    unsigned voffA[2], voffB[2];
#pragma unroll
    for (int i = 0; i < 2; ++i) { int R, C; stage_rc(tid * 16 + i * 8192, R, C); const int Rb = Epi::PERM ? ((R & ~31) + perm32(R & 31)) : R;
        voffA[i] = (unsigned)(R * lda + C) * 2u; voffB[i] = (unsigned)(Rb * K + C) * 2u; }
    const size_t kstep = (size_t)(BK * 2);
    const size_t hstep = (size_t)HALF * K * 2;
    const size_t tstep = 2 * hstep;
    const size_t hstepA = (size_t)HALF * lda * 2, tstepA = 2 * hstepA;
#define PG8_AK(c1, c2, tt) (((tt) < ksp ? (c1) : (c2)) + (size_t)(tt) * kstep)
    const unsigned ldsw = (unsigned)wid * 1024u;
    const int aoff = lds_byte(wr * 64 + fr, fq * 8), boff = lds_byte(wc * 32 + fr, fq * 8);
#define PG8_SA(b, h) (((b) * 2 + (h)) * HTB)
#define PG8_SB(b, h) ((4 + (b) * 2 + (h)) * HTB)
#define PG8_STAGE(bufoff, gbase, voff) do { _Pragma("unroll") for (int _i = 0; _i < 2; ++_i) \
        __builtin_amdgcn_global_load_lds((const unsigned*)((const char*)(gbase) + (voff)[_i]), (PG8_LAS unsigned*)(lds + (bufoff) + ldsw + _i * 8192), 16, 0, 0); } while (0)
#define PG8_LDA(dst, b, h) do { _Pragma("unroll") for (int m = 0; m < 4; ++m) _Pragma("unroll") for (int k = 0; k < 2; ++k) dst[m][k] = *(const PG8_LAS bf16x8*)(lds + PG8_SA(b, h) + aoff + m * 2048 + k * 1024); } while (0)
#define PG8_LDB(dst, b, h) do { _Pragma("unroll") for (int n = 0; n < 2; ++n) _Pragma("unroll") for (int k = 0; k < 2; ++k) dst[n][k] = *(const PG8_LAS bf16x8*)(lds + PG8_SB(b, h) + boff + n * 2048 + k * 1024); } while (0)
#define PG8_MMA(ai, bj, At, Bt) do { __builtin_amdgcn_s_setprio(1); _Pragma("unroll") for (int m = 0; m < 4; ++m) _Pragma("unroll") for (int n = 0; n < 2; ++n) _Pragma("unroll") for (int k = 0; k < 2; ++k) \
        acc[ai][bj][m][n] = __builtin_amdgcn_mfma_f32_16x16x32_bf16(Bt[n][k], At[m][k], acc[ai][bj][m][n], 0, 0, 0); __builtin_amdgcn_s_setprio(0); } while (0)
#define PG8_WAIT_V(n) asm volatile("s_waitcnt vmcnt(" #n ")" ::: "memory")
#define PG8_WAIT_L(n) asm volatile("s_waitcnt lgkmcnt(" #n ")" ::: "memory")
#define PG8_BAR __builtin_amdgcn_s_barrier()
#define PG8_SCHED __builtin_amdgcn_sched_barrier(0)
    Unit cur, nxt; int ui = 0;
    if (!S.next(0, cur)) return;
    f32x4 acc[2][2][4][2];
#pragma unroll
    for (int a = 0; a < 2; ++a)
#pragma unroll
        for (int b = 0; b < 2; ++b)
#pragma unroll
            for (int m = 0; m < 4; ++m)
#pragma unroll
                for (int n = 0; n < 2; ++n) acc[a][b][m][n] = (f32x4){0.f, 0.f, 0.f, 0.f};
    bf16x8 At[4][2], B0[2][2], B1[2][2];
    const char* cA = (const char*)g.A + (size_t)cur.pm * tstepA; const char* cA2 = (const char*)A2b + (size_t)cur.pm * tstepA - (size_t)ksp * kstep; const char* cB = (const char*)g.Bt + (size_t)cur.pn * tstep;
    S.a_ready(cur);
    if constexpr (SP2) {
        PG8_STAGE(PG8_SB(0, 0), cB, voffB); PG8_STAGE(PG8_SB(0, 1), cB + hstep, voffB); PG8_STAGE(PG8_SA(0, 0), cA, voffA); PG8_STAGE(PG8_SA(0, 1), cA + hstepA, voffA);
        if (wr == 1) PG8_BAR;
        PG8_WAIT_V(2); PG8_BAR;
        PG8_STAGE(PG8_SB(1, 0), cB + kstep, voffB); PG8_STAGE(PG8_SA(1, 0), cA + kstep, voffA); PG8_STAGE(PG8_SB(1, 1), cB + hstep + kstep, voffB);
        PG8_WAIT_V(6); PG8_BAR;
    } else {
        PG8_STAGE(PG8_SB(0, 0), cB, voffB); PG8_STAGE(PG8_SA(0, 0), cA, voffA); PG8_STAGE(PG8_SB(0, 1), cB + hstep, voffB); PG8_STAGE(PG8_SA(0, 1), cA + hstepA, voffA);
        if (wr == 1) PG8_BAR;
        PG8_WAIT_V(4); PG8_BAR;
        PG8_STAGE(PG8_SB(1, 0), cB + kstep, voffB); PG8_STAGE(PG8_SA(1, 0), cA + kstep, voffA); PG8_STAGE(PG8_SB(1, 1), cB + hstep + kstep, voffB);
        PG8_WAIT_V(6); PG8_BAR;
    }
    for (;;) {
        const bool has_next = S.next(ui + 1, nxt);
        const char* nA = has_next ? (const char*)g.A + (size_t)nxt.pm * tstepA : cA; const char* nA2 = has_next ? (const char*)A2b + (size_t)nxt.pm * tstepA - (size_t)ksp * kstep : cA2; const char* nB = has_next ? (const char*)g.Bt + (size_t)nxt.pn * tstep : cB;
        for (int t = 0; t < nt; t += 2) {
            const bool last = (t == nt - 2);
            const char* a1 = PG8_AK(cA, cA2, t + 1);
            const char* a2 = last ? nA : PG8_AK(cA, cA2, t + 2); const char* b2 = last ? nB : cB + (size_t)(t + 2) * kstep;
            const char* a3 = last ? nA + kstep : PG8_AK(cA, cA2, t + 3); const char* b3 = b2 + kstep;
            if (last && has_next) S.a_ready(nxt);
            if constexpr (Epi::MID) { if (t == ksp) E.mid(acc, cur, wr, wc, fr, fq); }
            if constexpr (SP2) {
            PG8_LDB(B0, 0, 0); PG8_LDB(B1, 0, 1); PG8_SCHED; PG8_LDA(At, 0, 0); PG8_STAGE(PG8_SA(1, 1), a1 + hstepA, voffA);
            PG8_WAIT_V(8); PG8_WAIT_L(0); PG8_BAR; PG8_MMA(0, 0, At, B0); PG8_MMA(0, 1, At, B1); PG8_BAR; PG8_SCHED;
            PG8_LDA(At, 0, 1); PG8_STAGE(PG8_SB(0, 0), b2, voffB); PG8_STAGE(PG8_SB(0, 1), b2 + hstep, voffB); PG8_STAGE(PG8_SA(0, 0), a2, voffA);
            PG8_WAIT_V(8); PG8_WAIT_L(0); PG8_BAR; PG8_MMA(1, 0, At, B0); PG8_MMA(1, 1, At, B1); PG8_BAR; PG8_SCHED;
            PG8_LDB(B0, 1, 0); PG8_LDB(B1, 1, 1); PG8_SCHED; PG8_LDA(At, 1, 0); PG8_STAGE(PG8_SA(0, 1), a2 + hstepA, voffA);
            PG8_WAIT_V(8); PG8_WAIT_L(0); PG8_BAR; PG8_MMA(0, 0, At, B0); PG8_MMA(0, 1, At, B1); PG8_BAR; PG8_SCHED;
            PG8_LDA(At, 1, 1); PG8_STAGE(PG8_SB(1, 0), b3, voffB); PG8_STAGE(PG8_SB(1, 1), b3 + hstep, voffB); PG8_STAGE(PG8_SA(1, 0), a3, voffA);
            PG8_WAIT_V(8); PG8_WAIT_L(0); PG8_BAR; PG8_MMA(1, 0, At, B0); PG8_MMA(1, 1, At, B1); PG8_BAR; PG8_SCHED;
            } else {
            PG8_LDB(B0, 0, 0); PG8_SCHED; PG8_LDA(At, 0, 0); PG8_STAGE(PG8_SA(1, 1), a1 + hstepA, voffA);
            PG8_WAIT_L(8); PG8_BAR; PG8_WAIT_L(0); PG8_MMA(0, 0, At, B0); PG8_BAR; PG8_SCHED;
            PG8_LDB(B1, 0, 1); PG8_STAGE(PG8_SB(0, 0), b2, voffB);
            PG8_BAR; PG8_WAIT_L(0); PG8_MMA(0, 1, At, B1); PG8_BAR;
            PG8_LDA(At, 0, 1); PG8_STAGE(PG8_SA(0, 0), a2, voffA);
            PG8_BAR; PG8_WAIT_L(0); PG8_MMA(1, 0, At, B0); PG8_BAR; PG8_SCHED;
            PG8_STAGE(PG8_SB(0, 1), b2 + hstep, voffB);
            PG8_WAIT_V(6); PG8_BAR; PG8_MMA(1, 1, At, B1); PG8_BAR;
            PG8_LDB(B0, 1, 0); PG8_SCHED; PG8_LDA(At, 1, 0); PG8_STAGE(PG8_SA(0, 1), a2 + hstepA, voffA);
            PG8_WAIT_L(8); PG8_BAR; PG8_WAIT_L(0); PG8_MMA(0, 0, At, B0); PG8_BAR; PG8_SCHED;
            PG8_LDB(B1, 1, 1); PG8_STAGE(PG8_SB(1, 0), b3, voffB);
            PG8_BAR; PG8_WAIT_L(0); PG8_MMA(0, 1, At, B1); PG8_BAR;
            PG8_LDA(At, 1, 1); PG8_STAGE(PG8_SA(1, 0), a3, voffA);
            PG8_BAR; PG8_WAIT_L(0); PG8_MMA(1, 0, At, B0); PG8_BAR; PG8_SCHED;
            PG8_STAGE(PG8_SB(1, 1), b3 + hstep, voffB);
            PG8_WAIT_V(6); PG8_BAR; PG8_MMA(1, 1, At, B1); PG8_BAR;
            }
        }
        if constexpr (ALIGN_EPI) { if (wr == 0) PG8_BAR; }
        if constexpr (!Epi::AFTER_DRAIN) { E(acc, cur, wr, wc, fr, fq); S.done(cur); }
        if (!has_next) break;
#pragma unroll
        for (int a = 0; a < 2; ++a)
#pragma unroll
            for (int b = 0; b < 2; ++b)
#pragma unroll
                for (int m = 0; m < 4; ++m)
#pragma unroll
                    for (int n = 0; n < 2; ++n) acc[a][b][m][n] = (f32x4){0.f, 0.f, 0.f, 0.f};
        cur = nxt; cA = nA; cA2 = nA2; cB = nB; ++ui;
        if constexpr (ALIGN_EPI) { if (wr == 1) PG8_BAR; }
    }
    PG8_WAIT_V(0);
    if constexpr (!ALIGN_EPI) { if (wr == 0) PG8_BAR; }
    PG8_BAR;
    if constexpr (Epi::AFTER_DRAIN) { E.fused(acc, cur, wr, wc, fr, fq, lds, wid, lane); S.done(cur); }
#undef PG8_SA
#undef PG8_AK
#undef PG8_SB
#undef PG8_STAGE
#undef PG8_LDA
#undef PG8_LDB
#undef PG8_MMA
#undef PG8_WAIT_V
#undef PG8_WAIT_L
#undef PG8_BAR
#undef PG8_SCHED
}
}

#ifndef PG8_SP2
#define PG8_SP2 true
#endif
#ifndef PG8_ALIGN
#define PG8_ALIGN true
#endif
#include <hip/hip_bf16.h>
#include <cmath>
#include <hip/hip_bf16.h>
#include <cmath>
namespace attn_body {
using bf16=__hip_bfloat16;
using bf16x8=__attribute__((ext_vector_type(8)))short;
using s16x4=__attribute__((ext_vector_type(4)))short;
using f32x16=__attribute__((ext_vector_type(16)))float;
using u32x4=__attribute__((ext_vector_type(4)))unsigned;
constexpr int BATCH=8,NHEAD=16,SEQ=4096,D=64,DM=NHEAD*D,OPITCH=2048,VW=128;
constexpr int NW=8,QBLK=32,QB=QBLK*NW,KVBLK=64,NQB=SEQ/QB;
__device__ __forceinline__ int crow(int r,int hi){return (r&3)+8*(r>>2)+4*hi;}
#define SBAR() __builtin_amdgcn_sched_barrier(0)
__device__ __forceinline__ void cmask(f32x16&p0,f32x16&p1,int jb,int qrel,int hi){
  const float NEG=-INFINITY; int kb=64*jb+4*hi;
  #pragma unroll
  for(int r=0;r<16;++r){int kv=kb+(r&3)+8*(r>>2); if(kv>qrel)p0[r]=NEG; if(kv+32>qrel)p1[r]=NEG;}
}
constexpr int NSLOT=3, SLOTK=8192, SLOTV=16384, OSTP=272;
constexpr int LDS_K=0, LDS_V=NSLOT*SLOTK, LDS_WS=LDS_V+NSLOT*SLOTV, LDS_OST=LDS_WS+NW*64*4, LDS_BYTES=LDS_OST+NW*32*OSTP;
constexpr float C2=0.125f*1.4426950408889634f;
__device__ __forceinline__ void glds16(const void*gsrc,unsigned lds_dst){unsigned keep;
  asm volatile("s_mov_b32 %0, m0\n\ts_mov_b32 m0, %2\n\ts_nop 0\n\tglobal_load_lds_dwordx4 %1, off\n\ts_mov_b32 m0, %0":"=&s"(keep):"v"(gsrc),"s"(lds_dst):"memory");}
__device__ __forceinline__ float max3f(float a,float b,float c){float r;asm("v_max3_f32 %0, %1, %2, %3":"=v"(r):"v"(a),"v"(b),"v"(c));return r;}
__device__ __forceinline__ float max2f(float a,float b){float r;asm("v_max_f32_e32 %0, %1, %2":"=v"(r):"v"(a),"v"(b));return r;}
__device__ __forceinline__ float fsub_s(float a,float b){float r;asm("v_sub_f32_e32 %0, %1, %2":"=v"(r):"v"(a),"v"(b));return r;}
typedef float f32x2_t __attribute__((ext_vector_type(2))); typedef __bf16 bf16x2_t __attribute__((ext_vector_type(2)));
__device__ __forceinline__ unsigned cvtpk_s(float lo,float hi){f32x2_t v={lo,hi};bf16x2_t b=__builtin_convertvector(v,bf16x2_t);return __builtin_bit_cast(unsigned,b);}
#define WAIT_BAR(N) asm volatile("s_waitcnt vmcnt(" #N ") lgkmcnt(0)\n\ts_barrier":::"memory")
#define MFMA(a,b,c) __builtin_amdgcn_mfma_f32_32x32x16_bf16(a,b,c,0,0,0)
__device__ __forceinline__ void qkt(f32x16&p0,f32x16&p1,const char*Kslot,const bf16x8*qr,int r32,int hi){
  const char*kb=Kslot+hi*1024+r32*16;
  #pragma unroll
  for(int d0=0;d0<4;++d0){
    const bf16x8 b0=*reinterpret_cast<const bf16x8*>(kb+d0*2048);
    const bf16x8 b1=*reinterpret_cast<const bf16x8*>(kb+d0*2048+512);
    if(d0==0){p0=MFMA(b0,qr[0],f32x16{});p1=MFMA(b1,qr[0],f32x16{});}
    else{p0=MFMA(b0,qr[d0],p0);p1=MFMA(b1,qr[d0],p1);}}
}
typedef __attribute__((address_space(3))) const char* lds_cptr;
typedef short v4i16_t __attribute__((ext_vector_type(4)));
#define KLD(p) (*(const __attribute__((address_space(3))) bf16x8*)(p))
__device__ __forceinline__ s16x4 vtr(lds_cptr p){ return __builtin_bit_cast(s16x4,__builtin_amdgcn_ds_read_tr16_b64_v4i16((__attribute__((address_space(3))) v4i16_t*)p)); }
__device__ __forceinline__ float rowmax(const f32x16&p0,const f32x16&p1){
  float a=max3f(p0[0],p0[1],p1[0]),b=max3f(p0[2],p0[3],p1[1]);a=max3f(a,p1[2],p1[3]);
  #pragma unroll
  for(int r=4;r<16;r+=4){a=max3f(a,p0[r],p0[r+1]);b=max3f(b,p0[r+2],p0[r+3]);a=max3f(a,p1[r],p1[r+1]);b=max3f(b,p1[r+2],p1[r+3]);}
  const float m=max2f(a,b);
  auto rr=__builtin_amdgcn_permlane32_swap(__float_as_uint(m),__float_as_uint(m),false,false);
  return max2f(__uint_as_float(rr[0]),__uint_as_float(rr[1]));
}
__device__ __forceinline__ void pv4(f32x16*o,int vb,bf16x8 pa0,bf16x8 pa1,bf16x8 pa2,bf16x8 pa3){
  #pragma unroll
  for(int d0=0;d0<4;++d0){s16x4 lo[4],hi[4];
    #pragma unroll
    for(int ks=0;ks<4;++ks){
      asm volatile("ds_read_b64_tr_b16 %0,%1 offset:%c2":"=&v"(lo[ks]):"v"(vb),"i"(d0*4096+ks*1024):"memory");
      asm volatile("ds_read_b64_tr_b16 %0,%1 offset:%c2":"=&v"(hi[ks]):"v"(vb),"i"(d0*4096+ks*1024+512):"memory");}
    asm volatile("s_waitcnt lgkmcnt(0)":::"memory");SBAR();
    #define PK(k) (bf16x8){lo[k][0],lo[k][1],lo[k][2],lo[k][3],hi[k][0],hi[k][1],hi[k][2],hi[k][3]}
    o[d0]=MFMA(pa0,PK(0),o[d0]);
    o[d0]=MFMA(pa1,PK(1),o[d0]);
    o[d0]=MFMA(pa2,PK(2),o[d0]);
    o[d0]=MFMA(pa3,PK(3),o[d0]);
    #undef PK
  }
}
#ifndef ATTN_STORE16
#define ATTN_STORE16(p,v) (*(u32x4*)(p)=(v))
#endif
template<int THRL> __device__ __forceinline__ void attn_unit(int b,int h,int qb,const bf16*Q,const bf16*__restrict__ K,const bf16*__restrict__ V,bf16*O,char*shm,const int wave_){
  const int lane=lane_id_(),r32=lane&31,hi=lane>>5; const int wid=wave_;
  const long rowbase=(long)b*SEQ; const int q0=qb*QB;
  const bf16*Qw=Q+(rowbase+q0+wid*QBLK)*DM+h*D;
  const bf16*Kh=K+rowbase*DM+h*D,*Vh=V+rowbase*DM+(h>>1)*VW;
  const unsigned lds0=(unsigned)(uintptr_t)shm;
  float*wsf=(float*)(shm+LDS_WS)+wid*64;
  const bf16*ksrc=Kh+(long)lane*DM+wid*8;
  const bf16*vsrc=Vh+(long)(16*(wid&3)+(lane>>2))*DM+(wid>>2)*32+(lane&3)*8;
  const unsigned kdst=lds0+LDS_K+wid*1024, vdst=lds0+LDS_V+wid*1024;
  #define DMA_K(t,slot) glds16(ksrc+(long)(t)*KVBLK*DM,(unsigned)__builtin_amdgcn_readfirstlane(kdst+(slot)))
  #define DMA_V(t,slot) do{ glds16(vsrc+(long)(t)*KVBLK*DM,(unsigned)__builtin_amdgcn_readfirstlane(vdst+(slot))); glds16(vsrc+(long)(t)*KVBLK*DM+64,(unsigned)__builtin_amdgcn_readfirstlane(vdst+(slot)+8192)); }while(0)
  const char*Kbase=shm+LDS_K; bf16x8 kf[8];
  const lds_cptr shm3=(lds_cptr)shm; const lds_cptr kp0=shm3+LDS_K+hi*1024+r32*16; const lds_cptr vp0=shm3+LDS_V+((lane>>4)&1)*32+(lane&3)*8+(4*hi+((lane&15)>>2))*64;
  const int NT=(q0+QB)/KVBLK;
  DMA_K(0,0);DMA_V(0,0);DMA_K(1,SLOTK);
  bf16x8 qr[4];
  #pragma unroll
  for(int d0=0;d0<4;++d0)qr[d0]=*reinterpret_cast<const bf16x8*>(&Qw[(long)r32*DM+d0*16+hi*8]);
  float mhat=0.f,l_reg=0.f;f32x16 o[4];o[0]=f32x16{};o[1]=f32x16{};o[2]=f32x16{};o[3]=f32x16{};
  const int qrel=wid*QBLK+r32;
  #define CMASK(P0,P1,t) do{int jb_=(t)-(NT-4); if(jb_>=0)cmask(P0,P1,jb_,qrel,hi);}while(0)
  bool resc=false;
  #define RESC() do{ if(resc){ asm volatile("s_waitcnt lgkmcnt(0)":::"memory"); \
      _Pragma("unroll") for(int r=0;r<16;++r){ const float f_=wsf[crow(r,hi)]; o[0][r]*=f_; o[1][r]*=f_; o[2][r]*=f_; o[3][r]*=f_; } } }while(0)
  f32x16 C0,C1; u32x4 pwa0,pwa1,pwa2,pwa3;
  int sk_prev=0,sk_cur=0,sk_next=SLOTK, sv_prev=0,sv_cur=0,sv_next=SLOTV;
  #define ROT() do{sk_prev=sk_cur;sk_cur=sk_next;sk_next=(sk_next==(NSLOT-1)*SLOTK)?0:sk_next+SLOTK; sv_prev=sv_cur;sv_cur=sv_next;sv_next=(sv_next==(NSLOT-1)*SLOTV)?0:sv_next+SLOTV;}while(0)
  #define PKW(P,B) cvtpk_s(P[B],P[B+1])
  DMA_K(2,2*SLOTK);
  WAIT_BAR(4);
  qkt(C0,C1,Kbase,qr,r32,hi);asm volatile("s_nop 15\n\ts_nop 7":"+v"(C0),"+v"(C1));CMASK(C0,C1,0);
  { const float rm=rowmax(C0,C1); mhat=rm;
    _Pragma("unroll") for(int r=0;r<16;++r){C0[r]=fsub_s(C0[r],rm);C1[r]=fsub_s(C1[r],rm);}
    _Pragma("unroll") for(int r=0;r<16;++r){C0[r]=__builtin_amdgcn_exp2f(C0[r]);C1[r]=__builtin_amdgcn_exp2f(C1[r]);}
    float s_=0.f; _Pragma("unroll") for(int r=0;r<16;++r)s_+=C0[r]+C1[r]; l_reg=s_;
    pwa0=(u32x4){PKW(C0,0),PKW(C0,2),PKW(C0,4),PKW(C0,6)};pwa1=(u32x4){PKW(C0,8),PKW(C0,10),PKW(C0,12),PKW(C0,14)};pwa2=(u32x4){PKW(C1,0),PKW(C1,2),PKW(C1,4),PKW(C1,6)};pwa3=(u32x4){PKW(C1,8),PKW(C1,10),PKW(C1,12),PKW(C1,14)}; }
  WAIT_BAR(0);
  DMA_K(3,0);DMA_V(1,SLOTV);
  ROT();
  { _Pragma("unroll") for(int j=0;j<8;++j)kf[j]=KLD(kp0+sk_cur+(j>>1)*2048+(j&1)*512); }
  WAIT_BAR(3);
  s16x4 vlo[16],vhi[16];
  #define PAF(S,k) __builtin_bit_cast(bf16x8,pw##S##k)
  #define VFR(i) (bf16x8){vlo[i][0],vlo[i][1],vlo[i][2],vlo[i][3],vhi[i][0],vhi[i][1],vhi[i][2],vhi[i][3]}
  #define PIN(x) asm volatile("":"+v"(x))
  #define MX3(a,b,c) __builtin_fmaxf(__builtin_fmaxf((a),(b)),(c))
  #define EX(v) __builtin_amdgcn_exp2f(v)
  #define VRDL(i) vlo[i]=vtr(vp_+(((i)>>2)*4096+((i)&3)*1024))
  #define VRDH(i) vhi[i]=vtr(vp_+(((i)>>2)*4096+((i)&3)*1024+512))
  #define STEP_AB(t,GK,GV,GL) do{ SBAR(); \
    const lds_cptr vp_=vp0+sv_prev; \
     C0=MFMA(kf[0],qr[0],f32x16{}); SBAR(); \
     C1=MFMA(kf[1],qr[0],f32x16{}); SBAR(); \
    VRDL(0); SBAR(); C0=MFMA(kf[2],qr[1],C0); SBAR(); \
    VRDH(0); SBAR(); C1=MFMA(kf[3],qr[1],C1); SBAR(); \
    VRDL(4); SBAR(); C0=MFMA(kf[4],qr[2],C0); SBAR(); \
    VRDH(4); SBAR(); C1=MFMA(kf[5],qr[2],C1); SBAR(); \
    VRDL(8); SBAR(); C0=MFMA(kf[6],qr[3],C0); SBAR(); \
    VRDH(8); SBAR(); C1=MFMA(kf[7],qr[3],C1); SBAR(); \
    if(GK){DMA_K((t)+3,sk_cur);} if(GV){DMA_V((t)+1,sv_next);} \
    CMASK(C0,C1,t); \
    { float a=MX3(C0[0],C0[1],C1[0]),b=MX3(C0[2],C0[3],C1[1]); a=MX3(a,C1[2],C1[3]); \
      _Pragma("unroll") for(int r=4;r<16;r+=4){a=MX3(a,C0[r],C0[r+1]);b=MX3(b,C0[r+2],C0[r+3]);a=MX3(a,C1[r],C1[r+1]);b=MX3(b,C1[r+2],C1[r+3]);} \
      float rm=__builtin_fmaxf(a,b); { auto rr=__builtin_amdgcn_permlane32_swap(__float_as_uint(rm),__float_as_uint(rm),false,false); rm=__builtin_fmaxf(__uint_as_float(rr[0]),__uint_as_float(rr[1])); } \
      resc=false; \
      rm-=mhat; \
      if(__builtin_expect(__any(rm>(float)THRL),0)){ const float dl=__builtin_fmaxf(rm,0.f); mhat+=dl; \
        const float f=__builtin_amdgcn_exp2f(-dl); l_reg*=f; if(hi==0)wsf[r32]=f; resc=true; } \
      _Pragma("unroll") for(int r=0;r<16;++r){C0[r]-=mhat;C1[r]-=mhat;} } \
    SBAR(); float sacc=0.f; \
    VRDL(12); VRDH(12); SBAR(); o[0]=MFMA(PAF(a,0),VFR(0),o[0]); C0[0]=EX(C0[0]); C0[1]=EX(C0[1]); PIN(C0); SBAR(); \
    VRDL(1); VRDH(1); SBAR(); o[1]=MFMA(PAF(a,0),VFR(4),o[1]); C0[2]=EX(C0[2]); C0[3]=EX(C0[3]); PIN(C0); sacc+=(C0[0]+C0[1]); PIN(sacc); SBAR(); \
    VRDL(5); VRDH(5); SBAR(); o[2]=MFMA(PAF(a,0),VFR(8),o[2]); C0[4]=EX(C0[4]); C0[5]=EX(C0[5]); PIN(C0); sacc+=(C0[2]+C0[3]); PIN(sacc); SBAR(); \
    VRDL(9); VRDH(9); SBAR(); o[3]=MFMA(PAF(a,0),VFR(12),o[3]); C0[6]=EX(C0[6]); C0[7]=EX(C0[7]); PIN(C0); sacc+=(C0[4]+C0[5]); PIN(sacc); SBAR(); \
    VRDL(13); VRDH(13); if(GL){ kf[0]=KLD(kp0+sk_next+0); } SBAR(); o[0]=MFMA(PAF(a,1),VFR(1),o[0]); C0[8]=EX(C0[8]); C0[9]=EX(C0[9]); PIN(C0); sacc+=(C0[6]+C0[7]); PIN(sacc); pwa0[0]=PKW(C0,0); PIN(pwa0); SBAR(); \
    VRDL(2); VRDH(2); if(GL){ kf[1]=KLD(kp0+sk_next+512); } SBAR(); o[1]=MFMA(PAF(a,1),VFR(5),o[1]); C0[10]=EX(C0[10]); C0[11]=EX(C0[11]); PIN(C0); sacc+=(C0[8]+C0[9]); PIN(sacc); pwa0[1]=PKW(C0,2); PIN(pwa0); SBAR(); \
    VRDL(6); VRDH(6); if(GL){ kf[2]=KLD(kp0+sk_next+2048); } SBAR(); o[2]=MFMA(PAF(a,1),VFR(9),o[2]); C0[12]=EX(C0[12]); C0[13]=EX(C0[13]); PIN(C0); sacc+=(C0[10]+C0[11]); PIN(sacc); pwa0[2]=PKW(C0,4); PIN(pwa0); SBAR(); \
    VRDL(10); VRDH(10); if(GL){ kf[3]=KLD(kp0+sk_next+2560); } SBAR(); o[3]=MFMA(PAF(a,1),VFR(13),o[3]); C0[14]=EX(C0[14]); C0[15]=EX(C0[15]); PIN(C0); sacc+=(C0[12]+C0[13]); PIN(sacc); pwa0[3]=PKW(C0,6); PIN(pwa0); SBAR(); \
    VRDL(14); VRDH(14); if(GL){ kf[4]=KLD(kp0+sk_next+4096); } SBAR(); o[0]=MFMA(PAF(a,2),VFR(2),o[0]); C1[0]=EX(C1[0]); C1[1]=EX(C1[1]); PIN(C1); sacc+=(C0[14]+C0[15]); PIN(sacc); pwa1[0]=PKW(C0,8); PIN(pwa1); SBAR(); \
    VRDL(3); VRDH(3); if(GL){ kf[5]=KLD(kp0+sk_next+4608); } SBAR(); o[1]=MFMA(PAF(a,2),VFR(6),o[1]); C1[2]=EX(C1[2]); C1[3]=EX(C1[3]); PIN(C1); sacc+=(C1[0]+C1[1]); PIN(sacc); pwa1[1]=PKW(C0,10); PIN(pwa1); SBAR(); \
    VRDL(7); VRDH(7); if(GL){ kf[6]=KLD(kp0+sk_next+6144); } SBAR(); o[2]=MFMA(PAF(a,2),VFR(10),o[2]); C1[4]=EX(C1[4]); C1[5]=EX(C1[5]); PIN(C1); sacc+=(C1[2]+C1[3]); PIN(sacc); pwa1[2]=PKW(C0,12); PIN(pwa1); SBAR(); \
    VRDL(11); VRDH(11); if(GL){ kf[7]=KLD(kp0+sk_next+6656); } SBAR(); o[3]=MFMA(PAF(a,2),VFR(14),o[3]); C1[6]=EX(C1[6]); C1[7]=EX(C1[7]); PIN(C1); sacc+=(C1[4]+C1[5]); PIN(sacc); pwa1[3]=PKW(C0,14); PIN(pwa1); SBAR(); \
    VRDL(15); VRDH(15); SBAR(); o[0]=MFMA(PAF(a,3),VFR(3),o[0]); C1[8]=EX(C1[8]); C1[9]=EX(C1[9]); PIN(C1); sacc+=(C1[6]+C1[7]); PIN(sacc); pwa2[0]=PKW(C1,0); PIN(pwa2); SBAR(); \
    o[1]=MFMA(PAF(a,3),VFR(7),o[1]); C1[10]=EX(C1[10]); C1[11]=EX(C1[11]); PIN(C1); sacc+=(C1[8]+C1[9]); PIN(sacc); pwa2[1]=PKW(C1,2); PIN(pwa2); SBAR(); \
    o[2]=MFMA(PAF(a,3),VFR(11),o[2]); C1[12]=EX(C1[12]); C1[13]=EX(C1[13]); PIN(C1); sacc+=(C1[10]+C1[11]); PIN(sacc); pwa2[2]=PKW(C1,4); PIN(pwa2); SBAR(); \
    o[3]=MFMA(PAF(a,3),VFR(15),o[3]); C1[14]=EX(C1[14]); C1[15]=EX(C1[15]); PIN(C1); sacc+=(C1[12]+C1[13]); PIN(sacc); pwa2[3]=PKW(C1,6); PIN(pwa2); SBAR(); \
    sacc+=(C1[14]+C1[15]); pwa3[0]=PKW(C1,8); pwa3[1]=PKW(C1,10); pwa3[2]=PKW(C1,12); pwa3[3]=PKW(C1,14); PIN(pwa3); l_reg+=sacc; \
    }while(0)
  #define STEP_BA(t,GK,GV,GL) do{ SBAR(); \
    const lds_cptr vp_=vp0+sv_prev; \
     C0=MFMA(kf[0],qr[0],f32x16{}); SBAR(); \
     C1=MFMA(kf[1],qr[0],f32x16{}); SBAR(); \
    VRDL(0); SBAR(); C0=MFMA(kf[2],qr[1],C0); SBAR(); \
    VRDH(0); SBAR(); C1=MFMA(kf[3],qr[1],C1); SBAR(); \
    VRDL(4); SBAR(); C0=MFMA(kf[4],qr[2],C0); SBAR(); \
    VRDH(4); SBAR(); C1=MFMA(kf[5],qr[2],C1); SBAR(); \
    VRDL(8); SBAR(); C0=MFMA(kf[6],qr[3],C0); SBAR(); \
    VRDH(8); SBAR(); C1=MFMA(kf[7],qr[3],C1); SBAR(); \
    if(GK){DMA_K((t)+3,sk_cur);} if(GV){DMA_V((t)+1,sv_next);} \
    CMASK(C0,C1,t); \
    { float a=MX3(C0[0],C0[1],C1[0]),b=MX3(C0[2],C0[3],C1[1]); a=MX3(a,C1[2],C1[3]); \
      _Pragma("unroll") for(int r=4;r<16;r+=4){a=MX3(a,C0[r],C0[r+1]);b=MX3(b,C0[r+2],C0[r+3]);a=MX3(a,C1[r],C1[r+1]);b=MX3(b,C1[r+2],C1[r+3]);} \
      float rm=__builtin_fmaxf(a,b); { auto rr=__builtin_amdgcn_permlane32_swap(__float_as_uint(rm),__float_as_uint(rm),false,false); rm=__builtin_fmaxf(__uint_as_float(rr[0]),__uint_as_float(rr[1])); } \
      resc=false; \
      rm-=mhat; \
      if(__builtin_expect(__any(rm>(float)THRL),0)){ const float dl=__builtin_fmaxf(rm,0.f); mhat+=dl; \
        const float f=__builtin_amdgcn_exp2f(-dl); l_reg*=f; if(hi==0)wsf[r32]=f; resc=true; } \
      _Pragma("unroll") for(int r=0;r<16;++r){C0[r]-=mhat;C1[r]-=mhat;} } \
    SBAR(); float sacc=0.f; \
    VRDL(12); VRDH(12); SBAR(); o[0]=MFMA(PAF(a,0),VFR(0),o[0]); C0[0]=EX(C0[0]); C0[1]=EX(C0[1]); PIN(C0); SBAR(); \
    VRDL(1); VRDH(1); SBAR(); o[1]=MFMA(PAF(a,0),VFR(4),o[1]); C0[2]=EX(C0[2]); C0[3]=EX(C0[3]); PIN(C0); sacc+=(C0[0]+C0[1]); PIN(sacc); SBAR(); \
    VRDL(5); VRDH(5); SBAR(); o[2]=MFMA(PAF(a,0),VFR(8),o[2]); C0[4]=EX(C0[4]); C0[5]=EX(C0[5]); PIN(C0); sacc+=(C0[2]+C0[3]); PIN(sacc); SBAR(); \
    VRDL(9); VRDH(9); SBAR(); o[3]=MFMA(PAF(a,0),VFR(12),o[3]); C0[6]=EX(C0[6]); C0[7]=EX(C0[7]); PIN(C0); sacc+=(C0[4]+C0[5]); PIN(sacc); SBAR(); \
    VRDL(13); VRDH(13); if(GL){ kf[0]=KLD(kp0+sk_next+0); } SBAR(); o[0]=MFMA(PAF(a,1),VFR(1),o[0]); C0[8]=EX(C0[8]); C0[9]=EX(C0[9]); PIN(C0); sacc+=(C0[6]+C0[7]); PIN(sacc); pwa0[0]=PKW(C0,0); PIN(pwa0); SBAR(); \
    VRDL(2); VRDH(2); if(GL){ kf[1]=KLD(kp0+sk_next+512); } SBAR(); o[1]=MFMA(PAF(a,1),VFR(5),o[1]); C0[10]=EX(C0[10]); C0[11]=EX(C0[11]); PIN(C0); sacc+=(C0[8]+C0[9]); PIN(sacc); pwa0[1]=PKW(C0,2); PIN(pwa0); SBAR(); \
    VRDL(6); VRDH(6); if(GL){ kf[2]=KLD(kp0+sk_next+2048); } SBAR(); o[2]=MFMA(PAF(a,1),VFR(9),o[2]); C0[12]=EX(C0[12]); C0[13]=EX(C0[13]); PIN(C0); sacc+=(C0[10]+C0[11]); PIN(sacc); pwa0[2]=PKW(C0,4); PIN(pwa0); SBAR(); \
    VRDL(10); VRDH(10); if(GL){ kf[3]=KLD(kp0+sk_next+2560); } SBAR(); o[3]=MFMA(PAF(a,1),VFR(13),o[3]); C0[14]=EX(C0[14]); C0[15]=EX(C0[15]); PIN(C0); sacc+=(C0[12]+C0[13]); PIN(sacc); pwa0[3]=PKW(C0,6); PIN(pwa0); SBAR(); \
    VRDL(14); VRDH(14); if(GL){ kf[4]=KLD(kp0+sk_next+4096); } SBAR(); o[0]=MFMA(PAF(a,2),VFR(2),o[0]); C1[0]=EX(C1[0]); C1[1]=EX(C1[1]); PIN(C1); sacc+=(C0[14]+C0[15]); PIN(sacc); pwa1[0]=PKW(C0,8); PIN(pwa1); SBAR(); \
    VRDL(3); VRDH(3); if(GL){ kf[5]=KLD(kp0+sk_next+4608); } SBAR(); o[1]=MFMA(PAF(a,2),VFR(6),o[1]); C1[2]=EX(C1[2]); C1[3]=EX(C1[3]); PIN(C1); sacc+=(C1[0]+C1[1]); PIN(sacc); pwa1[1]=PKW(C0,10); PIN(pwa1); SBAR(); \
    VRDL(7); VRDH(7); if(GL){ kf[6]=KLD(kp0+sk_next+6144); } SBAR(); o[2]=MFMA(PAF(a,2),VFR(10),o[2]); C1[4]=EX(C1[4]); C1[5]=EX(C1[5]); PIN(C1); sacc+=(C1[2]+C1[3]); PIN(sacc); pwa1[2]=PKW(C0,12); PIN(pwa1); SBAR(); \
    VRDL(11); VRDH(11); if(GL){ kf[7]=KLD(kp0+sk_next+6656); } SBAR(); o[3]=MFMA(PAF(a,2),VFR(14),o[3]); C1[6]=EX(C1[6]); C1[7]=EX(C1[7]); PIN(C1); sacc+=(C1[4]+C1[5]); PIN(sacc); pwa1[3]=PKW(C0,14); PIN(pwa1); SBAR(); \
    VRDL(15); VRDH(15); SBAR(); o[0]=MFMA(PAF(a,3),VFR(3),o[0]); C1[8]=EX(C1[8]); C1[9]=EX(C1[9]); PIN(C1); sacc+=(C1[6]+C1[7]); PIN(sacc); pwa2[0]=PKW(C1,0); PIN(pwa2); SBAR(); \
    o[1]=MFMA(PAF(a,3),VFR(7),o[1]); C1[10]=EX(C1[10]); C1[11]=EX(C1[11]); PIN(C1); sacc+=(C1[8]+C1[9]); PIN(sacc); pwa2[1]=PKW(C1,2); PIN(pwa2); SBAR(); \
    o[2]=MFMA(PAF(a,3),VFR(11),o[2]); C1[12]=EX(C1[12]); C1[13]=EX(C1[13]); PIN(C1); sacc+=(C1[10]+C1[11]); PIN(sacc); pwa2[2]=PKW(C1,4); PIN(pwa2); SBAR(); \
    o[3]=MFMA(PAF(a,3),VFR(15),o[3]); C1[14]=EX(C1[14]); C1[15]=EX(C1[15]); PIN(C1); sacc+=(C1[12]+C1[13]); PIN(sacc); pwa2[3]=PKW(C1,6); PIN(pwa2); SBAR(); \
    sacc+=(C1[14]+C1[15]); pwa3[0]=PKW(C1,8); pwa3[1]=PKW(C1,10); pwa3[2]=PKW(C1,12); pwa3[3]=PKW(C1,14); PIN(pwa3); l_reg+=sacc; \
    }while(0)

  int t=1;
  #undef CMASK
  #define CMASK(P0,P1,t) do{}while(0)
  for(;t+5<NT;t+=2){
    STEP_AB(t,true,true,true);     WAIT_BAR(3); RESC(); ROT();
    STEP_BA(t+1,true,true,true);   WAIT_BAR(3); RESC(); ROT();
  }
  #undef CMASK
  #define CMASK(P0,P1,t) do{int jb_=(t)-(NT-4); if(jb_>=0)cmask(P0,P1,jb_,qrel,hi);}while(0)
  #define ENDW(tt) do{ if((tt)+3<NT){WAIT_BAR(3);} else if((tt)+2<NT){WAIT_BAR(2);} else {WAIT_BAR(0);} }while(0)
  for(;t+1<NT;t+=2){
    STEP_AB(t,(t+3<NT),(t+1<NT),(t+1<NT));       ENDW(t);   RESC(); ROT();
    STEP_BA(t+1,(t+4<NT),(t+2<NT),(t+2<NT));     ENDW(t+1); RESC(); ROT();
  }
  STEP_AB(NT-1,false,false,false); RESC();
  SBAR(); pv4(o,(int)(unsigned long)(vp0+sv_cur),PAF(a,0),PAF(a,1),PAF(a,2),PAF(a,3));
  #undef PKW
  #undef PAF
  #undef VFR
  #undef PIN
  #undef MX3
  #undef EX
  #undef VRDL
  #undef VRDH
  #undef STEP_AB
  #undef STEP_BA
  #undef ENDW
  {auto rr=__builtin_amdgcn_permlane32_swap(__float_as_uint(l_reg),__float_as_uint(l_reg),false,false);l_reg=__uint_as_float(rr[0])+__uint_as_float(rr[1]);}
  if(hi==0)wsf[32+r32]=l_reg;asm volatile("s_waitcnt lgkmcnt(0)":::"memory");
  float rli[16];
  #pragma unroll
  for(int r=0;r<16;++r)rli[r]=__builtin_amdgcn_rcpf(wsf[32+crow(r,hi)]);
  int l2_=lane_id_(); asm volatile("":"+v"(l2_));
  bf16*Ow=O+(rowbase+q0+wid*QBLK)*OPITCH+h*VW;
  { char*stg=shm+LDS_OST+wid*(32*OSTP);
    #pragma unroll
    for(int r=0;r<16;++r){const int orow=crow(r,hi);
      #pragma unroll
      for(int d0=0;d0<4;++d0)*(bf16*)(stg+orow*OSTP+(d0*32+r32)*2)=__float2bfloat16(o[d0][r]*rli[r]);}
    asm volatile("s_waitcnt lgkmcnt(0)":::"memory");
    #pragma unroll
    for(int i=0;i<8;++i){const int row=i*4+(l2_>>4),ch=l2_&15; const u32x4 v=*(const u32x4*)(stg+row*OSTP+ch*16); ATTN_STORE16(Ow+(long)row*OPITCH+ch*8,v);} }
  asm volatile("s_waitcnt lgkmcnt(0)\n\ts_barrier":::"memory");
  #undef DMA_K
  #undef DMA_V
  #undef CMASK
  #undef RESC
  #undef ROT
}
constexpr int ATTN_LDS_BYTES=LDS_BYTES;
struct AttnTensors { const bf16* Q; const bf16* K; const bf16* V; bf16* O; };
struct AttnUnit { int bh; int qb; };
struct StaticOrder {
  int vcu, G;
  __device__ __forceinline__ explicit StaticOrder(int vcu_,int G_):vcu(vcu_),G(G_){}
  __device__ __forceinline__ bool next(int i,AttnUnit&u)const{ const int w=vcu+(i>>3)*G; if(w>=BATCH*NHEAD*2)return false; u.bh=w>>1; const int j=w&1,k=i&7,base=4*(k>>1); u.qb=(k&1)?(base+3-j):(base+j); return true; }
};
template<class Sched,int THRL=8> __device__ __forceinline__ void attn_phase(char*lds,const AttnTensors&T,const Sched&S,const int wave_){
  AttnUnit u;
  for(int i=0;S.next(i,u);++i){ attn_unit<THRL>(u.bh/NHEAD,u.bh%NHEAD,u.qb,T.Q,T.K,T.V,T.O,lds,wave_); }
}
#undef SBAR
#undef WAIT_BAR
#undef MFMA
#undef KLD
}
#define GAS __attribute__((address_space(1)))
#define LAS __attribute__((address_space(3)))
#define XB_TMO      128
#define XB_XCNT(j)  (256  + 64 * (j))
#define XB_XSUB(j)  (1280 + 64 * (j))
#define XB_XGEN(j)  (2304 + 64 * (j))
#define XB_TOP      3328
#define XB_TOPGEN   3392
#define XCD_BAR_WORDS 3456
#define XB_SPIN_CAP (1u << 18)

__device__ __forceinline__ unsigned xb_ld(unsigned* p)              { return __hip_atomic_load(p, __ATOMIC_RELAXED, __HIP_MEMORY_SCOPE_AGENT); }
__device__ __forceinline__ unsigned xb_add(unsigned* p, unsigned v) { return __hip_atomic_fetch_add(p, v, __ATOMIC_RELAXED, __HIP_MEMORY_SCOPE_AGENT); }
__device__ __forceinline__ unsigned xb_xcc_id() { return (unsigned)__builtin_amdgcn_s_getreg((3 << 11) | 20) & 0xFu; }
#define XB_SPIN(cond, bar) do { unsigned _sp = 0; while (cond) { __builtin_amdgcn_s_sleep(1); \
    if ((++_sp & 255u) == 0u) { if (xb_ld(&(bar)[XB_TMO])) break; if (_sp > XB_SPIN_CAP) { atomicAdd(&(bar)[XB_TMO], 1u); break; } } } } while (0)

struct XcdBarrier {
    unsigned* bar; unsigned x;
    volatile LAS unsigned* st;
};

__device__ __forceinline__ XcdBarrier xcd_barrier_post(unsigned* bar, volatile LAS unsigned* st, const bool lane0w0) {
    XcdBarrier b; b.bar = bar; b.x = xb_xcc_id(); b.st = st;
    if (lane0w0) (void)xb_add(&bar[XB_XCNT(b.x)], 1u);
    return b;
}
__device__ __forceinline__ void xcd_barrier_complete(unsigned* bar, unsigned x, unsigned& nloc, unsigned& nx) {
    const unsigned G = gridDim.x * gridDim.y * gridDim.z;
    unsigned sum, cnt, mine, sp = 0u;
    for (;;) {
        sum = 0u; cnt = 0u; mine = 0u;
#pragma unroll
        for (unsigned j = 0; j < 16; ++j) { const unsigned c = xb_ld(&bar[XB_XCNT(j)]); sum += c; cnt += (c > 0u) ? 1u : 0u; mine = (j == x) ? c : mine; }
        if (sum == G) break;
        __builtin_amdgcn_s_sleep(1);
        if ((++sp & 255u) == 0u) { if (xb_ld(&bar[XB_TMO])) break; if (sp > XB_SPIN_CAP) { atomicAdd(&bar[XB_TMO], 1u); break; } }
    }
    nloc = mine > 0u ? mine : 1u; nx = cnt > 0u ? cnt : 1u;
}

__device__ __forceinline__ void xcd_barrier(const XcdBarrier& b, const bool lane0w0) {
    asm volatile("s_waitcnt vmcnt(0)" ::: "memory");
    __syncthreads();
    if (lane0w0) {
        unsigned* bar = b.bar;
        __builtin_amdgcn_s_waitcnt(0);
        unsigned nloc = b.st[0], nx = b.st[1];
        if (nloc == 0u) { xcd_barrier_complete(bar, b.x, nloc, nx); b.st[0] = nloc; b.st[1] = nx; }
        const unsigned old = xb_add(&bar[XB_XSUB(b.x)], 1u);
        const unsigned gen = old / nloc;
        if (old + 1u == (gen + 1u) * nloc) {
            __builtin_amdgcn_fence(__ATOMIC_RELEASE, "agent");
            asm volatile("s_waitcnt vmcnt(0)" ::: "memory");
            const unsigned og = xb_add(&bar[XB_TOP], 1u);
            const unsigned tg = og / nx;
            if (og + 1u == (tg + 1u) * nx) xb_add(&bar[XB_TOPGEN], 1u);
            else XB_SPIN(xb_ld(&bar[XB_TOPGEN]) == tg, bar);
            __builtin_amdgcn_fence(__ATOMIC_ACQUIRE, "agent");
            xb_add(&bar[XB_XGEN(b.x)], 1u);
            asm volatile("s_waitcnt vmcnt(0)" ::: "memory");
        } else {
            XB_SPIN(xb_ld(&bar[XB_XGEN(b.x)]) == gen, bar);
            __builtin_amdgcn_fence(__ATOMIC_ACQUIRE, "agent");
            asm volatile("s_waitcnt vmcnt(0)" ::: "memory");
        }
    }
    __syncthreads();
}
constexpr int NWAVES = 8;
constexpr int BATCH = 8, SEQ = 4096, D = 1024, M = BATCH * SEQ, NIN = 8192;
constexpr float NORM_EPS = 1e-6f;
constexpr float LAM_INIT = 0.2f;
constexpr size_t MiB = 1u << 20, SLOT = 64 * MiB;
constexpr size_t WS_XR = 0 * SLOT, WS_ZR = 1 * SLOT  , WS_Q = 2 * SLOT  , WS_K = 3 * SLOT  , WS_V = 4 * SLOT  , WS_ZA = 5 * SLOT  , WS_U = 6 * SLOT;
constexpr size_t WS_MISC = 7 * SLOT;
constexpr size_t WS_CTL = WS_MISC, CTL_ZERO_BYTES = 64 * 1024;
constexpr size_t WS_CARRY = WS_MISC + 1 * MiB;
constexpr size_t WS_STATS = WS_MISC + 2 * MiB;
constexpr size_t WS_WIN = WS_MISC + 4 * MiB;
constexpr size_t WS_WR = WS_MISC + 20 * MiB, WS_WA = WS_MISC + 22 * MiB, WS_WO = WS_MISC + 24 * MiB, WS_END = WS_MISC + 26 * MiB;
constexpr int LDS_BYTES = 147456;
constexpr int MISC_OFF = 147456 - 256;

typedef unsigned short bf16;
typedef unsigned v4u __attribute__((ext_vector_type(4)));
typedef float f32x4 __attribute__((ext_vector_type(4)));
typedef float f32x16 __attribute__((ext_vector_type(16)));
typedef short bf16x8 __attribute__((ext_vector_type(8)));
#define LDS_WAIT() asm volatile("s_waitcnt lgkmcnt(0)" ::: "memory")
__device__ __forceinline__ unsigned f2bf(float f) { unsigned u = __builtin_bit_cast(unsigned, f); return (u + 0x7fffu + ((u >> 16) & 1u)) >> 16; }
typedef float f32x2_ __attribute__((ext_vector_type(2))); typedef __bf16 bf16x2_ __attribute__((ext_vector_type(2)));
__device__ __forceinline__ unsigned pk2(float lo, float hi) { f32x2_ v = {lo, hi}; return __builtin_bit_cast(unsigned, __builtin_convertvector(v, bf16x2_)); }
__device__ __forceinline__ float bflo(unsigned w) { return __builtin_bit_cast(float, w << 16); }
__device__ __forceinline__ float bfhi(unsigned w) { return __builtin_bit_cast(float, w & 0xffff0000u); }
__device__ __forceinline__ float sigm(float v) { return __builtin_amdgcn_rcpf(1.0f + __builtin_amdgcn_exp2f(-1.4426950408889634f * v)); }
__device__ __forceinline__ float wave_sum(float v) {
#pragma unroll
    for (int o = 1; o < 64; o <<= 1) v += __shfl_xor(v, o);
    return v;
}

struct Frame {
    LAS unsigned char* lds;
    int wave, vcu, G;
    const float* in[19]; float* out; unsigned char* ws;
};
enum { I_X = 0, I_PREG, I_POSTG, I_WIN, I_CONVW, I_CONVB, I_WA, I_BA, I_WX, I_BX, I_LRUA, I_LQ1, I_LK1, I_LQ2, I_LK2, I_SUBG, I_WBR, I_WBA, I_WOUT };

__device__ __forceinline__ void p0_transpose_item(const float* W, int K, int N, bf16* WT, int ldk, LAS float* scr, int item, int lane) {
    const int nblk = N / 32, kb = item / nblk, nb = item % nblk, k0 = 64 * kb, n0 = 32 * nb;
#pragma unroll 8
    for (int i = 0; i < 32; ++i) { const int kk = 2 * i + (lane >> 5); scr[kk * 33 + (lane & 31)] = W[(size_t)(k0 + kk) * N + n0 + (lane & 31)]; }
    LDS_WAIT(); asm volatile("" ::: "memory");
    const int c = lane & 7;
#pragma unroll
    for (int j = 0; j < 4; ++j) { const int n = (lane >> 3) + 8 * j; const LAS float* s = scr + (8 * c) * 33 + n;
        v4u o; o.x = pk2(s[0 * 33], s[1 * 33]); o.y = pk2(s[2 * 33], s[3 * 33]); o.z = pk2(s[4 * 33], s[5 * 33]); o.w = pk2(s[6 * 33], s[7 * 33]);
        *(GAS v4u*)(WT + (size_t)(n0 + n) * ldk + k0 + 8 * c) = o; }
    LDS_WAIT(); asm volatile("" ::: "memory");
}
__device__ __forceinline__ void p0_prologue(Frame& F) {
    LAS float* scr = (LAS float*)(F.lds + F.wave * 16384);
    const int gw = F.vcu * NWAVES + F.wave, NGW = F.G * NWAVES;
    constexpr int I_BIG = (D / 64) * (NIN / 32), I_SM = (D / 64) * (D / 32);
    constexpr int NITEMS = I_BIG + 3 * I_SM;
    for (int it = gw; it < NITEMS; it += NGW) {
        int r = it;
        if (r < I_BIG) { p0_transpose_item(F.in[I_WIN], D, NIN, (bf16*)(F.ws + WS_WIN), D, scr, r, lane_id_()); continue; } r -= I_BIG;
        if (r < I_SM) { p0_transpose_item(F.in[I_WBR], D, D, (bf16*)(F.ws + WS_WR), 2 * D, scr, r, lane_id_()); continue; } r -= I_SM;
        if (r < I_SM) { p0_transpose_item(F.in[I_WBA], D, D, (bf16*)(F.ws + WS_WR) + D, 2 * D, scr, r, lane_id_()); continue; } r -= I_SM;
        p0_transpose_item(F.in[I_WOUT], D, D, (bf16*)(F.ws + WS_WO), D, scr, r, lane_id_());
    }
    const GAS f32x4* gp = (const GAS f32x4*)F.in[I_PREG] + lane_id_();
    f32x4 gg[4];
#pragma unroll
    for (int j = 0; j < 4; ++j) gg[j] = gp[64 * j];
    for (int m = gw; m < M; m += NGW) {
        const GAS f32x4* xr = (const GAS f32x4*)(F.in[I_X] + (size_t)m * D) + lane_id_();
        f32x4 v[4]; float s = 0.f;
#pragma unroll
        for (int j = 0; j < 4; ++j) { v[j] = xr[64 * j]; s += (v[j].x * v[j].x + v[j].y * v[j].y) + (v[j].z * v[j].z + v[j].w * v[j].w); }
        const float rstd = 1.0f / sqrtf(wave_sum(s) * (1.f / D) + NORM_EPS);
        GAS unsigned long long* o8 = (GAS unsigned long long*)((bf16*)(F.ws + WS_U) + (size_t)m * D) + lane_id_();
#pragma unroll
        for (int j = 0; j < 4; ++j) { const f32x4 y = v[j] * rstd * gg[j]; o8[64 * j] = (unsigned long long)pk2(y.x, y.y) | ((unsigned long long)pk2(y.z, y.w) << 32); }
    }
}

constexpr int SC_WFRAG = 0;
constexpr int SC_CONV = 16384;
constexpr int SC_WAVE = 16384 + 2048, SC_WAVE_BYTES = 5120 + 4608;
__device__ __forceinline__ int crow16(int r, int hi) { return (r & 3) + 8 * (r >> 2) + 4 * hi; }
template <bool PASS2> __device__ __forceinline__ void scan_phase(Frame& F) {
    const int lane = lane_id_(), tid_ = F.wave * 64 + lane, r32 = lane & 31, hi = lane >> 5;
    LAS unsigned char* const lw = F.lds + SC_WAVE + F.wave * SC_WAVE_BYTES;
    LAS unsigned char* const lz = lw + 5120;
    const LAS float* const lc = (const LAS float*)(F.lds + SC_CONV);
    const bf16* XR = (const bf16*)(F.ws + WS_XR); bf16* ZR = (bf16*)(F.ws + WS_ZR);
    float* carry = (float*)(F.ws + WS_CARRY);
    for (int wi = F.vcu; wi < BATCH * 16 * 2; wi += F.G) {
        const int b = wi >> 5, g = (wi >> 1) & 15, half = wi & 1, sc = half * 8 + F.wave, c0 = g * 64;
        __syncthreads();
        for (int idx = tid_; idx < 1024; idx += NWAVES * 64) {
            const int mat = idx >> 9, f = (idx >> 6) & 7, kk = f >> 1, nt = f & 1, ln = idx & 63, n = 32 * nt + (ln & 31), kb = 16 * kk + 8 * (ln >> 5);
            const float* W = F.in[mat ? I_WX : I_WA] + (size_t)(g * 64 + kb) * 64 + n;
            v4u o; o.x = pk2(W[0], W[64]); o.y = pk2(W[128], W[192]); o.z = pk2(W[256], W[320]); o.w = pk2(W[384], W[448]);
            *(LAS v4u*)(F.lds + SC_WFRAG + idx * 16) = o;
        }
        if (tid_ < 320) { const int tap = tid_ >> 6, ch = tid_ & 63; ((LAS float*)(F.lds + SC_CONV))[tid_] = (tap < 4) ? F.in[I_CONVW][tap * D + c0 + ch] : F.in[I_CONVB][c0 + ch]; }
        __syncthreads();
        float cba[2], cbx[2], ckc[2], H[2], P[2];
#pragma unroll
        for (int nt = 0; nt < 2; ++nt) { const int c = c0 + 32 * nt + r32; cba[nt] = F.in[I_BA][c]; cbx[nt] = F.in[I_BX][c];
            ckc[nt] = -8.0f * 1.4426950408889634f * log1pf(expf(-F.in[I_LRUA][c])); H[nt] = 0.f; P[nt] = 1.f; }
        if (PASS2) {
            for (int j0 = 0; j0 < sc; j0 += 8) {
                float2 ab[8][2];
#pragma unroll
                for (int jj = 0; jj < 8; ++jj)
#pragma unroll
                    for (int nt = 0; nt < 2; ++nt) ab[jj][nt] = *(const float2*)(carry + ((size_t)(b * 16 + ((j0 + jj) & 15)) * D + c0 + 32 * nt + r32) * 2);
#pragma unroll
                for (int jj = 0; jj < 8; ++jj) if (j0 + jj < sc) {
#pragma unroll
                    for (int nt = 0; nt < 2; ++nt) H[nt] = ab[jj][nt].x * H[nt] + ab[jj][nt].y; }
            }
        }
        bf16x8 idf[4];
#pragma unroll
        for (int kk = 0; kk < 4; ++kk) { const int d = (32 * (kk >> 1) + r32) - (16 * kk + 8 * hi); v4u w;
            w.x = (d == 0 ? 0x3F80u : 0u) | (d == 1 ? 0x3F800000u : 0u); w.y = (d == 2 ? 0x3F80u : 0u) | (d == 3 ? 0x3F800000u : 0u);
            w.z = (d == 4 ? 0x3F80u : 0u) | (d == 5 ? 0x3F800000u : 0u); w.w = (d == 6 ? 0x3F80u : 0u) | (d == 7 ? 0x3F800000u : 0u);
            idf[kk] = __builtin_bit_cast(bf16x8, w); }
        v4u nx[5], nz[4];
#define SC_LOAD(T0) do { _Pragma("unroll") for (int i = 0; i < 5; ++i) { const int row = i * 8 + (lane >> 3), ch = lane & 7, t = (T0) - 3 + row; \
                nx[i] = (v4u){0u, 0u, 0u, 0u}; if (row < 35 && t >= 0) nx[i] = *(const GAS v4u*)(XR + (size_t)(b * SEQ + t) * D + c0 + ch * 8); } \
            if (PASS2) { _Pragma("unroll") for (int i = 0; i < 4; ++i) { const int row = i * 8 + (lane >> 3), ch = lane & 7; \
                nz[i] = *(const GAS v4u*)(ZR + (size_t)(b * SEQ + (T0) + row) * D + c0 + ch * 8); } } } while (0)
        SC_LOAD(sc * 256);
        for (int sub = 0; sub < 8; ++sub) {
            const int t0 = sc * 256 + sub * 32;
#pragma unroll
            for (int i = 0; i < 5; ++i) { const int row = i * 8 + (lane >> 3), ch = lane & 7; if (row < 35) *(LAS v4u*)(lw + row * 144 + ch * 16) = nx[i]; }
            if (PASS2) {
#pragma unroll
                for (int i = 0; i < 4; ++i) { const int row = i * 8 + (lane >> 3), ch = lane & 7; *(LAS v4u*)(lz + row * 144 + ch * 16) = nz[i]; }
            }
            if (sub < 7) SC_LOAD(t0 + 32);
            bf16x8 af[4];
#pragma unroll
            for (int kk = 0; kk < 4; ++kk) { const int cb = 16 * kk + 8 * hi;
                f32x4 a0 = *(const LAS f32x4*)(lc + 256 + cb), a1 = *(const LAS f32x4*)(lc + 256 + cb + 4);
#pragma unroll
                for (int tap = 0; tap < 4; ++tap) { const v4u x = *(const LAS v4u*)(lw + (r32 + tap) * 144 + cb * 2);
                    const f32x4 w0 = *(const LAS f32x4*)(lc + tap * 64 + cb), w1 = *(const LAS f32x4*)(lc + tap * 64 + cb + 4);
                    a0[0] += w0[0] * bflo(x.x); a0[1] += w0[1] * bfhi(x.x); a0[2] += w0[2] * bflo(x.y); a0[3] += w0[3] * bfhi(x.y);
                    a1[0] += w1[0] * bflo(x.z); a1[1] += w1[1] * bfhi(x.z); a1[2] += w1[2] * bflo(x.w); a1[3] += w1[3] * bfhi(x.w); }
                v4u w; w.x = pk2(a0[0], a0[1]); w.y = pk2(a0[2], a0[3]); w.z = pk2(a1[0], a1[1]); w.w = pk2(a1[2], a1[3]);
                af[kk] = __builtin_bit_cast(bf16x8, w); }
#pragma unroll
            for (int nt = 0; nt < 2; ++nt) {
                f32x16 accR = {}, accI = {}, accX = {};
#pragma unroll
                for (int kk = 0; kk < 4; ++kk) {
                    const bf16x8 fa = *(const LAS bf16x8*)(F.lds + SC_WFRAG + ((0 * 8 + kk * 2 + nt) * 64 + lane) * 16);
                    const bf16x8 fx = *(const LAS bf16x8*)(F.lds + SC_WFRAG + ((1 * 8 + kk * 2 + nt) * 64 + lane) * 16);
                    accR = __builtin_amdgcn_mfma_f32_32x32x16_bf16(af[kk], fa, accR, 0, 0, 0);
                    accI = __builtin_amdgcn_mfma_f32_32x32x16_bf16(af[kk], fx, accI, 0, 0, 0);
                    if ((kk >> 1) == nt) accX = __builtin_amdgcn_mfma_f32_32x32x16_bf16(af[kk], idf[kk], accX, 0, 0, 0);
                }
                float Ap[16], hl[16], Aq[4], Bq[4];
#pragma unroll
                for (int q = 0; q < 4; ++q) { float pa = 1.f, hh = 0.f;
#pragma unroll
                    for (int j = 0; j < 4; ++j) { const int r = 4 * q + j;
                        const float rg = sigm(accR[r] + cba[nt]), ig = sigm(accI[r] + cbx[nt]);
                        const float a = __builtin_amdgcn_exp2f(ckc[nt] * rg);
                        const float bb = __builtin_amdgcn_sqrtf(fmaxf(1.0f - a * a, 0.f)) * ig * accX[r];
                        hh = a * hh + bb; pa *= a; Ap[r] = pa; hl[r] = hh; }
                    Aq[q] = pa; Bq[q] = hh; }
                float Ao[4], Bo[4];
#pragma unroll
                for (int q = 0; q < 4; ++q) { Ao[q] = __shfl_xor(Aq[q], 32); Bo[q] = __shfl_xor(Bq[q], 32); }
                float ci[4]; float Hc = H[nt], Pc = P[nt]; const bool up = (hi != 0);
#pragma unroll
                for (int q = 0; q < 4; ++q) { const float a0 = up ? Ao[q] : Aq[q], b0 = up ? Bo[q] : Bq[q], a1 = up ? Aq[q] : Ao[q], b1 = up ? Bq[q] : Bo[q];
                    const float mid = a0 * Hc + b0; ci[q] = up ? mid : Hc; Hc = a1 * mid + b1; Pc *= a0 * a1; }
                H[nt] = Hc; P[nt] = Pc;
                if (PASS2) {
#pragma unroll
                    for (int q = 0; q < 4; ++q) {
#pragma unroll
                        for (int j = 0; j < 4; ++j) { const int r = 4 * q + j; const float hv = Ap[r] * ci[q] + hl[r];
                            LAS unsigned short* zp = (LAS unsigned short*)(lz + crow16(r, hi) * 144 + (32 * nt + r32) * 2);
                            const float zs = __builtin_bit_cast(float, (unsigned)(*zp) << 16);
                            *zp = (unsigned short)pk2(hv * zs, 0.f); } }
                }
            }
            if (PASS2) {
#pragma unroll
                for (int i = 0; i < 4; ++i) { const int row = i * 8 + (lane >> 3), ch = lane & 7;
                    *(GAS v4u*)(ZR + (size_t)(b * SEQ + t0 + row) * D + c0 + ch * 8) = *(const LAS v4u*)(lz + row * 144 + ch * 16); }
            }
        }
#undef SC_LOAD
        if (!PASS2) { if (hi == 0) {
#pragma unroll
            for (int nt = 0; nt < 2; ++nt) *(float2*)(carry + ((size_t)(b * 16 + sc) * D + c0 + 32 * nt + r32) * 2) = make_float2(P[nt], H[nt]); } }
    }
    __syncthreads();
}

__device__ __forceinline__ void combine_phase(Frame& F) {
    const int gw = F.vcu * NWAVES + F.wave, NGW = F.G * NWAVES, lane = lane_id_(), hd = lane >> 3, p = lane & 7;
    const float l1 = wave_sum(F.in[I_LQ1][lane] * F.in[I_LK1][lane]), l2 = wave_sum(F.in[I_LQ2][lane] * F.in[I_LK2][lane]);
    const float lam = expf(l1) - expf(l2) + LAM_INIT;
    float gsc[16];
#pragma unroll
    for (int i = 0; i < 16; ++i) gsc[i] = F.in[I_SUBG][p * 16 + i] * (1.0f - LAM_INIT);
    const bf16* OB = (const bf16*)F.out; bf16* ZA = (bf16*)(F.ws + WS_ZA);
    for (int m = gw; m < M; m += NGW) {
        const bf16* ob = OB + (size_t)m * 2048 + hd * 256 + p * 16;
        const v4u a0 = *(const GAS v4u*)ob, a1 = *(const GAS v4u*)(ob + 8), b0 = *(const GAS v4u*)(ob + 128), b1 = *(const GAS v4u*)(ob + 136);
        bf16* zp = ZA + (size_t)m * D + hd * 128 + p * 16;
        const v4u z0 = *(const GAS v4u*)zp, z1 = *(const GAS v4u*)(zp + 8);
        float o[16]; const unsigned aw[8] = {a0.x, a0.y, a0.z, a0.w, a1.x, a1.y, a1.z, a1.w}, bw[8] = {b0.x, b0.y, b0.z, b0.w, b1.x, b1.y, b1.z, b1.w}, zw[8] = {z0.x, z0.y, z0.z, z0.w, z1.x, z1.y, z1.z, z1.w};
        float ss = 0.f;
#pragma unroll
        for (int i = 0; i < 8; ++i) { o[2 * i] = bflo(aw[i]) - lam * bflo(bw[i]); o[2 * i + 1] = bfhi(aw[i]) - lam * bfhi(bw[i]); ss += o[2 * i] * o[2 * i] + o[2 * i + 1] * o[2 * i + 1]; }
        ss += __shfl_xor(ss, 1); ss += __shfl_xor(ss, 2); ss += __shfl_xor(ss, 4);
        const float rstd = 1.0f / sqrtf(ss * (1.f / 128.f) + NORM_EPS);
        unsigned yw[8];
#pragma unroll
        for (int i = 0; i < 8; ++i) yw[i] = pk2(o[2 * i] * rstd * gsc[2 * i] * bflo(zw[i]), o[2 * i + 1] * rstd * gsc[2 * i + 1] * bfhi(zw[i]));
        *(GAS v4u*)zp = (v4u){yw[0], yw[1], yw[2], yw[3]}; *(GAS v4u*)(zp + 8) = (v4u){yw[4], yw[5], yw[6], yw[7]};
    }
}

__device__ __forceinline__ void final_phase(Frame& F) {
    const int gw = F.vcu * NWAVES + F.wave, NGW = F.G * NWAVES, lane = lane_id_();
    const float* stats = (const float*)(F.ws + WS_STATS);
    f32x4 gg[4];
#pragma unroll
    for (int j = 0; j < 4; ++j) gg[j] = ((const GAS f32x4*)F.in[I_POSTG])[lane + 64 * j];
    for (int m = gw; m < M; m += NGW) {
        float s = stats[(size_t)m * 16 + (lane & 15)];
        s += __shfl_xor(s, 1); s += __shfl_xor(s, 2); s += __shfl_xor(s, 4); s += __shfl_xor(s, 8);
        const float rstd = 1.0f / sqrtf(s * (1.f / D) + NORM_EPS);
        GAS f32x4* yp = (GAS f32x4*)(F.out + (size_t)m * D) + lane; const GAS f32x4* xp = (const GAS f32x4*)(F.in[I_X] + (size_t)m * D) + lane;
#pragma unroll
        for (int j = 0; j < 4; ++j) { const f32x4 y = yp[64 * j], x = xp[64 * j]; yp[64 * j] = x + y * rstd * gg[j]; }
    }
}

struct Args { const float* in[19]; float* out; unsigned char* ws; int ph_lo, ph_hi; };
__global__ void __launch_bounds__(NWAVES * 64, 2) fwd_kernel(Args args) {
    extern __shared__ __attribute__((aligned(16))) unsigned char lds[];
    Frame F;
    F.lds = (LAS unsigned char*)lds;
    F.wave = __builtin_amdgcn_readfirstlane((int)threadIdx.x >> 6);
    F.G = gridDim.x; { const int bx = blockIdx.x; F.vcu = (F.G % 8 == 0) ? (bx % 8) * (F.G / 8) + bx / 8 : bx; }
#pragma unroll
    for (int i = 0; i < 19; ++i) F.in[i] = args.in[i];
    F.out = args.out; F.ws = args.ws;
    unsigned char* ws = args.ws;
    const int lo = args.ph_lo, hi = args.ph_hi;
#define IN(k) (lo <= (k) && (k) < hi)
    const bool lane0w0 = (F.wave == 0) && (lane_id_() == 0);
    if (lane0w0) { ((volatile LAS unsigned*)(F.lds + MISC_OFF))[0] = 0u; ((volatile LAS unsigned*)(F.lds + MISC_OFF))[1] = 0u; }
    __syncthreads();
    XcdBarrier bar = xcd_barrier_post((unsigned*)(ws + WS_CTL) + 1024, (volatile LAS unsigned*)(F.lds + MISC_OFF), lane0w0);
#define SEAM(k) do { if (IN(k) && IN((k) + 1)) { xcd_barrier(bar, (F.wave == 0) && (lane_id_() == 0)); } } while (0)

    if (IN(0)) { p0_prologue(F); }
    SEAM(0);
    if (IN(1)) {
        pg8::Gemm g{(const pg8::bf16_t*)(ws + WS_U), (const pg8::bf16_t*)(ws + WS_WIN), M, 6144, D}; pg8::StaticOrder S; S.init(M, 6144, F.G, (int)blockIdx.x);
        pg8::EpiSplit E{(pg8::bf16_t*)(ws + WS_XR), SLOT / 2, 0x100310u, attn_body::C2};
        pg8::gemm_phase<pg8::EpiSplit, pg8::StaticOrder, PG8_ALIGN, PG8_SP2>(F.lds, g, S, E, F.wave);
    }
    SEAM(1);
    if (IN(2)) {
        scan_phase<false>(F);
        const attn_body::AttnTensors AT{(const attn_body::bf16*)(ws + WS_Q), (const attn_body::bf16*)(ws + WS_K), (const attn_body::bf16*)(ws + WS_V), (attn_body::bf16*)F.out};
        const attn_body::StaticOrder AS(F.vcu, F.G); attn_body::attn_phase<attn_body::StaticOrder>((char*)lds, AT, AS, F.wave);
    }
    SEAM(2);
    if (IN(3)) {
        { pg8::Gemm g{(const pg8::bf16_t*)(ws + WS_U), (const pg8::bf16_t*)(ws + WS_WIN) + (size_t)6144 * D, M, 2048, D}; pg8::StaticOrder S; S.init(M, 2048, F.G, (int)blockIdx.x);
          pg8::EpiSplit E{(pg8::bf16_t*)(ws + WS_Q), SLOT / 2, 0x22u, 1.0f};
          pg8::gemm_phase<pg8::EpiSplit, pg8::StaticOrder, PG8_ALIGN, PG8_SP2>(F.lds, g, S, E, F.wave); }
        scan_phase<true>(F);
        combine_phase(F);
    }
    SEAM(3);
    if (IN(4)) {
        pg8::Gemm g{(const pg8::bf16_t*)(ws + WS_ZR), (const pg8::bf16_t*)(ws + WS_WR), M, D, 2 * D, (const pg8::bf16_t*)(ws + WS_ZA), D, (D / 64)}; pg8::StaticOrder S; S.init(M, D, F.G, (int)blockIdx.x);
        pg8::EpiGateMerge E{(const pg8::bf16_t*)(ws + WS_Q), (const pg8::bf16_t*)(ws + WS_K), (pg8::bf16_t*)(ws + WS_V)};
        pg8::gemm_phase<pg8::EpiGateMerge, pg8::StaticOrder, PG8_ALIGN, PG8_SP2>(F.lds, g, S, E, F.wave);
    }
    SEAM(4);
    if (IN(5)) {
        pg8::Gemm g{(const pg8::bf16_t*)(ws + WS_V), (const pg8::bf16_t*)(ws + WS_WO), M, D, D}; pg8::StaticOrder S; S.init(M, D, F.G, (int)blockIdx.x);
        pg8::EpiF32Stats E{F.out, (float*)(ws + WS_STATS)};
        pg8::gemm_phase<pg8::EpiF32Stats, pg8::StaticOrder, PG8_ALIGN, PG8_SP2>(F.lds, g, S, E, F.wave);
    }
    SEAM(5);
    if (IN(6)) { final_phase(F); }
#undef IN
#undef SEAM
}

extern "C" void kernel_launch(void* const* d_in, const int* in_sizes, int n_in, void* d_out, int out_size, void* d_ws, size_t ws_size, hipStream_t stream) {
    static int grid = 0;
    if (grid == 0) {
        if (n_in != 19 || in_sizes[0] != M * D || out_size != M * D || ws_size < WS_END) { fprintf(stderr, "kernel_launch: unexpected shapes (n_in %d, in0 %d, out %d, ws %zu)\n", n_in, n_in > 0 ? in_sizes[0] : -1, out_size, ws_size); grid = -1; return; }
        int dev = 0, cus = 0, per_cu = 0;
        if (hipGetDevice(&dev) != hipSuccess || hipDeviceGetAttribute(&cus, hipDeviceAttributeMultiprocessorCount, dev) != hipSuccess) { grid = -1; return; }
        if (hipFuncSetAttribute((const void*)fwd_kernel, hipFuncAttributeMaxDynamicSharedMemorySize, LDS_BYTES) != hipSuccess) { fprintf(stderr, "kernel_launch: hipFuncSetAttribute failed\n"); grid = -1; return; }
        if (hipOccupancyMaxActiveBlocksPerMultiprocessor(&per_cu, (const void*)fwd_kernel, NWAVES * 64, LDS_BYTES) != hipSuccess || per_cu < 1) { fprintf(stderr, "kernel_launch: occupancy query says %d\n", per_cu); (void)hipGetLastError(); grid = -1; return; }
        grid = cus;
    }
    if (grid < 0) return;
    if (hipMemsetAsync((char*)d_ws + WS_CTL, 0, CTL_ZERO_BYTES, stream) != hipSuccess) { fprintf(stderr, "kernel_launch: hipMemsetAsync failed\n"); return; }
    Args a{};
    for (int i = 0; i < 19; ++i) a.in[i] = (const float*)d_in[i];
    a.out = (float*)d_out; a.ws = (unsigned char*)d_ws; a.ph_lo = 0; a.ph_hi = 7;
    void* kargs[] = {&a};
    const hipError_t e = hipLaunchCooperativeKernel((const void*)fwd_kernel, dim3(grid), dim3(NWAVES * 64), kargs, LDS_BYTES, stream);
    if (e != hipSuccess) fprintf(stderr, "kernel_launch: launch failed: %s (grid %d)\n", hipGetErrorString(e), grid);
}
```
